# Optimizing an MI355X kernel written in HIP

```python
import jax, jax.numpy as jnp
from jax import lax
import numpy as np

D_MODEL = 1024
BATCH = 8
SEQ = 2048
DEPTH = 1
DEC_BATCH = 128
DEC_SEQ = 1
PAST_LEN = 16384
PAGE_SIZE = 128

CONV_DIM = D_MODEL // 2
CONV_WIDTH = 31
RET_HEADS = 4
RET_QK_DIM = 128
RET_V_DIM = 256
RET_QK_WIDTH = RET_HEADS * RET_QK_DIM
RET_V_WIDTH = RET_HEADS * RET_V_DIM
RET_CHUNK = 128
FFN_DIM = 4 * D_MODEL
ROPE_BASE = 10000.0
EPS = 1e-6
IN_SIZES = (CONV_DIM, CONV_DIM, RET_QK_WIDTH, RET_QK_WIDTH, RET_V_WIDTH, RET_V_WIDTH, D_MODEL, D_MODEL)
IN_COLS = sum(IN_SIZES)
IN_SPLITS = [int(s) for s in np.cumsum(IN_SIZES)[:-1]]

kernel_name = "gated_conformer_retention_decoder_step"


def rms_norm(x, w):
    xf = x.astype(jnp.float32)
    y = xf * lax.rsqrt(jnp.mean(xf * xf, axis=-1, keepdims=True) + EPS)
    return (y * w.astype(jnp.float32)).astype(x.dtype)


def layer_norm(x, w, b):
    xf = x.astype(jnp.float32)
    mu = jnp.mean(xf, axis=-1, keepdims=True)
    xc = xf - mu
    y = xc * lax.rsqrt(jnp.mean(xc * xc, axis=-1, keepdims=True) + EPS)
    return (y * w.astype(jnp.float32) + b.astype(jnp.float32)).astype(x.dtype)


def rotary(x, pos):
    half = x.shape[-1] // 2
    freqs = 1.0 / (ROPE_BASE ** jnp.linspace(0.0, 1.0, half, dtype=jnp.float32))
    ang = pos[:, None] * freqs[None, :]
    c = jnp.cos(ang)[None, :, None, :]
    s = jnp.sin(ang)[None, :, None, :]
    x1, x2 = x[..., :half], x[..., half:]
    return jnp.concatenate([x1 * c - x2 * s, x2 * c + x1 * s], axis=-1)


def log_gammas():
    return jnp.log1p(-jnp.exp2(-5.0 - jnp.arange(RET_HEADS, dtype=jnp.float32)))


def retention_chunk(S, q, k, v):
    C = q.shape[1]
    lg = log_gammas()
    idx = jnp.arange(C, dtype=jnp.float32)
    diff = idx[:, None] - idx[None, :]
    causal = diff >= 0
    expo = jnp.where(causal, diff, 0.0)
    decay = jnp.where(causal[None], jnp.exp(expo[None] * lg[:, None, None]), 0.0)
    scores = jnp.einsum('bihd,bjhd->bhij', q, k) * decay[None]
    intra = jnp.einsum('bhij,bjhe->bihe', scores, v)
    q_decay = jnp.exp((idx + 1.0)[:, None] * lg[None, :])
    cross = jnp.einsum('bihd,bhde->bihe', q, S) * q_decay[None, :, :, None]
    k_decay = jnp.exp((C - 1.0 - idx)[:, None] * lg[None, :])
    S_new = jnp.exp(C * lg)[None, :, None, None] * S + jnp.einsum(
        'bjhd,bjhe->bhde', k * k_decay[None, :, :, None], v)
    return S_new, intra + cross


def retention_scan(q, k, v, S0):
    B, T = q.shape[0], q.shape[1]
    chunk = RET_CHUNK if T % RET_CHUNK == 0 else T
    n = T // chunk

    def to_chunks(a):
        return jnp.moveaxis(a.reshape(B, n, chunk, a.shape[2], a.shape[3]), 1, 0)

    def step(S, qkv):
        qc, kc, vc = qkv
        return retention_chunk(S, qc, kc, vc)

    S_fin, o = lax.scan(step, S0, (to_chunks(q), to_chunks(k), to_chunks(v)))
    o = jnp.moveaxis(o, 0, 1).reshape(B, T, RET_HEADS, RET_V_DIM)
    return S_fin, o


def mixer(xn, conv_buf, ret_state, pos, w_in, w_dw, b_dw, conv_ln_w, conv_ln_b,
          w_conv_out, w_ret_out, w_o):
    B, T, _ = xn.shape
    proj = xn @ w_in
    a_val, a_gate, q, k, v, g, gate_a, gate_b = jnp.split(proj, IN_SPLITS, axis=-1)

    u = a_val * jax.nn.sigmoid(a_gate)
    full = jnp.concatenate([conv_buf.astype(u.dtype), u], axis=1)
    conv = lax.conv_general_dilated(
        full, w_dw[:, None, :], window_strides=(1,), padding='VALID',
        dimension_numbers=('NWC', 'WIO', 'NWC'), feature_group_count=CONV_DIM) + b_dw
    new_buf = full[:, full.shape[1] - (CONV_WIDTH - 1):]
    a_out = jax.nn.silu(layer_norm(conv, conv_ln_w, conv_ln_b)) @ w_conv_out

    qf = rotary(q.reshape(B, T, RET_HEADS, RET_QK_DIM).astype(jnp.float32), pos)
    kf = rotary(k.reshape(B, T, RET_HEADS, RET_QK_DIM).astype(jnp.float32), pos) * (RET_QK_DIM ** -0.5)
    vf = v.reshape(B, T, RET_HEADS, RET_V_DIM).astype(jnp.float32)
    S_new, o = retention_scan(qf, kf, vf, ret_state.astype(jnp.float32))
    o = o * lax.rsqrt(jnp.mean(o * o, axis=-1, keepdims=True) + EPS)
    o = o.reshape(B, T, RET_V_WIDTH).astype(xn.dtype)
    b_out = (jax.nn.silu(g) * o) @ w_ret_out

    merged = jax.nn.sigmoid(gate_a) * a_out + jax.nn.sigmoid(gate_b) * b_out
    return merged @ w_o, new_buf, S_new


def block(x, conv_buf, ret_state, pos, p):
    (n_mix_pre, n_mix_post, w_in, w_dw, b_dw, conv_ln_w, conv_ln_b, w_conv_out,
     w_ret_out, w_o, n_ffn_pre, n_ffn_post, w_up, w_down) = p
    m, new_buf, S_new = mixer(rms_norm(x, n_mix_pre), conv_buf, ret_state, pos, w_in, w_dw, b_dw,
                              conv_ln_w, conv_ln_b, w_conv_out, w_ret_out, w_o)
    h = x + rms_norm(m, n_mix_post)
    f = jnp.square(jax.nn.relu(rms_norm(h, n_ffn_pre) @ w_up)) @ w_down
    return h + rms_norm(f, n_ffn_post), new_buf, S_new


def setup_inputs(seed: int = 0) -> dict:
    key = jax.random.key(seed)
    ks = jax.random.split(key, 20)
    f32 = jnp.float32

    def nrm(k, shape, scale):
        return jax.random.normal(k, shape, f32) * scale

    def gain(k, n):
        return 1.0 + nrm(k, (DEPTH, n), 0.02)

    return {
        "x_prompt": nrm(ks[0], (BATCH, SEQ, D_MODEL), 1.0),
        "x_sample": nrm(ks[1], (DEC_BATCH, DEC_SEQ, D_MODEL), 1.0),
        "cache_conv": nrm(ks[2], (DEPTH, DEC_BATCH, CONV_WIDTH - 1, CONV_DIM), 0.5),
        "state_ret": nrm(ks[3], (DEPTH, DEC_BATCH, RET_HEADS, RET_QK_DIM, RET_V_DIM), 0.5),
        "norm_mix_pre": gain(ks[4], D_MODEL),
        "norm_mix_post": gain(ks[5], D_MODEL),
        "w_in": nrm(ks[6], (DEPTH, D_MODEL, IN_COLS), D_MODEL ** -0.5),
        "w_dw": nrm(ks[7], (DEPTH, CONV_WIDTH, CONV_DIM), CONV_WIDTH ** -0.5),
        "b_dw": nrm(ks[8], (DEPTH, CONV_DIM), 0.01),
        "conv_ln_w": gain(ks[9], CONV_DIM),
        "conv_ln_b": nrm(ks[10], (DEPTH, CONV_DIM), 0.01),
        "w_conv_out": nrm(ks[11], (DEPTH, CONV_DIM, D_MODEL), CONV_DIM ** -0.5),
        "w_ret_out": nrm(ks[12], (DEPTH, RET_V_WIDTH, D_MODEL), RET_V_WIDTH ** -0.5),
        "w_o": nrm(ks[13], (DEPTH, D_MODEL, D_MODEL), D_MODEL ** -0.5),
        "norm_ffn_pre": gain(ks[14], D_MODEL),
        "norm_ffn_post": gain(ks[15], D_MODEL),
        "w_ffn_up": nrm(ks[16], (DEPTH, D_MODEL, FFN_DIM), D_MODEL ** -0.5),
        "w_ffn_down": nrm(ks[17], (DEPTH, FFN_DIM, D_MODEL), FFN_DIM ** -0.5),
    }


def reference(x_prompt, x_sample, cache_conv, state_ret, norm_mix_pre, norm_mix_post, w_in,
              w_dw, b_dw, conv_ln_w, conv_ln_b, w_conv_out, w_ret_out, w_o, norm_ffn_pre,
              norm_ffn_post, w_ffn_up, w_ffn_down):
    B, T = x_prompt.shape[0], x_prompt.shape[1]
    Bs, Ts = x_sample.shape[0], x_sample.shape[1]
    pos_p = jnp.arange(T, dtype=jnp.float32)
    pos_s = PAST_LEN + jnp.arange(Ts, dtype=jnp.float32)
    zero_buf = jnp.zeros((B, CONV_WIDTH - 1, CONV_DIM), x_prompt.dtype)
    zero_S = jnp.zeros((B, RET_HEADS, RET_QK_DIM, RET_V_DIM), jnp.float32)

    xp, xs = x_prompt, x_sample
    conv_p, ret_p, conv_s, ret_s = [], [], [], []
    for l in range(DEPTH):
        p = (norm_mix_pre[l], norm_mix_post[l], w_in[l], w_dw[l], b_dw[l], conv_ln_w[l],
             conv_ln_b[l], w_conv_out[l], w_ret_out[l], w_o[l], norm_ffn_pre[l],
             norm_ffn_post[l], w_ffn_up[l], w_ffn_down[l])
        xp, cb, sp = block(xp, zero_buf, zero_S, pos_p, p)
        xs, cbs, ss = block(xs, cache_conv[l], state_ret[l], pos_s, p)
        conv_p.append(cb)
        ret_p.append(sp)
        conv_s.append(cbs)
        ret_s.append(ss)

    new_conv_prompt = jnp.stack(conv_p)
    new_ret_prompt = jnp.stack(ret_p)
    new_conv_sample = jnp.stack(conv_s)
    new_ret_sample = jnp.stack(ret_s)
    return (xp, xs, new_conv_prompt, new_ret_prompt, new_conv_sample, new_ret_sample)
```

```cpp
#include <hip/hip_runtime.h>
#include <hip/hip_cooperative_groups.h>
#include <cstdio>
#include <cstdint>
namespace cg = cooperative_groups;

#define LAS __attribute__((address_space(3)))
typedef unsigned short bf16_t;
typedef short bf16x8 __attribute__((ext_vector_type(8)));
typedef float f32x4 __attribute__((ext_vector_type(4)));
typedef unsigned u32x4 __attribute__((ext_vector_type(4)));
typedef unsigned u32x2 __attribute__((ext_vector_type(2)));

constexpr int DM = 1024, NB = 8, SEQ = 2048, MP = NB * SEQ  , MS = 128, RT = MP + MS  ;
constexpr int CD = 512, CW = 31, NH = 4, DK = 128, DV = 256, FF = 4096, NIN = 6144;
constexpr float EPS = 1e-6f;
constexpr size_t O_NCP = (size_t)RT * DM;
constexpr size_t O_NRP = O_NCP + (size_t)NB * 30 * CD;
constexpr size_t O_NCS = O_NRP + (size_t)NB * NH * DK * DV;
constexpr size_t O_NRS = O_NCS + (size_t)MS * 30 * CD;
constexpr size_t WS_CTL = 0, WS_BAR = 4096, WS_WIN = 131072, WS_WCO = WS_WIN + (size_t)NIN * DM * 2, WS_WRO = WS_WCO + (size_t)DM * CD * 2,
                 WS_WO = WS_WRO + (size_t)DM * DM * 2, WS_WUP = WS_WO + (size_t)DM * DM * 2, WS_WDN = WS_WUP + (size_t)FF * DM * 2,
                 WS_ACT = WS_WDN + (size_t)FF * DM * 2;
constexpr size_t A_U = 0, A_Q = A_U + (size_t)RT * 512 * 2, A_K = A_Q + (size_t)RT * 512 * 2, A_V = A_K + (size_t)RT * 512 * 2,
                 A_SG = A_V + (size_t)RT * 1024 * 2, A_SA = A_SG + (size_t)RT * 1024 * 2, A_SB = A_SA + (size_t)RT * 1024 * 2,
                 A_AACT = A_SB + (size_t)RT * 1024 * 2, A_END = A_AACT + (size_t)RT * 512 * 2;
constexpr size_t A_M2 = (size_t)RT * 1024 * 2  , A_HN = 0  , A_F = 0  , A_UP = (size_t)RT * 1024 * 4;
static_assert(A_UP + (size_t)RT * FF * 2 <= A_END, "act region");
constexpr size_t WS_SSQ = WS_ACT + A_END, WS_END = WS_SSQ + (size_t)MP * 16 * 4;
constexpr size_t WS_XCH = WS_END;
constexpr size_t WS_XCHS = WS_XCH + 3 * 64 * 256 * 4 * 4;
constexpr size_t WS_WCO2 = WS_XCHS + 3 * 8 * 16 * 32 * 4;
constexpr size_t WS_END2 = WS_WCO2 + (size_t)DM * DM * 2;
constexpr size_t AA_OFF = (size_t)RT * 1024;
constexpr size_t CTL_XCNT = 20480;
constexpr size_t CTL_XCNTS = CTL_XCNT + 3 * 64 * 256;
constexpr size_t CTL_ZERO = CTL_XCNTS + 3 * 8 * 256;
static_assert(CTL_ZERO <= WS_WIN, "control words");
constexpr int LDS_BYTES = 147456;

struct Ctx {
    const float *xp, *xs, *cache_conv, *state_ret, *n_mix_pre, *n_mix_post, *w_in, *w_dw, *b_dw, *ln_w, *ln_b, *w_co, *w_ro, *w_o,
        *n_ffn_pre, *n_ffn_post, *w_up, *w_dn;
    float* out; unsigned char* ws;
};

__device__ __forceinline__ unsigned pk2(float lo, float hi) { unsigned r; asm volatile("v_cvt_pk_bf16_f32 %0, %1, %2" : "=v"(r) : "v"(lo), "v"(hi)); return r; }
__device__ __forceinline__ float bflo(unsigned w) { return __uint_as_float(w << 16); }
__device__ __forceinline__ float bfhi(unsigned w) { return __uint_as_float(w & 0xffff0000u); }
__device__ __forceinline__ float bf2f(bf16_t b) { return __uint_as_float(((unsigned)b) << 16); }
__device__ __forceinline__ float sigm(float x) { return __builtin_amdgcn_rcpf(1.0f + __expf(-x)); }
__device__ __forceinline__ float wave_sum(float v) {
#pragma unroll
    for (int o = 1; o < 64; o <<= 1) v += __shfl_xor(v, o);
    return v;
}
#define LDS_WAIT() asm volatile("s_waitcnt lgkmcnt(0)" ::: "memory")
__device__ __forceinline__ int otid() { int t = threadIdx.x; asm volatile("" : "+v"(t)); return t; }
__device__ __forceinline__ const float* xrow(const Ctx& c, int row) { return row < MP ? c.xp + (size_t)row * DM : c.xs + (size_t)(row - MP) * DM; }

namespace pg8 {
constexpr int BM = 256, BK = 64, HALF = 128, HTB = HALF * BK * 2, STAGE_BYTES = 8 * HTB, NXCD = 8, WGM = 8;
__host__ __device__ __forceinline__ int lds_byte(int r, int c) { const int st = (r >> 4) * 2 + (c >> 5), rr = r & 15, cc = c & 31, ob = rr * 64 + cc * 2; return st * 1024 + (ob ^ (((ob >> 9) & 1) << 5)); }
__host__ __device__ __forceinline__ void stage_rc(int b, int& R, int& C) { const int st = b / 1024, sb = b % 1024, swz = sb ^ (((sb >> 9) & 1) << 5); R = (st >> 1) * 16 + swz / 64; C = (st & 1) * 32 + (swz % 64) / 2; }
__host__ __device__ __forceinline__ int perm32(int rho) { const int n = rho >> 4, i = rho & 15; return 8 * (i >> 2) + 4 * n + (i & 3); }
struct Unit { int pm, pn; int sel = 0; };
struct Gemm { const bf16_t* A; const bf16_t* Bt; int M, N, K; const float* ssq = nullptr; const bf16_t* A2 = nullptr; const bf16_t* Bt2 = nullptr; int nt0 = 0; };
struct StaticOrder {
    int nM, nN, nwg, G, c;
    __device__ void init(int M, int N, int G_, int c_) { nM = M / BM; nN = N / BM; nwg = nM * nN; G = G_; c = c_; }
    __device__ bool next(int i, Unit& u) const {
        const long L = (long)i * G + c; if (L >= nwg) return false;
        int wgid = (int)L; { const int q = nwg / NXCD, r = nwg % NXCD, xcd = wgid % NXCD, off = wgid / NXCD; wgid = (xcd < r ? xcd * (q + 1) : r * (q + 1) + (xcd - r) * q) + off; }
        const int nig = WGM * nN, gid = wgid / nig, fm = gid * WGM, gsz = (nM - fm) < WGM ? (nM - fm) : WGM;
        u.pm = fm + ((wgid % nig) % gsz); u.pn = (wgid % nig) / gsz; return true;
    }
};
template <class Epi, bool ALIGN_EPI = false, bool SP2 = true, bool HNORM = false, bool P3 = false>
__device__ __forceinline__ void gemm_phase(LAS unsigned char* lds, const Gemm g, const StaticOrder& S, const Epi& E) {
    int tid_ = threadIdx.x; asm volatile("" : "+v"(tid_));
    const int tid = tid_, wid = __builtin_amdgcn_readfirstlane(tid >> 6), lane = tid & 63, wr = wid >> 2, wc = wid & 3, fr = lane & 15, fq = lane >> 4;
    const int K = g.K, nt = K / BK;
    unsigned voffA[2], voffB[2];
#pragma unroll
    for (int i = 0; i < 2; ++i) { int R, C; stage_rc(tid * 16 + i * 8192, R, C); const int Rb = (R & ~31) + perm32(R & 31);
        voffA[i] = (unsigned)(R * K + C) * 2u; voffB[i] = (unsigned)(Rb * K + C) * 2u; }
    const size_t kstep = (size_t)(BK * 2);
    const size_t hstep = (size_t)HALF * K * 2;
    const size_t tstep = 2 * hstep;
    const unsigned ldsw = (unsigned)wid * 1024u;
    const int aoff = lds_byte(wr * 64 + fr, fq * 8), boff = lds_byte(wc * 32 + fr, fq * 8);
#define PG8_SA(b, h) (((b) * 2 + (h)) * HTB)
#define PG8_SB(b, h) ((4 + (b) * 2 + (h)) * HTB)
#define PG8_STAGE(bufoff, gbase, voff) do { _Pragma("unroll") for (int _i = 0; _i < 2; ++_i) \
        __builtin_amdgcn_global_load_lds((const unsigned*)((const char*)(gbase) + (voff)[_i]), (LAS unsigned*)(lds + (bufoff) + ldsw + _i * 8192), 16, 0, 0); } while (0)
#define PG8_LDA(dst, b, h) do { _Pragma("unroll") for (int m = 0; m < 4; ++m) _Pragma("unroll") for (int k = 0; k < 2; ++k) dst[m][k] = *(const LAS bf16x8*)(lds + PG8_SA(b, h) + aoff + m * 2048 + k * 1024); } while (0)
#define PG8_LDB(dst, b, h) do { _Pragma("unroll") for (int n = 0; n < 2; ++n) _Pragma("unroll") for (int k = 0; k < 2; ++k) dst[n][k] = *(const LAS bf16x8*)(lds + PG8_SB(b, h) + boff + n * 2048 + k * 1024); } while (0)
#define PG8_MMA(ai, bj, At, Bt) do { __builtin_amdgcn_s_setprio(1); _Pragma("unroll") for (int m = 0; m < 4; ++m) _Pragma("unroll") for (int n = 0; n < 2; ++n) _Pragma("unroll") for (int k = 0; k < 2; ++k) \
        acc[ai][bj][m][n] = __builtin_amdgcn_mfma_f32_16x16x32_bf16(Bt[n][k], At[m][k], acc[ai][bj][m][n], 0, 0, 0); __builtin_amdgcn_s_setprio(0); } while (0)
#define PG8_WAIT_V(n) asm volatile("s_waitcnt vmcnt(" #n ")" ::: "memory")
#define PG8_WAIT_L(n) asm volatile("s_waitcnt lgkmcnt(" #n ")" ::: "memory")
#define PG8_BAR __builtin_amdgcn_s_barrier()
#define PG8_SCHED __builtin_amdgcn_sched_barrier(0)
    Unit cur, nxt; int ui = 0;
    if (!S.next(0, cur)) return;
    f32x4 acc[2][2][4][2];
#pragma unroll
    for (int a = 0; a < 2; ++a)
#pragma unroll
        for (int b = 0; b < 2; ++b)
#pragma unroll
            for (int m = 0; m < 4; ++m)
#pragma unroll
                for (int n = 0; n < 2; ++n) acc[a][b][m][n] = (f32x4){0.f, 0.f, 0.f, 0.f};
    bf16x8 At[4][2], B0[2][2], B1[2][2];
    const char* cA = (const char*)g.A + (size_t)cur.pm * tstep; const char* cB = (const char*)g.Bt + (size_t)cur.pn * tstep;
    LAS float* hrt = (LAS float*)(lds + STAGE_BYTES);
    if constexpr (HNORM) {
        if (tid < 256) { const float* q = g.ssq + (size_t)(cur.pm * 256 + tid) * 16; float r[4];
#pragma unroll
            for (int hh = 0; hh < 4; ++hh) { const f32x4 v = *(const f32x4*)(q + 4 * hh); r[hh] = 1.0f / sqrtf(((v.x + v.y) + (v.z + v.w)) * (1.0f / 256.0f) + 1e-6f); }
            *(LAS f32x4*)(hrt + tid * 4) = (f32x4){r[0] / r[1], r[1] / r[2], r[2] / r[3], r[3]}; }
        asm volatile("s_waitcnt vmcnt(0) lgkmcnt(0)" ::: "memory"); PG8_BAR;
    }
    if constexpr (SP2) {
        PG8_STAGE(PG8_SB(0, 0), cB, voffB); PG8_STAGE(PG8_SB(0, 1), cB + hstep, voffB); PG8_STAGE(PG8_SA(0, 0), cA, voffA); PG8_STAGE(PG8_SA(0, 1), cA + hstep, voffA);
        if (wr == 1) PG8_BAR;
        PG8_WAIT_V(2); PG8_BAR;
        PG8_STAGE(PG8_SB(1, 0), cB + kstep, voffB); PG8_STAGE(PG8_SA(1, 0), cA + kstep, voffA); PG8_STAGE(PG8_SB(1, 1), cB + hstep + kstep, voffB);
        PG8_WAIT_V(6); PG8_BAR;
    } else {
    PG8_STAGE(PG8_SB(0, 0), cB, voffB); PG8_STAGE(PG8_SA(0, 0), cA, voffA); PG8_STAGE(PG8_SB(0, 1), cB + hstep, voffB); PG8_STAGE(PG8_SA(0, 1), cA + hstep, voffA);
    if (wr == 1) PG8_BAR;
    PG8_WAIT_V(4); PG8_BAR;
    PG8_STAGE(PG8_SB(1, 0), cB + kstep, voffB); PG8_STAGE(PG8_SA(1, 0), cA + kstep, voffA); PG8_STAGE(PG8_SB(1, 1), cB + hstep + kstep, voffB);
    PG8_WAIT_V(6); PG8_BAR;
    }
    for (;;) {
        bool has_next; const char* nA; const char* nB; int ntc = nt;
        if constexpr (P3) { has_next = (ui == 0); nxt = cur; nxt.sel = 1; ntc = (ui == 0) ? g.nt0 : nt;
            nA = has_next ? (const char*)g.A2 + (size_t)cur.pm * tstep : cA; nB = has_next ? (const char*)g.Bt2 + (size_t)cur.pn * tstep : cB; }
        else { has_next = S.next(ui + 1, nxt);
            nA = has_next ? (const char*)g.A + (size_t)nxt.pm * tstep : cA; nB = has_next ? (const char*)g.Bt + (size_t)nxt.pn * tstep : cB; }
        for (int t = 0; t < ntc; t += 2) {
            const bool last = (t == ntc - 2);
            const char* a1 = cA + (size_t)(t + 1) * kstep;
            const char* a2 = last ? nA : cA + (size_t)(t + 2) * kstep; const char* b2 = last ? nB : cB + (size_t)(t + 2) * kstep;
            const char* a3 = a2 + kstep; const char* b3 = b2 + kstep;
            if constexpr (HNORM) { if ((!P3 || ui == 1) && (t == 4 || t == 8 || t == 12)) { const int hi = (t >> 2) - 1;
#pragma unroll
                for (int ai = 0; ai < 2; ++ai)
#pragma unroll
                    for (int m = 0; m < 4; ++m) { const float f = hrt[(ai * 128 + wr * 64 + m * 16 + fr) * 4 + hi];
#pragma unroll
                        for (int bj = 0; bj < 2; ++bj)
#pragma unroll
                            for (int n = 0; n < 2; ++n) acc[ai][bj][m][n] *= f; } } }
            if constexpr (SP2) {
            PG8_LDB(B0, 0, 0); PG8_LDB(B1, 0, 1); PG8_SCHED; PG8_LDA(At, 0, 0); PG8_STAGE(PG8_SA(1, 1), a1 + hstep, voffA);
            PG8_WAIT_V(8); PG8_WAIT_L(0); PG8_BAR; PG8_MMA(0, 0, At, B0); PG8_MMA(0, 1, At, B1); PG8_BAR; PG8_SCHED;
            PG8_LDA(At, 0, 1); PG8_STAGE(PG8_SB(0, 0), b2, voffB); PG8_STAGE(PG8_SB(0, 1), b2 + hstep, voffB); PG8_STAGE(PG8_SA(0, 0), a2, voffA);
            PG8_WAIT_V(8); PG8_WAIT_L(0); PG8_BAR; PG8_MMA(1, 0, At, B0); PG8_MMA(1, 1, At, B1); PG8_BAR; PG8_SCHED;
            PG8_LDB(B0, 1, 0); PG8_LDB(B1, 1, 1); PG8_SCHED; PG8_LDA(At, 1, 0); PG8_STAGE(PG8_SA(0, 1), a2 + hstep, voffA);
            PG8_WAIT_V(8); PG8_WAIT_L(0); PG8_BAR; PG8_MMA(0, 0, At, B0); PG8_MMA(0, 1, At, B1); PG8_BAR; PG8_SCHED;
            PG8_LDA(At, 1, 1); PG8_STAGE(PG8_SB(1, 0), b3, voffB); PG8_STAGE(PG8_SB(1, 1), b3 + hstep, voffB); PG8_STAGE(PG8_SA(1, 0), a3, voffA);
            PG8_WAIT_V(8); PG8_WAIT_L(0); PG8_BAR; PG8_MMA(1, 0, At, B0); PG8_MMA(1, 1, At, B1); PG8_BAR; PG8_SCHED;
            } else {
            PG8_LDB(B0, 0, 0); PG8_SCHED; PG8_LDA(At, 0, 0); PG8_STAGE(PG8_SA(1, 1), a1 + hstep, voffA);
            PG8_WAIT_L(8); PG8_BAR; PG8_WAIT_L(0); PG8_MMA(0, 0, At, B0); PG8_BAR; PG8_SCHED;
            PG8_LDB(B1, 0, 1); PG8_STAGE(PG8_SB(0, 0), b2, voffB);
            PG8_BAR; PG8_WAIT_L(0); PG8_MMA(0, 1, At, B1); PG8_BAR;
            PG8_LDA(At, 0, 1); PG8_STAGE(PG8_SA(0, 0), a2, voffA);
            PG8_BAR; PG8_WAIT_L(0); PG8_MMA(1, 0, At, B0); PG8_BAR; PG8_SCHED;
            PG8_STAGE(PG8_SB(0, 1), b2 + hstep, voffB);
            PG8_WAIT_V(6); PG8_BAR; PG8_MMA(1, 1, At, B1); PG8_BAR;
            PG8_LDB(B0, 1, 0); PG8_SCHED; PG8_LDA(At, 1, 0); PG8_STAGE(PG8_SA(0, 1), a2 + hstep, voffA);
            PG8_WAIT_L(8); PG8_BAR; PG8_WAIT_L(0); PG8_MMA(0, 0, At, B0); PG8_BAR; PG8_SCHED;
            PG8_LDB(B1, 1, 1); PG8_STAGE(PG8_SB(1, 0), b3, voffB);
            PG8_BAR; PG8_WAIT_L(0); PG8_MMA(0, 1, At, B1); PG8_BAR;
            PG8_LDA(At, 1, 1); PG8_STAGE(PG8_SA(1, 0), a3, voffA);
            PG8_BAR; PG8_WAIT_L(0); PG8_MMA(1, 0, At, B0); PG8_BAR; PG8_SCHED;
            PG8_STAGE(PG8_SB(1, 1), b3 + hstep, voffB);
            PG8_WAIT_V(6); PG8_BAR; PG8_MMA(1, 1, At, B1); PG8_BAR;
            }
        }
        if constexpr (HNORM) { if (!P3 || ui == 1) {
#pragma unroll
            for (int ai = 0; ai < 2; ++ai)
#pragma unroll
                for (int m = 0; m < 4; ++m) { const float f = hrt[(ai * 128 + wr * 64 + m * 16 + fr) * 4 + 3];
#pragma unroll
                    for (int bj = 0; bj < 2; ++bj)
#pragma unroll
                        for (int n = 0; n < 2; ++n) acc[ai][bj][m][n] *= f; } } }
        if constexpr (ALIGN_EPI) { if (wr == 0) PG8_BAR; }
        if constexpr (!Epi::AFTER_DRAIN) E(acc, cur, wr, wc, fr, fq);
        if (!has_next) break;
#pragma unroll
        for (int a = 0; a < 2; ++a)
#pragma unroll
            for (int b = 0; b < 2; ++b)
#pragma unroll
                for (int m = 0; m < 4; ++m)
#pragma unroll
                    for (int n = 0; n < 2; ++n) acc[a][b][m][n] = (f32x4){0.f, 0.f, 0.f, 0.f};
        cur = nxt; cA = nA; cB = nB; ++ui;
        if constexpr (ALIGN_EPI) { if (wr == 1) PG8_BAR; }
    }
    PG8_WAIT_V(0);
    if constexpr (!ALIGN_EPI) { if (wr == 0) PG8_BAR; }
    PG8_BAR;
    if constexpr (Epi::AFTER_DRAIN) E.fused(acc, cur, wr, wc, fr, fq, lds, tid);
#undef PG8_SA
#undef PG8_SB
#undef PG8_STAGE
#undef PG8_LDA
#undef PG8_LDB
#undef PG8_MMA
#undef PG8_WAIT_V
#undef PG8_WAIT_L
#undef PG8_BAR
#undef PG8_SCHED
}
}

enum { EK_IN = 0, EK_CO, EK_RO, EK_WO, EK_UP, EK_DN };

template <int KIND>
__device__ __forceinline__ void epi8(const Ctx& c, int row, int col, f32x4 v0, f32x4 v1) {
    unsigned char* act = c.ws + WS_ACT;
    if constexpr (KIND == EK_IN) {
        if (col < 1024) {
            u32x2 w; w.x = pk2(v0[0] * sigm(v0[1]), v0[2] * sigm(v0[3])); w.y = pk2(v1[0] * sigm(v1[1]), v1[2] * sigm(v1[3]));
            *(u32x2*)((bf16_t*)(act + A_U) + (size_t)row * 512 + (col >> 1)) = w;
        } else if (col < 2048) {
            const bool isk = col >= 1536; const int cc = col - (isk ? 1536 : 1024), h = cc >> 7, i0 = (cc & 127) >> 1;
            const float pos = row < MP ? (float)(row & (SEQ - 1)) : 16384.0f;
            const float sc = isk ? 0.08838834764831845f : 1.0f;
            const float* freq = (const float*)(c.ws + WS_CTL + 256);
            const f32x4 fv = *(const f32x4*)(freq + i0);
            float x1[4] = {v0[0], v0[2], v1[0], v1[2]}, x2[4] = {v0[1], v0[3], v1[1], v1[3]}, o1[4], o2[4];
#pragma unroll
            for (int p = 0; p < 4; ++p) {
                const float ang = pos * fv[p];
                const double a = (double)ang; const double n = rint(a * 0.15915494309189535);
                const float r = (float)(a - n * 6.283185307179586);
                const float sn = __sinf(r) * sc, cs = __cosf(r) * sc;
                o1[p] = x1[p] * cs - x2[p] * sn; o2[p] = x2[p] * cs + x1[p] * sn;
            }
            bf16_t* dst = (bf16_t*)(act + (isk ? A_K : A_Q)) + (size_t)row * 512 + h * 128 + i0;
            u32x2 w1, w2; w1.x = pk2(o1[0], o1[1]); w1.y = pk2(o1[2], o1[3]); w2.x = pk2(o2[0], o2[1]); w2.y = pk2(o2[2], o2[3]);
            *(u32x2*)dst = w1; *(u32x2*)(dst + 64) = w2;
        } else {
            const int seg = (col - 2048) >> 10, cc = (col - 2048) & 1023;
            float f[8] = {v0[0], v0[1], v0[2], v0[3], v1[0], v1[1], v1[2], v1[3]};
            if (seg == 1) {
#pragma unroll
                for (int j = 0; j < 8; ++j) f[j] = f[j] * sigm(f[j]);
            } else if (seg >= 2) {
#pragma unroll
                for (int j = 0; j < 8; ++j) f[j] = sigm(f[j]);
            }
            u32x4 w; w.x = pk2(f[0], f[1]); w.y = pk2(f[2], f[3]); w.z = pk2(f[4], f[5]); w.w = pk2(f[6], f[7]);
            *(u32x4*)((bf16_t*)(act + A_V + (size_t)seg * ((size_t)RT * 1024 * 2)) + (size_t)row * 1024 + cc) = w;
        }
    } else if constexpr (KIND == EK_CO) {
        u32x4* p = (u32x4*)((bf16_t*)(act + A_SA) + (size_t)row * 1024 + col); const u32x4 g = *p;
        u32x4 w; w.x = pk2(v0[0] * bflo(g.x), v0[1] * bfhi(g.x)); w.y = pk2(v0[2] * bflo(g.y), v0[3] * bfhi(g.y));
        w.z = pk2(v1[0] * bflo(g.z), v1[1] * bfhi(g.z)); w.w = pk2(v1[2] * bflo(g.w), v1[3] * bfhi(g.w));
        *p = w;
    } else if constexpr (KIND == EK_RO) {
        const u32x4 t = *(const u32x4*)((bf16_t*)(act + A_SA) + (size_t)row * 1024 + col);
        u32x4* p = (u32x4*)((bf16_t*)(act + A_SB) + (size_t)row * 1024 + col); const u32x4 g = *p;
        u32x4 w; w.x = pk2(bflo(t.x) + v0[0] * bflo(g.x), bfhi(t.x) + v0[1] * bfhi(g.x)); w.y = pk2(bflo(t.y) + v0[2] * bflo(g.y), bfhi(t.y) + v0[3] * bfhi(g.y));
        w.z = pk2(bflo(t.z) + v1[0] * bflo(g.z), bfhi(t.z) + v1[1] * bfhi(g.z)); w.w = pk2(bflo(t.w) + v1[2] * bflo(g.w), bfhi(t.w) + v1[3] * bfhi(g.w));
        *p = w;
    } else if constexpr (KIND == EK_WO) {
        u32x4 w; w.x = pk2(v0[0], v0[1]); w.y = pk2(v0[2], v0[3]); w.z = pk2(v1[0], v1[1]); w.w = pk2(v1[2], v1[3]);
        *(u32x4*)((bf16_t*)(act + A_M2) + (size_t)row * DM + col) = w;
    } else if constexpr (KIND == EK_UP) {
        float f[8] = {v0[0], v0[1], v0[2], v0[3], v1[0], v1[1], v1[2], v1[3]};
#pragma unroll
        for (int j = 0; j < 8; ++j) { const float r = fmaxf(f[j], 0.f); f[j] = r * r; }
        u32x4 w; w.x = pk2(f[0], f[1]); w.y = pk2(f[2], f[3]); w.z = pk2(f[4], f[5]); w.w = pk2(f[6], f[7]);
        *(u32x4*)((bf16_t*)(act + A_UP) + (size_t)row * FF + col) = w;
    } else {
        u32x4 w; w.x = pk2(v0[0], v0[1]); w.y = pk2(v0[2], v0[3]); w.z = pk2(v1[0], v1[1]); w.w = pk2(v1[2], v1[3]);
        *(u32x4*)((bf16_t*)(act + A_F) + (size_t)row * DM + col) = w;
    }
}

template <int KIND> struct Epi {
    static constexpr bool AFTER_DRAIN = false;
    Ctx c;
    __device__ __forceinline__ void operator()(const f32x4 (&acc)[2][2][4][2], const pg8::Unit& u, int wr, int wc, int fr, int fq) const {
#pragma unroll
        for (int ai = 0; ai < 2; ++ai)
#pragma unroll
            for (int m = 0; m < 4; ++m) {
                const int row = u.pm * 256 + ai * 128 + wr * 64 + m * 16 + fr;
#pragma unroll
                for (int bj = 0; bj < 2; ++bj) epi8<KIND>(c, row, u.pn * 256 + bj * 128 + wc * 32 + 8 * fq, acc[ai][bj][m][0], acc[ai][bj][m][1]);
            }
    }
};

__device__ __forceinline__ void row_rms_exchange(const Ctx& c, int set, const f32x4 (&v)[2][2][4][2], const pg8::Unit& u, int wr, int wc, int fr, int fq, LAS unsigned char* lds, int tid) {
    LAS float* P = (LAS float*)lds;
    LAS float* S = (LAS float*)(lds + 8192);
    unsigned* slots = (unsigned*)(c.ws + WS_XCH) + (size_t)set * 64 * 256 * 4;
    unsigned* cnt = (unsigned*)(c.ws + WS_CTL + CTL_XCNT) + (size_t)(set * 64 + u.pm) * 64;
#pragma unroll
    for (int ai = 0; ai < 2; ++ai)
#pragma unroll
        for (int m = 0; m < 4; ++m) {
            float q = 0.f;
#pragma unroll
            for (int bj = 0; bj < 2; ++bj)
#pragma unroll
                for (int n = 0; n < 2; ++n) { const f32x4 x = v[ai][bj][m][n]; q += (x[0] * x[0] + x[1] * x[1]) + (x[2] * x[2] + x[3] * x[3]); }
            q += __shfl_xor(q, 16); q += __shfl_xor(q, 32);
            if (fq == 0) P[(ai * 128 + wr * 64 + m * 16 + fr) * 4 + wc] = q;
        }
    __syncthreads();
    if (tid < 256) {
        const float t = (P[tid * 4 + 0] + P[tid * 4 + 1]) + (P[tid * 4 + 2] + P[tid * 4 + 3]);
        __hip_atomic_store(slots + ((size_t)(u.pm * 256 + tid) * 4 + u.pn), __float_as_uint(t), __ATOMIC_RELAXED, __HIP_MEMORY_SCOPE_AGENT);
    }
    asm volatile("s_waitcnt vmcnt(0)" ::: "memory");
    __syncthreads();
    if (tid == 0) {
        __hip_atomic_fetch_add(cnt, 1u, __ATOMIC_RELAXED, __HIP_MEMORY_SCOPE_AGENT);
        unsigned sp = 0;
        while (__hip_atomic_load(cnt, __ATOMIC_RELAXED, __HIP_MEMORY_SCOPE_AGENT) < 4u) { __builtin_amdgcn_s_sleep(1); if (++sp > (1u << 22)) break; }
        __builtin_amdgcn_fence(__ATOMIC_ACQUIRE, "agent");
        asm volatile("s_waitcnt vmcnt(0)" ::: "memory");
    }
    __syncthreads();
    if (tid < 256) {
        const unsigned* sl = slots + (size_t)(u.pm * 256 + tid) * 4;
        float t = 0.f;
#pragma unroll
        for (int k = 0; k < 4; ++k) t += __uint_as_float(__hip_atomic_load(sl + k, __ATOMIC_RELAXED, __HIP_MEMORY_SCOPE_AGENT));
        S[tid] = 1.0f / sqrtf(t * (1.0f / DM) + EPS);
    }
    __syncthreads();
}
struct EpiWoFused {
    static constexpr bool AFTER_DRAIN = true;
    Ctx c;
    __device__ __forceinline__ void fused(f32x4 (&acc)[2][2][4][2], const pg8::Unit& u, int wr, int wc, int fr, int fq, LAS unsigned char* lds, int tid) const {
        row_rms_exchange(c, 1, acc, u, wr, wc, fr, fq, lds, tid);
        const LAS float* S = (const LAS float*)(lds + 8192);
        bf16_t* MB = (bf16_t*)(c.ws + WS_ACT + A_M2); bf16_t* HN = (bf16_t*)(c.ws + WS_ACT + A_HN);
#pragma unroll
        for (int bj = 0; bj < 2; ++bj) {
            const int col = u.pn * 256 + bj * 128 + wc * 32 + 8 * fq;
            const f32x4 g0 = *(const f32x4*)(c.n_mix_post + col), g1 = *(const f32x4*)(c.n_mix_post + col + 4);
#pragma unroll
            for (int ai = 0; ai < 2; ++ai)
#pragma unroll
                for (int m = 0; m < 4; ++m) { const int rl = ai * 128 + wr * 64 + m * 16 + fr; const float rs = S[rl]; const size_t ro = (size_t)(u.pm * 256 + rl) * DM + col;
                    const f32x4 x0 = __builtin_nontemporal_load((const f32x4*)(c.xp + ro)), x1 = __builtin_nontemporal_load((const f32x4*)(c.xp + ro + 4));
                    const f32x4 h0 = x0 + acc[ai][bj][m][0] * rs * g0, h1 = x1 + acc[ai][bj][m][1] * rs * g1;
                    acc[ai][bj][m][0] = h0; acc[ai][bj][m][1] = h1;
                    u32x4 w; w.x = pk2(h0[0], h0[1]); w.y = pk2(h0[2], h0[3]); w.z = pk2(h1[0], h1[1]); w.w = pk2(h1[2], h1[3]);
                    *(u32x4*)(MB + ro) = w; }
        }
        row_rms_exchange(c, 2, acc, u, wr, wc, fr, fq, lds, tid);
#pragma unroll
        for (int bj = 0; bj < 2; ++bj) {
            const int col = u.pn * 256 + bj * 128 + wc * 32 + 8 * fq;
            const f32x4 g0 = *(const f32x4*)(c.n_ffn_pre + col), g1 = *(const f32x4*)(c.n_ffn_pre + col + 4);
#pragma unroll
            for (int ai = 0; ai < 2; ++ai)
#pragma unroll
                for (int m = 0; m < 4; ++m) { const int rl = ai * 128 + wr * 64 + m * 16 + fr; const float rs = S[rl]; const size_t ro = (size_t)(u.pm * 256 + rl) * DM + col;
                    const f32x4 a = acc[ai][bj][m][0] * rs * g0, b = acc[ai][bj][m][1] * rs * g1;
                    u32x4 w; w.x = pk2(a[0], a[1]); w.y = pk2(a[2], a[3]); w.z = pk2(b[0], b[1]); w.w = pk2(b[2], b[3]);
                    *(u32x4*)(HN + ro) = w; }
        }
    }
};

__device__ __forceinline__ float small_rms_exchange(const Ctx& c, int set, int mt, int ng, int lane, const f32x4& s0, const f32x4& s1) {
    const int fr = lane & 15, fq = lane >> 4;
    unsigned* slots = (unsigned*)(c.ws + WS_XCHS) + (size_t)((set * 8 + mt) * 16) * 32;
    unsigned* cnt = (unsigned*)(c.ws + WS_CTL + CTL_XCNTS) + (size_t)(set * 8 + mt) * 64;
    float q = ((s0[0] * s0[0] + s0[1] * s0[1]) + (s0[2] * s0[2] + s0[3] * s0[3])) + ((s1[0] * s1[0] + s1[1] * s1[1]) + (s1[2] * s1[2] + s1[3] * s1[3]));
    q += __shfl_xor(q, 16); q += __shfl_xor(q, 32);
    if (fq == 0) __hip_atomic_store(slots + fr * 32 + ng, __float_as_uint(q), __ATOMIC_RELAXED, __HIP_MEMORY_SCOPE_AGENT);
    asm volatile("s_waitcnt vmcnt(0)" ::: "memory");
    if (lane == 0) {
        __hip_atomic_fetch_add(cnt, 1u, __ATOMIC_RELAXED, __HIP_MEMORY_SCOPE_AGENT);
        unsigned sp = 0;
        while (__hip_atomic_load(cnt, __ATOMIC_RELAXED, __HIP_MEMORY_SCOPE_AGENT) < 32u) { __builtin_amdgcn_s_sleep(1); if (++sp > (1u << 22)) break; }
    }
    __builtin_amdgcn_fence(__ATOMIC_ACQUIRE, "agent");
    asm volatile("s_waitcnt vmcnt(0)" ::: "memory");
    float t = 0.f;
#pragma unroll
    for (int k = 0; k < 8; ++k) t += __uint_as_float(__hip_atomic_load(slots + fr * 32 + fq * 8 + k, __ATOMIC_RELAXED, __HIP_MEMORY_SCOPE_AGENT));
    t += __shfl_xor(t, 16); t += __shfl_xor(t, 32);
    return 1.0f / sqrtf(t * (1.0f / DM) + EPS);
}
template <int KIND>
__device__ __forceinline__ void small_fused(const Ctx& c, int mt, int ng, int lane, f32x4 s0, f32x4 s1) {
    const int fr = lane & 15, fq = lane >> 4, col = ng * 32 + 8 * fq;
    const size_t ro = (size_t)(MP + mt * 16 + fr) * DM + col;
    bf16_t* MB = (bf16_t*)(c.ws + WS_ACT + A_M2);
    if constexpr (KIND == EK_WO) {
        const float rs = small_rms_exchange(c, 0, mt, ng, lane, s0, s1);
        const float* xr = c.xs + (size_t)(mt * 16 + fr) * DM + col;
        const f32x4 g0 = *(const f32x4*)(c.n_mix_post + col), g1 = *(const f32x4*)(c.n_mix_post + col + 4);
        const f32x4 h0 = *(const f32x4*)xr + s0 * rs * g0, h1 = *(const f32x4*)(xr + 4) + s1 * rs * g1;
        u32x4 w; w.x = pk2(h0[0], h0[1]); w.y = pk2(h0[2], h0[3]); w.z = pk2(h1[0], h1[1]); w.w = pk2(h1[2], h1[3]);
        *(u32x4*)(MB + ro) = w;
        const float rs2 = small_rms_exchange(c, 1, mt, ng, lane, h0, h1);
        const f32x4 p0 = *(const f32x4*)(c.n_ffn_pre + col), p1 = *(const f32x4*)(c.n_ffn_pre + col + 4);
        const f32x4 a = h0 * rs2 * p0, b = h1 * rs2 * p1;
        u32x4 v; v.x = pk2(a[0], a[1]); v.y = pk2(a[2], a[3]); v.z = pk2(b[0], b[1]); v.w = pk2(b[2], b[3]);
        *(u32x4*)((bf16_t*)(c.ws + WS_ACT + A_HN) + ro) = v;
    } else {
        const float rs = small_rms_exchange(c, 2, mt, ng, lane, s0, s1);
        const u32x4 hw = *(const u32x4*)(MB + ro);
        const f32x4 h0 = {bflo(hw.x), bfhi(hw.x), bflo(hw.y), bfhi(hw.y)}, h1 = {bflo(hw.z), bfhi(hw.z), bflo(hw.w), bfhi(hw.w)};
        const f32x4 g0 = *(const f32x4*)(c.n_ffn_post + col), g1 = *(const f32x4*)(c.n_ffn_post + col + 4);
        float* p = c.out + ro;
        *(f32x4*)p = h0 + s0 * rs * g0; *(f32x4*)(p + 4) = h1 + s1 * rs * g1;
    }
}

struct EpiDnFused {
    static constexpr bool AFTER_DRAIN = true;
    Ctx c;
    __device__ __forceinline__ void fused(const f32x4 (&acc)[2][2][4][2], const pg8::Unit& u, int wr, int wc, int fr, int fq, LAS unsigned char* lds, int tid) const {
        row_rms_exchange(c, 0, acc, u, wr, wc, fr, fq, lds, tid);
        const LAS float* S = (const LAS float*)(lds + 8192);
#pragma unroll
        for (int bj = 0; bj < 2; ++bj) {
            const int col = u.pn * 256 + bj * 128 + wc * 32 + 8 * fq;
            const f32x4 g0 = *(const f32x4*)(c.n_ffn_post + col), g1 = *(const f32x4*)(c.n_ffn_post + col + 4);
#pragma unroll
            for (int ai = 0; ai < 2; ++ai)
#pragma unroll
                for (int m = 0; m < 4; ++m) { const int rl = ai * 128 + wr * 64 + m * 16 + fr; const float rs = S[rl];
                    float* p = c.out + (size_t)(u.pm * 256 + rl) * DM + col;
                    const u32x4 hw = __builtin_nontemporal_load((const u32x4*)((const bf16_t*)(c.ws + WS_ACT + A_M2) + (size_t)(u.pm * 256 + rl) * DM + col));
                    const f32x4 h0 = {bflo(hw.x), bfhi(hw.x), bflo(hw.y), bfhi(hw.y)}, h1 = {bflo(hw.z), bfhi(hw.z), bflo(hw.w), bfhi(hw.w)};
                    __builtin_nontemporal_store(h0 + acc[ai][bj][m][0] * rs * g0, (f32x4*)p); __builtin_nontemporal_store(h1 + acc[ai][bj][m][1] * rs * g1, (f32x4*)(p + 4)); }
        }
    }
};

struct EpiP3 {
    static constexpr bool AFTER_DRAIN = false;
    Ctx c;
    __device__ __forceinline__ void operator()(const f32x4 (&acc)[2][2][4][2], const pg8::Unit& u, int wr, int wc, int fr, int fq) const {
        if (u.sel == 0) { Epi<EK_CO> e{c}; e(acc, u, wr, wc, fr, fq); } else { Epi<EK_RO> e{c}; e(acc, u, wr, wc, fr, fq); }
    }
};

template <int KIND, int N, int K, int NI, class BigEpi = Epi<KIND>, bool ALIGN = false, bool HNORM = false, bool DO_BIG = true, bool DO_SMALL = true, int LDA = K, int LDB = K, bool P3 = false>
__device__ __forceinline__ void gemm_all(const Ctx& c, LAS unsigned char* lds, const bf16_t* A, const bf16_t* Bt, const bf16_t* A2 = nullptr, const bf16_t* Bt2 = nullptr) {
    {
    if constexpr (DO_BIG) {
    pg8::StaticOrder S; S.init(MP, N, gridDim.x, blockIdx.x);
    BigEpi E{c};
    pg8::Gemm g{A, Bt, MP, N, K, (const float*)(c.ws + WS_SSQ), A2, Bt2, CD / 64};
    pg8::gemm_phase<BigEpi, ALIGN, true, HNORM, P3>(lds, g, S, E);
    __syncthreads();
    }
    if constexpr (DO_SMALL) {
    const int tid = otid(), wid = __builtin_amdgcn_readfirstlane(tid >> 6), lane = tid & 63, fr = lane & 15, fq = lane >> 4;
    LAS f32x4* red = (LAS f32x4*)lds;
    constexpr int nitems = 8 * (N / 32), kw = K / 8, KS = kw / 32, KB = KS > 4 ? 4 : KS;
    const unsigned toff = (unsigned)((fr * LDA + wid * kw + 8 * fq) * 2);
    const unsigned tb0 = (unsigned)((pg8::perm32(fr) * LDB + wid * kw + 8 * fq) * 2), tb1 = (unsigned)((pg8::perm32(16 + fr) * LDB + wid * kw + 8 * fq) * 2);
    for (int base = blockIdx.x * NI; base < nitems; base += gridDim.x * NI) {
        f32x4 a0[NI], a1[NI];
#pragma unroll
        for (int q = 0; q < NI; ++q) { a0[q] = (f32x4){0.f, 0.f, 0.f, 0.f}; a1[q] = (f32x4){0.f, 0.f, 0.f, 0.f}; }
#pragma unroll 1
        for (int k0 = 0; k0 < KS; k0 += KB) {
            bf16x8 af[NI][KB], b0[NI][KB], b1[NI][KB];
#pragma unroll
            for (int q = 0; q < NI; ++q) { const int item = base + q, mt = item & 7, ng = item >> 3;
                const char* ap = (const char*)(A + (size_t)(MP + mt * 16) * LDA) + (size_t)k0 * 64; const char* bp = (const char*)(Bt + (size_t)(ng * 32) * LDB) + (size_t)k0 * 64;
#pragma unroll
                for (int ks = 0; ks < KB; ++ks) { af[q][ks] = *(const bf16x8*)(ap + ks * 64 + toff); b0[q][ks] = *(const bf16x8*)(bp + ks * 64 + tb0); b1[q][ks] = *(const bf16x8*)(bp + ks * 64 + tb1); } }
#pragma unroll
            for (int q = 0; q < NI; ++q)
#pragma unroll
                for (int ks = 0; ks < KB; ++ks) { a0[q] = __builtin_amdgcn_mfma_f32_16x16x32_bf16(b0[q][ks], af[q][ks], a0[q], 0, 0, 0); a1[q] = __builtin_amdgcn_mfma_f32_16x16x32_bf16(b1[q][ks], af[q][ks], a1[q], 0, 0, 0); }
        }
#pragma unroll
        for (int q = 0; q < NI; ++q) { red[((q * 8 + wid) * 2 + 0) * 64 + lane] = a0[q]; red[((q * 8 + wid) * 2 + 1) * 64 + lane] = a1[q]; }
        __syncthreads();
        if (wid < NI && base + wid < nitems) {
            f32x4 s0 = red[((wid * 8) * 2 + 0) * 64 + lane], s1 = red[((wid * 8) * 2 + 1) * 64 + lane];
#pragma unroll
            for (int w = 1; w < 8; ++w) { s0 += red[((wid * 8 + w) * 2 + 0) * 64 + lane]; s1 += red[((wid * 8 + w) * 2 + 1) * 64 + lane]; }
            const int item = base + wid, mt = item & 7, ng = item >> 3;
            if constexpr (KIND == EK_WO || KIND == EK_DN) small_fused<KIND>(c, mt, ng, lane, s0, s1);
            else epi8<KIND>(c, MP + mt * 16 + fr, ng * 32 + 8 * fq, s0, s1);
        }
        __syncthreads();
    }
    }
    }
}

__device__ __forceinline__ int map_in(int n) {
    if (n < 512) return 2 * n;
    if (n < 1024) return 2 * (n - 512) + 1;
    if (n < 2048) { const int base = n < 1536 ? 1024 : 1536, cc = n - base, h = cc >> 7, d = cc & 127; return base + h * 128 + 2 * (d & 63) + (d >> 6); }
    return n;
}
struct WItem { const float* W; bf16_t* WT; int K, N, r; bool mapin; int ld; };
__device__ __forceinline__ void wt_load(const WItem& w, int lane, f32x4 (&v)[8]) {
    const int nblk = w.N / 32, kb = w.r / nblk, nb = w.r % nblk, k0 = 64 * kb, n0 = 32 * nb, kr = lane >> 3, seg = lane & 7;
    const float* wp = w.W + (size_t)(k0 + kr) * w.N + n0 + seg * 4;
#pragma unroll
    for (int i = 0; i < 8; ++i) v[i] = __builtin_nontemporal_load((const f32x4*)(wp + (size_t)(8 * i) * w.N));
}
__device__ __forceinline__ void wt_finish(const WItem& w, int lane, const f32x4 (&v)[8], LAS float* scr) {
    const int nblk = w.N / 32, kb = w.r / nblk, nb = w.r % nblk, k0 = 64 * kb, n0 = 32 * nb, kr = lane >> 3, seg = lane & 7;
#pragma unroll
    for (int i = 0; i < 8; ++i) { LAS float* d = scr + (8 * i + kr) * 33 + seg * 4; d[0] = v[i][0]; d[1] = v[i][1]; d[2] = v[i][2]; d[3] = v[i][3]; }
    LDS_WAIT();
    const int ch = lane & 7;
#pragma unroll
    for (int j = 0; j < 4; ++j) { const int n = (lane >> 3) + 8 * j; const LAS float* s = scr + (8 * ch) * 33 + n;
        u32x4 o; o.x = pk2(s[0 * 33], s[1 * 33]); o.y = pk2(s[2 * 33], s[3 * 33]); o.z = pk2(s[4 * 33], s[5 * 33]); o.w = pk2(s[6 * 33], s[7 * 33]);
        const int dn = w.mapin ? map_in(n0 + n) : (n0 + n);
        *(u32x4*)(w.WT + (size_t)dn * w.ld + k0 + 8 * ch) = o; }
    LDS_WAIT();
}
constexpr int WI_IN = (DM / 64) * (NIN / 32);
constexpr int WI_CO = (CD / 64) * (DM / 32), WI_RO = (DM / 64) * (DM / 32), WI_O = WI_RO, WI_UP = (DM / 64) * (FF / 32), WI_DN = (FF / 64) * (DM / 32);
constexpr int WI_TOTAL = WI_IN + WI_CO + WI_RO + WI_O + WI_UP + WI_DN;

__device__ __forceinline__ void wt_pair(const Ctx& c, int p, int lane, LAS float* scr) {
    int r = 2 * p; WItem w;
    if (r < WI_IN) { w.W = c.w_in; w.WT = (bf16_t*)(c.ws + WS_WIN); w.K = DM; w.N = NIN; w.mapin = true; w.ld = DM; }
    else if ((r -= WI_IN) < WI_CO) { w.W = c.w_co; w.WT = (bf16_t*)(c.ws + WS_WCO2); w.K = CD; w.N = DM; w.mapin = false; w.ld = DM; }
    else if ((r -= WI_CO) < WI_RO) { w.W = c.w_ro; w.WT = (bf16_t*)(c.ws + WS_WRO); w.K = DM; w.N = DM; w.mapin = false; w.ld = DM; }
    else if ((r -= WI_RO) < WI_O) { w.W = c.w_o; w.WT = (bf16_t*)(c.ws + WS_WO); w.K = DM; w.N = DM; w.mapin = false; w.ld = DM; }
    else if ((r -= WI_O) < WI_UP) { w.W = c.w_up; w.WT = (bf16_t*)(c.ws + WS_WUP); w.K = DM; w.N = FF; w.mapin = false; w.ld = DM; }
    else { r -= WI_UP; w.W = c.w_dn; w.WT = (bf16_t*)(c.ws + WS_WDN); w.K = FF; w.N = DM; w.mapin = false; w.ld = FF; }
    WItem w1 = w; w.r = r; w1.r = r + 1;
    f32x4 va[8], vb[8];
    wt_load(w, lane, va); wt_load(w1, lane, vb);
    wt_finish(w, lane, va, scr); wt_finish(w1, lane, vb, scr);
}
__device__ __forceinline__ void rms_rows4_to_bf16(const Ctx& c, int row0, int stride, const float* w, bf16_t* XN, int lane) {
    f32x4 v[4][4];
#pragma unroll
    for (int r = 0; r < 4; ++r) { const int row = row0 + r * stride;
        if (row < RT) { const float* x = xrow(c, row);
#pragma unroll
            for (int j = 0; j < 4; ++j) v[r][j] = __builtin_nontemporal_load((const f32x4*)x + 64 * j + lane); } }
#pragma unroll
    for (int r = 0; r < 4; ++r) { const int row = row0 + r * stride;
        if (row < RT) { float s = 0.f;
#pragma unroll
            for (int j = 0; j < 4; ++j) s += (v[r][j].x * v[r][j].x + v[r][j].y * v[r][j].y) + (v[r][j].z * v[r][j].z + v[r][j].w * v[r][j].w);
            const float rs = 1.0f / sqrtf(wave_sum(s) * (1.0f / DM) + EPS);
#pragma unroll
            for (int j = 0; j < 4; ++j) { const f32x4 g = *((const f32x4*)w + 64 * j + lane);
                u32x2 p; p.x = pk2(v[r][j].x * rs * g.x, v[r][j].y * rs * g.y); p.y = pk2(v[r][j].z * rs * g.z, v[r][j].w * rs * g.w);
                *((u32x2*)(XN + (size_t)row * DM) + 64 * j + lane) = p; } } }
}
__device__ __forceinline__ void phase0(const Ctx& c, LAS unsigned char* lds) {
    const int tid = otid(), wid = __builtin_amdgcn_readfirstlane(tid >> 6), lane = tid & 63;
    if (blockIdx.x == 0 && tid < 64) {
        const float xi = (float)tid / 63.0f;
        const float p = (float)exp((double)xi * 9.210340371976184);
        ((float*)(c.ws + WS_CTL + 256))[tid] = 1.0f / p;
    }
    LAS float* scr = (LAS float*)(lds + wid * 16384);
    const int gw = blockIdx.x * 8 + wid, NGW = gridDim.x * 8;
    bf16_t* XN = (bf16_t*)c.out;
    for (int row = gw; row < RT; row += 4 * NGW) rms_rows4_to_bf16(c, row, NGW, c.n_mix_pre, XN, lane);
    for (int p = gw; p < WI_IN / 2; p += NGW) wt_pair(c, p, lane, scr);
}

__device__ __forceinline__ void ret_prompt_item(const Ctx& c, LAS unsigned char* lds, int item) {
    const int tid = otid(), wid = __builtin_amdgcn_readfirstlane(tid >> 6), lane = tid & 63, fr = lane & 15, fq = lane >> 4;
    const int s = item & 3, h = (item >> 2) & 3, b = item >> 4;
    const float l2g = log2f(1.0f - exp2f(-5.0f - (float)h));
    unsigned char* act = c.ws + WS_ACT;
    const bf16_t* Q = (const bf16_t*)(act + A_Q); const bf16_t* Kg = (const bf16_t*)(act + A_K); const bf16_t* V = (const bf16_t*)(act + A_V); bf16_t* OB = (bf16_t*)c.out;
    float* SSQ = (float*)(c.ws + WS_SSQ);
    constexpr int LD = 136;
    LAS bf16_t* sQ = (LAS bf16_t*)lds; LAS bf16_t* sK = sQ + 128 * LD; LAS bf16_t* sKT = sK + 128 * LD; LAS bf16_t* sVT = sKT + 128 * LD; LAS bf16_t* sST = sVT + 64 * LD;
    for (int i = tid; i < 64 * LD / 2; i += 512) ((LAS unsigned*)sST)[i] = 0u;
    f32x4 Sacc[4];
#pragma unroll
    for (int e = 0; e < 4; ++e) Sacc[e] = (f32x4){0.f, 0.f, 0.f, 0.f};
    const float gC = exp2f(128.0f * l2g);
    const int il = 16 * wid + fr;
    u32x4 rq[4], rk[4]; unsigned kv[16], vv[8]; u32x2 sgv[4], sgc[4];
    const bf16_t* SGp = (const bf16_t*)(act + A_SG);
    const int dp = tid & 63, ep = tid & 31, jgv = tid >> 5;
    const int jgk = wid;
    const unsigned toq = (unsigned)(((tid >> 4) * 512 + (tid & 15) * 8) * 2);
    const unsigned tok = (unsigned)(2 * dp * 2);
    const unsigned tov = (unsigned)(((jgv * 8) * 1024 + 2 * ep) * 2);
    const unsigned tosg = (unsigned)((il * 1024 + 4 * fq) * 2);
#define RET_LOAD(CH) do { const size_t r0_ = (size_t)b * SEQ + (size_t)(CH) * 128; \
        const char* qb_ = (const char*)(Q + r0_ * 512 + h * 128); const char* kb_ = (const char*)(Kg + r0_ * 512 + h * 128); \
        const char* kt_ = (const char*)(Kg + (r0_ + jgk * 16) * 512 + h * 128); const char* vb_ = (const char*)(V + r0_ * 1024 + h * 256 + s * 64); \
        _Pragma("unroll") for (int i = 0; i < 4; ++i) { rq[i] = *(const u32x4*)(qb_ + (size_t)i * 32768 + toq); rk[i] = *(const u32x4*)(kb_ + (size_t)i * 32768 + toq); } \
        _Pragma("unroll") for (int jj = 0; jj < 16; ++jj) kv[jj] = *(const unsigned*)(kt_ + (size_t)jj * 1024 + tok); \
        _Pragma("unroll") for (int jj = 0; jj < 8; ++jj) vv[jj] = *(const unsigned*)(vb_ + (size_t)jj * 2048 + tov); \
        const char* sg_ = (const char*)(SGp + r0_ * 1024 + h * 256 + s * 64); \
        _Pragma("unroll") for (int et = 0; et < 4; ++et) sgv[et] = *(const u32x2*)(sg_ + (size_t)et * 32 + tosg); } while (0)
    RET_LOAD(0);
    for (int ch = 0; ch < SEQ / 128; ++ch) {
        const size_t r0 = (size_t)b * SEQ + (size_t)ch * 128;
#pragma unroll
        for (int i = 0; i < 4; ++i) { const int id = tid + 512 * i, row = id >> 4, cq = id & 15;
            *(LAS u32x4*)(sQ + row * LD + cq * 8) = rq[i]; *(LAS u32x4*)(sK + row * LD + cq * 8) = rk[i]; }
        {
            unsigned lo[8], hi[8];
#pragma unroll
            for (int jj = 0; jj < 16; jj += 2) {
                const float d0 = exp2f((float)(127 - (jgk * 16 + jj)) * l2g), d1 = exp2f((float)(127 - (jgk * 16 + jj + 1)) * l2g);
                lo[jj >> 1] = pk2(bflo(kv[jj]) * d0, bflo(kv[jj + 1]) * d1); hi[jj >> 1] = pk2(bfhi(kv[jj]) * d0, bfhi(kv[jj + 1]) * d1);
            }
            LAS u32x4* p0 = (LAS u32x4*)(sKT + (2 * dp) * LD + jgk * 16); LAS u32x4* p1 = (LAS u32x4*)(sKT + (2 * dp + 1) * LD + jgk * 16);
            p0[0] = (u32x4){lo[0], lo[1], lo[2], lo[3]}; p0[1] = (u32x4){lo[4], lo[5], lo[6], lo[7]};
            p1[0] = (u32x4){hi[0], hi[1], hi[2], hi[3]}; p1[1] = (u32x4){hi[4], hi[5], hi[6], hi[7]};
        }
        {
            u32x4 lo, hi;
            lo.x = (vv[0] & 0xffffu) | (vv[1] << 16); lo.y = (vv[2] & 0xffffu) | (vv[3] << 16); lo.z = (vv[4] & 0xffffu) | (vv[5] << 16); lo.w = (vv[6] & 0xffffu) | (vv[7] << 16);
            hi.x = (vv[0] >> 16) | (vv[1] & 0xffff0000u); hi.y = (vv[2] >> 16) | (vv[3] & 0xffff0000u); hi.z = (vv[4] >> 16) | (vv[5] & 0xffff0000u); hi.w = (vv[6] >> 16) | (vv[7] & 0xffff0000u);
            *(LAS u32x4*)(sVT + (2 * ep) * LD + jgv * 8) = lo; *(LAS u32x4*)(sVT + (2 * ep + 1) * LD + jgv * 8) = hi;
        }
#pragma unroll
        for (int et = 0; et < 4; ++et) sgc[et] = sgv[et];
        if (ch + 1 < SEQ / 128) RET_LOAD(ch + 1);
        __syncthreads();
        bf16x8 qf[4];
#pragma unroll
        for (int ks = 0; ks < 4; ++ks) qf[ks] = *(const LAS bf16x8*)(sQ + il * LD + ks * 32 + fq * 8);
        f32x4 sc[8];
#pragma unroll
        for (int jp = 0; jp < 8; jp += 2) {
            bf16x8 kf[2][4];
#pragma unroll
            for (int t = 0; t < 2; ++t)
#pragma unroll
                for (int ks = 0; ks < 4; ++ks) kf[t][ks] = *(const LAS bf16x8*)(sK + ((jp + t) * 16 + fr) * LD + ks * 32 + fq * 8);
#pragma unroll
            for (int t = 0; t < 2; ++t) { sc[jp + t] = (f32x4){0.f, 0.f, 0.f, 0.f};
#pragma unroll
                for (int ks = 0; ks < 4; ++ks) sc[jp + t] = __builtin_amdgcn_mfma_f32_16x16x32_bf16(kf[t][ks], qf[ks], sc[jp + t], 0, 0, 0); }
        }
        __syncthreads();
#pragma unroll
        for (int jt = 0; jt < 8; ++jt) { float pv[4];
#pragma unroll
            for (int jj = 0; jj < 4; ++jj) { const int df = il - (jt * 16 + 4 * fq + jj); pv[jj] = df >= 0 ? sc[jt][jj] * exp2f((float)df * l2g) : 0.f; }
            u32x2 w; w.x = pk2(pv[0], pv[1]); w.y = pk2(pv[2], pv[3]);
            *(LAS u32x2*)(sK + il * LD + jt * 16 + 4 * fq) = w; }
        LDS_WAIT(); __builtin_amdgcn_wave_barrier();
        f32x4 o[4];
#pragma unroll
        for (int ep2 = 0; ep2 < 4; ep2 += 2) {
            bf16x8 sf[2][4];
#pragma unroll
            for (int t = 0; t < 2; ++t)
#pragma unroll
                for (int ks = 0; ks < 4; ++ks) sf[t][ks] = *(const LAS bf16x8*)(sST + ((ep2 + t) * 16 + fr) * LD + ks * 32 + fq * 8);
#pragma unroll
            for (int t = 0; t < 2; ++t) { o[ep2 + t] = (f32x4){0.f, 0.f, 0.f, 0.f};
#pragma unroll
                for (int ks = 0; ks < 4; ++ks) o[ep2 + t] = __builtin_amdgcn_mfma_f32_16x16x32_bf16(sf[t][ks], qf[ks], o[ep2 + t], 0, 0, 0); }
        }
        const float qd = exp2f((float)(il + 1) * l2g);
#pragma unroll
        for (int et = 0; et < 4; ++et) { o[et] *= qd; Sacc[et] *= gC; }
#pragma unroll
        for (int k2 = 0; k2 < 4; k2 += 2) {
            bf16x8 pf[2], kf[2], vf[2][4];
#pragma unroll
            for (int t = 0; t < 2; ++t) { const int ks = k2 + t;
                pf[t] = *(const LAS bf16x8*)(sK + il * LD + ks * 32 + fq * 8); kf[t] = *(const LAS bf16x8*)(sKT + il * LD + ks * 32 + fq * 8);
#pragma unroll
                for (int et = 0; et < 4; ++et) vf[t][et] = *(const LAS bf16x8*)(sVT + (et * 16 + fr) * LD + ks * 32 + fq * 8); }
#pragma unroll
            for (int t = 0; t < 2; ++t)
#pragma unroll
                for (int et = 0; et < 4; ++et) { o[et] = __builtin_amdgcn_mfma_f32_16x16x32_bf16(vf[t][et], pf[t], o[et], 0, 0, 0);
                    Sacc[et] = __builtin_amdgcn_mfma_f32_16x16x32_bf16(kf[t], vf[t][et], Sacc[et], 0, 0, 0); }
        }
        float ss = 0.f;
#pragma unroll
        for (int et = 0; et < 4; ++et) { ss += (o[et][0] * o[et][0] + o[et][1] * o[et][1]) + (o[et][2] * o[et][2] + o[et][3] * o[et][3]);
            u32x2 w; w.x = pk2(o[et][0] * bflo(sgc[et].x), o[et][1] * bfhi(sgc[et].x)); w.y = pk2(o[et][2] * bflo(sgc[et].y), o[et][3] * bfhi(sgc[et].y));
            *(u32x2*)(OB + (r0 + il) * 1024 + h * 256 + s * 64 + et * 16 + 4 * fq) = w; }
        ss += __shfl_xor(ss, 16); ss += __shfl_xor(ss, 32);
        if (fq == 0) SSQ[(r0 + il) * 16 + h * 4 + s] = ss;
        __syncthreads();
#pragma unroll
        for (int et = 0; et < 4; ++et) { u32x2 w; w.x = pk2(Sacc[et][0], Sacc[et][1]); w.y = pk2(Sacc[et][2], Sacc[et][3]);
            *(LAS u32x2*)(sST + (et * 16 + fr) * LD + 16 * wid + 4 * fq) = w; }
    }
    float* nrp = c.out + O_NRP + ((size_t)(b * NH + h) * DK) * DV + s * 64;
#pragma unroll
    for (int et = 0; et < 4; ++et)
#pragma unroll
        for (int jj = 0; jj < 4; ++jj) nrp[(size_t)(16 * wid + 4 * fq + jj) * DV + et * 16 + fr] = Sacc[et][jj];
    __syncthreads();
#undef RET_LOAD
}

__device__ __forceinline__ float block_sum(float v, LAS float* red, int tid) {
    v = wave_sum(v);
    __syncthreads();
    if ((tid & 63) == 0) red[tid >> 6] = v;
    __syncthreads();
    float t = 0.f;
#pragma unroll
    for (int w = 0; w < 8; ++w) t += red[w];
    return t;
}

__device__ __forceinline__ void ret_sample_item(const Ctx& c, LAS unsigned char* lds, int item) {
    const int tid = otid(), b = item >> 2, h = item & 3, row = MP + b;
    unsigned char* act = c.ws + WS_ACT;
    const bf16_t* Q = (const bf16_t*)(act + A_Q) + (size_t)row * 512 + h * 128; const bf16_t* Kg = (const bf16_t*)(act + A_K) + (size_t)row * 512 + h * 128;
    const bf16_t* V = (const bf16_t*)(act + A_V) + (size_t)row * 1024 + h * 256; bf16_t* OB = (bf16_t*)c.out + (size_t)row * 1024 + h * 256;
    LAS float* sq = (LAS float*)lds; LAS float* sk = sq + 128; LAS float* red = sk + 128; LAS float* part = red + 16;
    if (tid < 128) sq[tid] = bf2f(Q[tid]); else if (tid < 256) sk[tid - 128] = bf2f(Kg[tid - 128]);
    __syncthreads();
    const float g = 1.0f - exp2f(-5.0f - (float)h);
    const int e4 = (tid & 63) * 4, dg = tid >> 6;
    const u32x2 vw = *(const u32x2*)(V + e4);
    const f32x4 vv = {bflo(vw.x), bfhi(vw.x), bflo(vw.y), bfhi(vw.y)};
    const float* Sin = c.state_ret + ((size_t)(b * NH + h) * DK + dg * 16) * DV + e4;
    float* Sout = c.out + O_NRS + ((size_t)(b * NH + h) * DK + dg * 16) * DV + e4;
    f32x4 oa = {0.f, 0.f, 0.f, 0.f};
    f32x4 sv[16];
#pragma unroll
    for (int dd = 0; dd < 16; ++dd) sv[dd] = __builtin_nontemporal_load((const f32x4*)(Sin + (size_t)dd * DV));
#pragma unroll
    for (int dd = 0; dd < 16; ++dd) { const float kd = sk[dg * 16 + dd], qd = sq[dg * 16 + dd];
        const f32x4 sn = sv[dd] * g + vv * kd; __builtin_nontemporal_store(sn, (f32x4*)(Sout + (size_t)dd * DV)); oa += sn * qd; }
    *(LAS f32x4*)(part + dg * 256 + e4) = oa;
    __syncthreads();
    float ov = 0.f;
    if (tid < 256) {
#pragma unroll
        for (int w = 0; w < 8; ++w) ov += part[w * 256 + tid];
    }
    const float tot = block_sum(ov * ov, red, tid);
    const float rs = 1.0f / sqrtf(tot * (1.0f / DV) + EPS);
    if (tid < 256) OB[tid] = (bf16_t)(pk2(bf2f(((const bf16_t*)(act + A_SG))[(size_t)row * 1024 + h * 256 + tid]) * ov * rs, 0.f) & 0xffffu);
    __syncthreads();
}

__device__ __forceinline__ void conv_prompt_item(const Ctx& c, LAS unsigned char* lds, int item) {
    const int tid = otid(), wid = tid >> 6, lane = tid & 63, b = item >> 6, t0 = (item & 63) * 32;
    unsigned char* act = c.ws + WS_ACT;
    const bf16_t* U = (const bf16_t*)(act + A_U) + (size_t)b * SEQ * 512; bf16_t* AA = (bf16_t*)c.out + AA_OFF + (size_t)b * SEQ * 1024;
    LAS bf16_t* sU = (LAS bf16_t*)lds; LAS float* sC = (LAS float*)(lds + 63488);
    {
        u32x4 uv[8];
#pragma unroll
        for (int i = 0; i < 8; ++i) { const int id = tid + 512 * i, lr = id >> 6, cq = id & 63, t = t0 - 30 + lr;
            uv[i] = (u32x4){0u, 0u, 0u, 0u}; if (t >= 0 && lr < 62) uv[i] = __builtin_nontemporal_load((const u32x4*)(U + (size_t)t * 512 + cq * 8)); }
#pragma unroll
        for (int i = 0; i < 8; ++i) { const int id = tid + 512 * i, lr = id >> 6, cq = id & 63;
            if (lr < 62) *(LAS u32x4*)(sU + lr * 512 + cq * 8) = uv[i]; }
    }
    float wreg[CW];
#pragma unroll
    for (int w = 0; w < CW; ++w) wreg[w] = c.w_dw[w * CD + tid];
    const float bias = c.b_dw[tid];
    __syncthreads();
#pragma unroll 1
    for (int tb = 0; tb < 4; ++tb) {
        float a[8];
#pragma unroll
        for (int o = 0; o < 8; ++o) a[o] = bias;
#pragma unroll
        for (int k = 0; k < 38; ++k) { const float u = bf2f(sU[(tb * 8 + k) * 512 + tid]);
#pragma unroll
            for (int o = 0; o < 8; ++o) { const int w = k - o; if (w >= 0 && w < CW) a[o] += u * wreg[w]; } }
#pragma unroll
        for (int o = 0; o < 8; ++o) sC[(tb * 8 + o) * 512 + tid] = a[o];
    }
    __syncthreads();
    const f32x4 g0 = *(const f32x4*)(c.ln_w + lane * 4), g1 = *(const f32x4*)(c.ln_w + 256 + lane * 4), b0 = *(const f32x4*)(c.ln_b + lane * 4), b1 = *(const f32x4*)(c.ln_b + 256 + lane * 4);
    for (int rr = wid; rr < 32; rr += 8) {
        f32x4 x0 = *(const LAS f32x4*)(sC + rr * 512 + lane * 4), x1 = *(const LAS f32x4*)(sC + rr * 512 + 256 + lane * 4);
        const float mean = wave_sum((x0.x + x0.y) + (x0.z + x0.w) + (x1.x + x1.y) + (x1.z + x1.w)) * (1.0f / CD);
        x0 -= mean; x1 -= mean;
        const float var = wave_sum((x0.x * x0.x + x0.y * x0.y) + (x0.z * x0.z + x0.w * x0.w) + (x1.x * x1.x + x1.y * x1.y) + (x1.z * x1.z + x1.w * x1.w)) * (1.0f / CD);
        const float rstd = 1.0f / sqrtf(var + EPS);
        f32x4 y0 = x0 * rstd * g0 + b0, y1 = x1 * rstd * g1 + b1;
#pragma unroll
        for (int j = 0; j < 4; ++j) { y0[j] = y0[j] * sigm(y0[j]); y1[j] = y1[j] * sigm(y1[j]); }
        u32x2 w0, w1; w0.x = pk2(y0.x, y0.y); w0.y = pk2(y0.z, y0.w); w1.x = pk2(y1.x, y1.y); w1.y = pk2(y1.z, y1.w);
        bf16_t* dst = AA + (size_t)(t0 + rr) * 1024;
        *(u32x2*)(dst + lane * 4) = w0; *(u32x2*)(dst + 256 + lane * 4) = w1;
    }
    if (t0 == SEQ - 32) {
        float* ncp = c.out + O_NCP + (size_t)b * 30 * CD;
        for (int id = tid; id < 30 * CD; id += 512) ncp[id] = bf2f(sU[(32 + (id >> 9)) * 512 + (id & 511)]);
    }
    __syncthreads();
}

__device__ __forceinline__ void conv_sample_item(const Ctx& c, LAS unsigned char* lds, int b) {
    const int tid = otid();
    unsigned char* act = c.ws + WS_ACT;
    LAS float* red = (LAS float*)lds;
    const float* cache = c.cache_conv + (size_t)b * 30 * CD; float* ncs = c.out + O_NCS + (size_t)b * 30 * CD;
    float acc = c.b_dw[tid];
#pragma unroll 1
    for (int w0 = 0; w0 < 30; w0 += 10) {
        float cv[10], wv[10];
#pragma unroll
        for (int w = 0; w < 10; ++w) { cv[w] = __builtin_nontemporal_load(cache + (w0 + w) * CD + tid); wv[w] = c.w_dw[(w0 + w) * CD + tid]; }
#pragma unroll
        for (int w = 0; w < 10; ++w) { acc += cv[w] * wv[w]; if (w0 + w >= 1) __builtin_nontemporal_store(cv[w], ncs + (w0 + w - 1) * CD + tid); }
    }
    const float u = bf2f(((const bf16_t*)(act + A_U))[(size_t)(MP + b) * 512 + tid]);
    acc += u * c.w_dw[30 * CD + tid]; ncs[29 * CD + tid] = u;
    const float mean = block_sum(acc, red, tid) * (1.0f / CD);
    const float d = acc - mean;
    const float var = block_sum(d * d, red, tid) * (1.0f / CD);
    float y = d * (1.0f / sqrtf(var + EPS)) * c.ln_w[tid] + c.ln_b[tid];
    y = y * sigm(y);
    ((bf16_t*)c.out + AA_OFF)[(size_t)(MP + b) * 1024 + tid] = (bf16_t)(pk2(y, 0.f) & 0xffffu);
    __syncthreads();
}

__device__ __forceinline__ void phase2(const Ctx& c, LAS unsigned char* lds, int rep) {
    for (int it = blockIdx.x; it < NB * NH * 4; it += gridDim.x) { const int x = it & 7, j = it >> 3; ret_prompt_item(c, lds, (x * 4 + (j >> 2)) * 4 + (j & 3)); }
    unsigned* counter = (unsigned*)(c.ws + WS_CTL) + rep;
    LAS int* sItem = (LAS int*)(lds + LDS_BYTES - 16);
    constexpr int N_CONV = MP / 32, N_RS = MS * NH, N_CS = MS, N_WQ = (WI_TOTAL - WI_IN) / 16, NTOT = N_CONV + N_RS + N_CS + N_WQ;
    static_assert((WI_TOTAL - WI_IN) % 16 == 0, "weight queue items");
    unsigned nxt = 0u;
    if (threadIdx.x == 0) nxt = atomicAdd(counter, 1u);
    for (;;) {
        if (threadIdx.x == 0) { *sItem = (int)nxt; nxt = atomicAdd(counter, 1u); }
        __syncthreads();
        const int it = __builtin_amdgcn_readfirstlane(*sItem);
        __syncthreads();
        if (it >= NTOT) break;
        if (it < N_CS) conv_sample_item(c, lds, it);
        else if (it < N_CS + N_CONV) conv_prompt_item(c, lds, it - N_CS);
        else if (it < N_CS + N_CONV + N_RS) ret_sample_item(c, lds, it - N_CS - N_CONV);
        else { const int t_ = otid(); const int wv = __builtin_amdgcn_readfirstlane(t_ >> 6);
            wt_pair(c, WI_IN / 2 + (it - N_CS - N_CONV - N_RS) * 8 + wv, t_ & 63, (LAS float*)(lds + wv * 16384)); __syncthreads(); }
    }
}

__device__ __forceinline__ void phase2b(const Ctx& c) {
    const int t_ = otid(); const int lane = t_ & 63, gw = blockIdx.x * 8 + (t_ >> 6), NGW = gridDim.x * 8;
    unsigned char* act = c.ws + WS_ACT;
    const float* SSQ = (const float*)(c.ws + WS_SSQ);
    for (int row0 = gw; row0 < RT; row0 += 4 * NGW) {
        u32x4 a[4][2], o[4][2]; float rs[4];
#pragma unroll
        for (int r = 0; r < 4; ++r) { const int row = row0 + r * NGW; rs[r] = 1.0f;
            if (row < RT) {
                const u32x4* sg = (const u32x4*)((bf16_t*)(act + A_SG) + (size_t)row * 1024 + lane * 16);
                const u32x4* ov = (const u32x4*)((const bf16_t*)c.out + (size_t)row * 1024 + lane * 16);
#pragma unroll
                for (int j = 0; j < 2; ++j) { a[r][j] = __builtin_nontemporal_load(sg + j); o[r][j] = __builtin_nontemporal_load(ov + j); }
                if (row < MP) { const f32x4 q = *(const f32x4*)(SSQ + (size_t)row * 16 + (lane >> 4) * 4); rs[r] = 1.0f / sqrtf(((q.x + q.y) + (q.z + q.w)) * (1.0f / DV) + EPS); }
            } }
#pragma unroll
        for (int r = 0; r < 4; ++r) { const int row = row0 + r * NGW;
            if (row < RT) { u32x4* dg = (u32x4*)((bf16_t*)(act + A_SG) + (size_t)row * 1024 + lane * 16); const float k = rs[r];
#pragma unroll
                for (int j = 0; j < 2; ++j) { const u32x4 x = a[r][j], y = o[r][j]; u32x4 w;
                    w.x = pk2(bflo(x.x) * bflo(y.x) * k, bfhi(x.x) * bfhi(y.x) * k); w.y = pk2(bflo(x.y) * bflo(y.y) * k, bfhi(x.y) * bfhi(y.y) * k);
                    w.z = pk2(bflo(x.z) * bflo(y.z) * k, bfhi(x.z) * bfhi(y.z) * k); w.w = pk2(bflo(x.w) * bflo(y.w) * k, bfhi(x.w) * bfhi(y.w) * k);
                    dg[j] = w; } } }
    }
}


#define XB_TMO      128
#define XB_XCNT(j)  (256  + 64 * (j))
#define XB_XSUB(j)  (1280 + 64 * (j))
#define XB_XGEN(j)  (2304 + 64 * (j))
#define XB_TOP      3328
#define XB_TOPGEN   3392
#define XCD_BAR_WORDS 3456
#define XB_SPIN_CAP (1u << 22)
__device__ __forceinline__ unsigned xb_ld(unsigned* p)              { return __hip_atomic_load(p, __ATOMIC_RELAXED, __HIP_MEMORY_SCOPE_AGENT); }
__device__ __forceinline__ unsigned xb_add(unsigned* p, unsigned v) { return __hip_atomic_fetch_add(p, v, __ATOMIC_RELAXED, __HIP_MEMORY_SCOPE_AGENT); }
__device__ __forceinline__ unsigned xb_xcc_id() { return (unsigned)__builtin_amdgcn_s_getreg((3 << 11) | 20) & 0xFu; }
#define XB_SPIN(cond, bar) do { unsigned _sp = 0; while (cond) { __builtin_amdgcn_s_sleep(1); \
    if ((++_sp & 255u) == 0u) { if (xb_ld(&(bar)[XB_TMO])) break; if (_sp > XB_SPIN_CAP) { atomicAdd(&(bar)[XB_TMO], 1u); break; } } } } while (0)
struct XcdBarrier { unsigned* bar; unsigned x; volatile LAS unsigned* st; };
__device__ __forceinline__ XcdBarrier xcd_barrier_post(unsigned* bar, volatile LAS unsigned* st) {
    XcdBarrier b; b.bar = bar; b.x = xb_xcc_id(); b.st = st;
    if (threadIdx.x == 0) (void)xb_add(&bar[XB_XCNT(b.x)], 1u);
    return b;
}
__device__ __forceinline__ void xcd_barrier_complete(unsigned* bar, unsigned x, unsigned& nloc, unsigned& nx) {
    const unsigned G = gridDim.x * gridDim.y * gridDim.z;
    unsigned sum, cnt, mine, sp = 0u;
    for (;;) {
        sum = 0u; cnt = 0u; mine = 0u;
#pragma unroll
        for (unsigned j = 0; j < 16; ++j) { const unsigned c = xb_ld(&bar[XB_XCNT(j)]); sum += c; cnt += (c > 0u) ? 1u : 0u; mine = (j == x) ? c : mine; }
        if (sum == G) break;
        __builtin_amdgcn_s_sleep(1);
        if ((++sp & 255u) == 0u) { if (xb_ld(&bar[XB_TMO])) break; if (sp > XB_SPIN_CAP) { atomicAdd(&bar[XB_TMO], 1u); break; } }
    }
    nloc = mine > 0u ? mine : 1u; nx = cnt > 0u ? cnt : 1u;
}
__device__ __forceinline__ void xcd_barrier(const XcdBarrier& b) {
    asm volatile("s_waitcnt vmcnt(0)" ::: "memory");
    __syncthreads();
    if (threadIdx.x == 0) {
        unsigned* bar = b.bar;
        __builtin_amdgcn_s_waitcnt(0);
        unsigned nloc = b.st[0], nx = b.st[1];
        if (nloc == 0u) { xcd_barrier_complete(bar, b.x, nloc, nx); b.st[0] = nloc; b.st[1] = nx; }
        const unsigned old = xb_add(&bar[XB_XSUB(b.x)], 1u);
        const unsigned gen = old / nloc;
        if (old + 1u == (gen + 1u) * nloc) {
            __builtin_amdgcn_fence(__ATOMIC_RELEASE, "agent");
            asm volatile("s_waitcnt vmcnt(0)" ::: "memory");
            const unsigned og = xb_add(&bar[XB_TOP], 1u);
            const unsigned tg = og / nx;
            if (og + 1u == (tg + 1u) * nx) xb_add(&bar[XB_TOPGEN], 1u);
            else XB_SPIN(xb_ld(&bar[XB_TOPGEN]) == tg, bar);
            __builtin_amdgcn_fence(__ATOMIC_ACQUIRE, "agent");
            xb_add(&bar[XB_XGEN(b.x)], 1u);
            asm volatile("s_waitcnt vmcnt(0)" ::: "memory");
        } else {
            XB_SPIN(xb_ld(&bar[XB_XGEN(b.x)]) == gen, bar);
            __builtin_amdgcn_fence(__ATOMIC_ACQUIRE, "agent");
            asm volatile("s_waitcnt vmcnt(0)" ::: "memory");
        }
    }
    __syncthreads();
}

__global__ void __launch_bounds__(512) fwd_megakernel(Ctx c) {
    extern __shared__ __attribute__((aligned(16))) unsigned char smem[];
    LAS unsigned char* lds = (LAS unsigned char*)smem;
    cg::grid_group grid = cg::this_grid();
    unsigned char* act = c.ws + WS_ACT;
    volatile LAS unsigned* xst = (volatile LAS unsigned*)(lds + LDS_BYTES - 32);
    if (threadIdx.x == 0) { xst[0] = 0u; xst[1] = 0u; }
    __syncthreads();
    const XcdBarrier xb = xcd_barrier_post((unsigned*)(c.ws + WS_BAR), xst);
    phase0(c, lds);
    if (c.ws == nullptr) grid.sync();
    xcd_barrier(xb);
    gemm_all<EK_IN, NIN, DM, 3, Epi<EK_IN>, true>(c, lds, (const bf16_t*)c.out, (const bf16_t*)(c.ws + WS_WIN));
    xcd_barrier(xb);
    phase2(c, lds, 0);
    xcd_barrier(xb);
    {
        const bf16_t* AAC = (const bf16_t*)c.out + AA_OFF; const bf16_t* WCO = (const bf16_t*)(c.ws + WS_WCO2);
        const bf16_t* OG = (const bf16_t*)c.out; const bf16_t* WRO = (const bf16_t*)(c.ws + WS_WRO);
        gemm_all<EK_RO, DM, DM, 1, EpiP3, true, true, true, false, DM, DM, true>(c, lds, AAC, WCO, OG, WRO);
        gemm_all<EK_CO, DM, CD, 1, Epi<EK_CO>, false, false, false, true, DM, DM>(c, lds, AAC, WCO);
        gemm_all<EK_RO, DM, DM, 1, Epi<EK_RO>, false, false, false, true>(c, lds, OG, WRO);
    }
    xcd_barrier(xb);
    gemm_all<EK_WO, DM, DM, 1, EpiWoFused>(c, lds, (const bf16_t*)(act + A_SB), (const bf16_t*)(c.ws + WS_WO));
    xcd_barrier(xb);
    gemm_all<EK_UP, FF, DM, 4, Epi<EK_UP>, true>(c, lds, (const bf16_t*)(act + A_HN), (const bf16_t*)(c.ws + WS_WUP));
    xcd_barrier(xb);
    gemm_all<EK_DN, DM, FF, 1, EpiDnFused>(c, lds, (const bf16_t*)(act + A_UP), (const bf16_t*)(c.ws + WS_WDN));
}

extern "C" void kernel_launch(void* const* d_in, const int* in_sizes, int n_in, void* d_out, int out_size, void* d_ws, size_t ws_size, hipStream_t stream) {
    static int grid_blocks = 0;
    if (!grid_blocks) {
        if (n_in != 18 || ws_size < WS_END2) { fprintf(stderr, "kernel_launch: unexpected n_in %d / ws_size %zu (need %zu)\n", n_in, ws_size, (size_t)WS_END2); grid_blocks = -1; return; }
        int dev = 0, cus = 0, per_cu = 0;
        hipGetDevice(&dev);
        hipDeviceGetAttribute(&cus, hipDeviceAttributeMultiprocessorCount, dev);
        if (hipFuncSetAttribute((const void*)fwd_megakernel, hipFuncAttributeMaxDynamicSharedMemorySize, LDS_BYTES) != hipSuccess) fprintf(stderr, "kernel_launch: hipFuncSetAttribute failed\n");
        hipOccupancyMaxActiveBlocksPerMultiprocessor(&per_cu, (const void*)fwd_megakernel, 512, LDS_BYTES);
        (void)hipGetLastError();
        if (per_cu < 1) { fprintf(stderr, "kernel_launch: occupancy query says %d blocks per CU\n", per_cu); per_cu = 1; }
        grid_blocks = cus * per_cu; if (grid_blocks > 256) grid_blocks = 256;
    }
    if (grid_blocks < 0) return;
    (void)hipMemsetAsync((char*)d_ws + WS_CTL, 0, CTL_ZERO, stream);
    Ctx c{};
    const float** f = (const float**)&c;
    for (int i = 0; i < 18; ++i) f[i] = (const float*)d_in[i];
    c.out = (float*)d_out; c.ws = (unsigned char*)d_ws;
    void* args[] = {&c};
    hipError_t e = hipLaunchCooperativeKernel((const void*)fwd_megakernel, dim3(grid_blocks), dim3(512), args, LDS_BYTES, stream);
    if (e != hipSuccess) fprintf(stderr, "cooperative launch failed: %s (grid %d)\n", hipGetErrorString(e), grid_blocks);
}
```

```cpp
#include <hip/hip_runtime.h>
#include <hip/hip_cooperative_groups.h>
#include <cstdio>
#include <cstdint>
namespace cg = cooperative_groups;

#define LAS __attribute__((address_space(3)))
typedef unsigned short bf16_t;
typedef short bf16x8 __attribute__((ext_vector_type(8)));
typedef float f32x4 __attribute__((ext_vector_type(4)));
typedef unsigned u32x4 __attribute__((ext_vector_type(4)));
typedef unsigned u32x2 __attribute__((ext_vector_type(2)));

constexpr int DM = 1024, NB = 8, SEQ = 2048, MP = NB * SEQ  , MS = 128, RT = MP + MS  ;
constexpr int CD = 512, CW = 31, NH = 4, DK = 128, DV = 256, FF = 4096, NIN = 6144;
constexpr float EPS = 1e-6f;
constexpr size_t O_NCP = (size_t)RT * DM;
constexpr size_t O_NRP = O_NCP + (size_t)NB * 30 * CD;
constexpr size_t O_NCS = O_NRP + (size_t)NB * NH * DK * DV;
constexpr size_t O_NRS = O_NCS + (size_t)MS * 30 * CD;
constexpr size_t WS_CTL = 0, WS_BAR = 4096, WS_WIN = 131072, WS_WCO = WS_WIN + (size_t)NIN * DM * 2, WS_WRO = WS_WCO + (size_t)DM * CD * 2,
                 WS_WO = WS_WRO + (size_t)DM * DM * 2, WS_WUP = WS_WO + (size_t)DM * DM * 2, WS_WDN = WS_WUP + (size_t)FF * DM * 2,
                 WS_ACT = WS_WDN + (size_t)FF * DM * 2;
constexpr size_t A_U = 0, A_Q = A_U + (size_t)RT * 512 * 2, A_K = A_Q + (size_t)RT * 512 * 2, A_V = A_K + (size_t)RT * 512 * 2,
                 A_SG = A_V + (size_t)RT * 1024 * 2, A_SA = A_SG + (size_t)RT * 1024 * 2, A_SB = A_SA + (size_t)RT * 1024 * 2,
                 A_AACT = A_SB + (size_t)RT * 1024 * 2, A_END = A_AACT + (size_t)RT * 512 * 2;
constexpr size_t A_M2 = (size_t)RT * 1024 * 2  , A_HN = 0  , A_F = 0  , A_UP = (size_t)RT * 1024 * 4;
static_assert(A_UP + (size_t)RT * FF * 2 <= A_END, "act region");
constexpr size_t WS_SSQ = WS_ACT + A_END, WS_END = WS_SSQ + (size_t)MP * 16 * 4;
constexpr size_t WS_XCH = WS_END;
constexpr size_t WS_XCHS = WS_XCH + 3 * 64 * 256 * 4 * 4;
constexpr size_t WS_END2 = WS_XCHS + 3 * 8 * 16 * 32 * 4;
constexpr size_t CTL_XCNT = 20480;
constexpr size_t CTL_XCNTS = CTL_XCNT + 3 * 64 * 256;
constexpr size_t CTL_ZERO = CTL_XCNTS + 3 * 8 * 256;
static_assert(CTL_ZERO <= WS_WIN, "control words");
constexpr int LDS_BYTES = 147456;

struct Ctx {
    const float *xp, *xs, *cache_conv, *state_ret, *n_mix_pre, *n_mix_post, *w_in, *w_dw, *b_dw, *ln_w, *ln_b, *w_co, *w_ro, *w_o,
        *n_ffn_pre, *n_ffn_post, *w_up, *w_dn;
    float* out; unsigned char* ws;
};

__device__ __forceinline__ unsigned pk2(float lo, float hi) { unsigned r; asm volatile("v_cvt_pk_bf16_f32 %0, %1, %2" : "=v"(r) : "v"(lo), "v"(hi)); return r; }
__device__ __forceinline__ float bflo(unsigned w) { return __uint_as_float(w << 16); }
__device__ __forceinline__ float bfhi(unsigned w) { return __uint_as_float(w & 0xffff0000u); }
__device__ __forceinline__ float bf2f(bf16_t b) { return __uint_as_float(((unsigned)b) << 16); }
__device__ __forceinline__ unsigned pack_u8x4(float a, float b, float c, float d) {
    return (unsigned)(a * 255.0f + 0.5f) | ((unsigned)(b * 255.0f + 0.5f) << 8) | ((unsigned)(c * 255.0f + 0.5f) << 16) | ((unsigned)(d * 255.0f + 0.5f) << 24);
}
__device__ __forceinline__ float u8f(unsigned w, int k) { return (float)((w >> (8 * k)) & 0xffu) * (1.0f / 255.0f); }
__device__ __forceinline__ float sigm(float x) { return __builtin_amdgcn_rcpf(1.0f + __expf(-x)); }
__device__ __forceinline__ float wave_sum(float v) {
#pragma unroll
    for (int o = 1; o < 64; o <<= 1) v += __shfl_xor(v, o);
    return v;
}
#define LDS_WAIT() asm volatile("s_waitcnt lgkmcnt(0)" ::: "memory")
__device__ __forceinline__ int otid() { int t = threadIdx.x; asm volatile("" : "+v"(t)); return t; }
__device__ __forceinline__ const float* xrow(const Ctx& c, int row) { return row < MP ? c.xp + (size_t)row * DM : c.xs + (size_t)(row - MP) * DM; }

namespace pg8 {
constexpr int BM = 256, BK = 64, HALF = 128, HTB = HALF * BK * 2, STAGE_BYTES = 8 * HTB, NXCD = 8, WGM = 8;
__host__ __device__ __forceinline__ int lds_byte(int r, int c) { const int st = (r >> 4) * 2 + (c >> 5), rr = r & 15, cc = c & 31, ob = rr * 64 + cc * 2; return st * 1024 + (ob ^ (((ob >> 9) & 1) << 5)); }
__host__ __device__ __forceinline__ void stage_rc(int b, int& R, int& C) { const int st = b / 1024, sb = b % 1024, swz = sb ^ (((sb >> 9) & 1) << 5); R = (st >> 1) * 16 + swz / 64; C = (st & 1) * 32 + (swz % 64) / 2; }
__host__ __device__ __forceinline__ int perm32(int rho) { const int n = rho >> 4, i = rho & 15; return 8 * (i >> 2) + 4 * n + (i & 3); }
struct Unit { int pm, pn; };
struct Gemm { const bf16_t* A; const bf16_t* Bt; int M, N, K; const float* ssq = nullptr; };
struct StaticOrder {
    int nM, nN, nwg, G, c;
    __device__ void init(int M, int N, int G_, int c_) { nM = M / BM; nN = N / BM; nwg = nM * nN; G = G_; c = c_; }
    __device__ bool next(int i, Unit& u) const {
        const long L = (long)i * G + c; if (L >= nwg) return false;
        int wgid = (int)L; { const int q = nwg / NXCD, r = nwg % NXCD, xcd = wgid % NXCD, off = wgid / NXCD; wgid = (xcd < r ? xcd * (q + 1) : r * (q + 1) + (xcd - r) * q) + off; }
        const int nig = WGM * nN, gid = wgid / nig, fm = gid * WGM, gsz = (nM - fm) < WGM ? (nM - fm) : WGM;
        u.pm = fm + ((wgid % nig) % gsz); u.pn = (wgid % nig) / gsz; return true;
    }
};
template <class Epi, bool ALIGN_EPI = false, bool SP2 = true, bool HNORM = false>
__device__ __forceinline__ void gemm_phase(LAS unsigned char* lds, const Gemm g, const StaticOrder& S, const Epi& E) {
    int tid_ = threadIdx.x; asm volatile("" : "+v"(tid_));
    const int tid = tid_, wid = __builtin_amdgcn_readfirstlane(tid >> 6), lane = tid & 63, wr = wid >> 2, wc = wid & 3, fr = lane & 15, fq = lane >> 4;
    const int K = g.K, nt = K / BK;
    unsigned voffA[2], voffB[2];
#pragma unroll
    for (int i = 0; i < 2; ++i) { int R, C; stage_rc(tid * 16 + i * 8192, R, C); const int Rb = (R & ~31) + perm32(R & 31);
        voffA[i] = (unsigned)(R * K + C) * 2u; voffB[i] = (unsigned)(Rb * K + C) * 2u; }
    const size_t kstep = (size_t)(BK * 2);
    const size_t hstep = (size_t)HALF * K * 2;
    const size_t tstep = 2 * hstep;
    const unsigned ldsw = (unsigned)wid * 1024u;
    const int aoff = lds_byte(wr * 64 + fr, fq * 8), boff = lds_byte(wc * 32 + fr, fq * 8);
#define PG8_SA(b, h) (((b) * 2 + (h)) * HTB)
#define PG8_SB(b, h) ((4 + (b) * 2 + (h)) * HTB)
#define PG8_STAGE(bufoff, gbase, voff) do { _Pragma("unroll") for (int _i = 0; _i < 2; ++_i) \
        __builtin_amdgcn_global_load_lds((const unsigned*)((const char*)(gbase) + (voff)[_i]), (LAS unsigned*)(lds + (bufoff) + ldsw + _i * 8192), 16, 0, 0); } while (0)
#define PG8_LDA(dst, b, h) do { _Pragma("unroll") for (int m = 0; m < 4; ++m) _Pragma("unroll") for (int k = 0; k < 2; ++k) dst[m][k] = *(const LAS bf16x8*)(lds + PG8_SA(b, h) + aoff + m * 2048 + k * 1024); } while (0)
#define PG8_LDB(dst, b, h) do { _Pragma("unroll") for (int n = 0; n < 2; ++n) _Pragma("unroll") for (int k = 0; k < 2; ++k) dst[n][k] = *(const LAS bf16x8*)(lds + PG8_SB(b, h) + boff + n * 2048 + k * 1024); } while (0)
#define PG8_MMA(ai, bj, At, Bt) do { __builtin_amdgcn_s_setprio(1); _Pragma("unroll") for (int m = 0; m < 4; ++m) _Pragma("unroll") for (int n = 0; n < 2; ++n) _Pragma("unroll") for (int k = 0; k < 2; ++k) \
        acc[ai][bj][m][n] = __builtin_amdgcn_mfma_f32_16x16x32_bf16(Bt[n][k], At[m][k], acc[ai][bj][m][n], 0, 0, 0); __builtin_amdgcn_s_setprio(0); } while (0)
#define PG8_WAIT_V(n) asm volatile("s_waitcnt vmcnt(" #n ")" ::: "memory")
#define PG8_WAIT_L(n) asm volatile("s_waitcnt lgkmcnt(" #n ")" ::: "memory")
#define PG8_BAR __builtin_amdgcn_s_barrier()
#define PG8_SCHED __builtin_amdgcn_sched_barrier(0)
    Unit cur, nxt; int ui = 0;
    if (!S.next(0, cur)) return;
    f32x4 acc[2][2][4][2];
#pragma unroll
    for (int a = 0; a < 2; ++a)
#pragma unroll
        for (int b = 0; b < 2; ++b)
#pragma unroll
            for (int m = 0; m < 4; ++m)
#pragma unroll
                for (int n = 0; n < 2; ++n) acc[a][b][m][n] = (f32x4){0.f, 0.f, 0.f, 0.f};
    bf16x8 At[4][2], B0[2][2], B1[2][2];
    const char* cA = (const char*)g.A + (size_t)cur.pm * tstep; const char* cB = (const char*)g.Bt + (size_t)cur.pn * tstep;
    LAS float* hrt = (LAS float*)(lds + STAGE_BYTES);
    if constexpr (HNORM) {
        if (tid < 256) { const float* q = g.ssq + (size_t)(cur.pm * 256 + tid) * 16; float r[4];
#pragma unroll
            for (int hh = 0; hh < 4; ++hh) { const f32x4 v = *(const f32x4*)(q + 4 * hh); r[hh] = 1.0f / sqrtf(((v.x + v.y) + (v.z + v.w)) * (1.0f / 256.0f) + 1e-6f); }
            *(LAS f32x4*)(hrt + tid * 4) = (f32x4){r[0] / r[1], r[1] / r[2], r[2] / r[3], r[3]}; }
        asm volatile("s_waitcnt vmcnt(0) lgkmcnt(0)" ::: "memory"); PG8_BAR;
    }
    if constexpr (SP2) {
        PG8_STAGE(PG8_SB(0, 0), cB, voffB); PG8_STAGE(PG8_SB(0, 1), cB + hstep, voffB); PG8_STAGE(PG8_SA(0, 0), cA, voffA); PG8_STAGE(PG8_SA(0, 1), cA + hstep, voffA);
        if (wr == 1) PG8_BAR;
        PG8_WAIT_V(2); PG8_BAR;
        PG8_STAGE(PG8_SB(1, 0), cB + kstep, voffB); PG8_STAGE(PG8_SA(1, 0), cA + kstep, voffA); PG8_STAGE(PG8_SB(1, 1), cB + hstep + kstep, voffB);
        PG8_WAIT_V(6); PG8_BAR;
    } else {
    PG8_STAGE(PG8_SB(0, 0), cB, voffB); PG8_STAGE(PG8_SA(0, 0), cA, voffA); PG8_STAGE(PG8_SB(0, 1), cB + hstep, voffB); PG8_STAGE(PG8_SA(0, 1), cA + hstep, voffA);
    if (wr == 1) PG8_BAR;
    PG8_WAIT_V(4); PG8_BAR;
    PG8_STAGE(PG8_SB(1, 0), cB + kstep, voffB); PG8_STAGE(PG8_SA(1, 0), cA + kstep, voffA); PG8_STAGE(PG8_SB(1, 1), cB + hstep + kstep, voffB);
    PG8_WAIT_V(6); PG8_BAR;
    }
    for (;;) {
        const bool has_next = S.next(ui + 1, nxt);
        const char* nA = has_next ? (const char*)g.A + (size_t)nxt.pm * tstep : cA; const char* nB = has_next ? (const char*)g.Bt + (size_t)nxt.pn * tstep : cB;
        for (int t = 0; t < nt; t += 2) {
            const bool last = (t == nt - 2);
            const char* a1 = cA + (size_t)(t + 1) * kstep;
            const char* a2 = last ? nA : cA + (size_t)(t + 2) * kstep; const char* b2 = last ? nB : cB + (size_t)(t + 2) * kstep;
            const char* a3 = a2 + kstep; const char* b3 = b2 + kstep;
            if constexpr (HNORM) { if (t == 4 || t == 8 || t == 12) { const int hi = (t >> 2) - 1;
#pragma unroll
                for (int ai = 0; ai < 2; ++ai)
#pragma unroll
                    for (int m = 0; m < 4; ++m) { const float f = hrt[(ai * 128 + wr * 64 + m * 16 + fr) * 4 + hi];
#pragma unroll
                        for (int bj = 0; bj < 2; ++bj)
#pragma unroll
                            for (int n = 0; n < 2; ++n) acc[ai][bj][m][n] *= f; } } }
            if constexpr (SP2) {
            PG8_LDB(B0, 0, 0); PG8_LDB(B1, 0, 1); PG8_SCHED; PG8_LDA(At, 0, 0); PG8_STAGE(PG8_SA(1, 1), a1 + hstep, voffA);
            PG8_WAIT_V(8); PG8_WAIT_L(0); PG8_BAR; PG8_MMA(0, 0, At, B0); PG8_MMA(0, 1, At, B1); PG8_BAR; PG8_SCHED;
            PG8_LDA(At, 0, 1); PG8_STAGE(PG8_SB(0, 0), b2, voffB); PG8_STAGE(PG8_SB(0, 1), b2 + hstep, voffB); PG8_STAGE(PG8_SA(0, 0), a2, voffA);
            PG8_WAIT_V(8); PG8_WAIT_L(0); PG8_BAR; PG8_MMA(1, 0, At, B0); PG8_MMA(1, 1, At, B1); PG8_BAR; PG8_SCHED;
            PG8_LDB(B0, 1, 0); PG8_LDB(B1, 1, 1); PG8_SCHED; PG8_LDA(At, 1, 0); PG8_STAGE(PG8_SA(0, 1), a2 + hstep, voffA);
            PG8_WAIT_V(8); PG8_WAIT_L(0); PG8_BAR; PG8_MMA(0, 0, At, B0); PG8_MMA(0, 1, At, B1); PG8_BAR; PG8_SCHED;
            PG8_LDA(At, 1, 1); PG8_STAGE(PG8_SB(1, 0), b3, voffB); PG8_STAGE(PG8_SB(1, 1), b3 + hstep, voffB); PG8_STAGE(PG8_SA(1, 0), a3, voffA);
            PG8_WAIT_V(8); PG8_WAIT_L(0); PG8_BAR; PG8_MMA(1, 0, At, B0); PG8_MMA(1, 1, At, B1); PG8_BAR; PG8_SCHED;
            } else {
            PG8_LDB(B0, 0, 0); PG8_SCHED; PG8_LDA(At, 0, 0); PG8_STAGE(PG8_SA(1, 1), a1 + hstep, voffA);
            PG8_WAIT_L(8); PG8_BAR; PG8_WAIT_L(0); PG8_MMA(0, 0, At, B0); PG8_BAR; PG8_SCHED;
            PG8_LDB(B1, 0, 1); PG8_STAGE(PG8_SB(0, 0), b2, voffB);
            PG8_BAR; PG8_WAIT_L(0); PG8_MMA(0, 1, At, B1); PG8_BAR;
            PG8_LDA(At, 0, 1); PG8_STAGE(PG8_SA(0, 0), a2, voffA);
            PG8_BAR; PG8_WAIT_L(0); PG8_MMA(1, 0, At, B0); PG8_BAR; PG8_SCHED;
            PG8_STAGE(PG8_SB(0, 1), b2 + hstep, voffB);
            PG8_WAIT_V(6); PG8_BAR; PG8_MMA(1, 1, At, B1); PG8_BAR;
            PG8_LDB(B0, 1, 0); PG8_SCHED; PG8_LDA(At, 1, 0); PG8_STAGE(PG8_SA(0, 1), a2 + hstep, voffA);
            PG8_WAIT_L(8); PG8_BAR; PG8_WAIT_L(0); PG8_MMA(0, 0, At, B0); PG8_BAR; PG8_SCHED;
            PG8_LDB(B1, 1, 1); PG8_STAGE(PG8_SB(1, 0), b3, voffB);
            PG8_BAR; PG8_WAIT_L(0); PG8_MMA(0, 1, At, B1); PG8_BAR;
            PG8_LDA(At, 1, 1); PG8_STAGE(PG8_SA(1, 0), a3, voffA);
            PG8_BAR; PG8_WAIT_L(0); PG8_MMA(1, 0, At, B0); PG8_BAR; PG8_SCHED;
            PG8_STAGE(PG8_SB(1, 1), b3 + hstep, voffB);
            PG8_WAIT_V(6); PG8_BAR; PG8_MMA(1, 1, At, B1); PG8_BAR;
            }
        }
        if constexpr (HNORM) {
#pragma unroll
            for (int ai = 0; ai < 2; ++ai)
#pragma unroll
                for (int m = 0; m < 4; ++m) { const float f = hrt[(ai * 128 + wr * 64 + m * 16 + fr) * 4 + 3];
#pragma unroll
                    for (int bj = 0; bj < 2; ++bj)
#pragma unroll
                        for (int n = 0; n < 2; ++n) acc[ai][bj][m][n] *= f; } }
        if constexpr (ALIGN_EPI) { if (wr == 0) PG8_BAR; }
        if constexpr (!Epi::AFTER_DRAIN) E(acc, cur, wr, wc, fr, fq);
        if (!has_next) break;
#pragma unroll
        for (int a = 0; a < 2; ++a)
#pragma unroll
            for (int b = 0; b < 2; ++b)
#pragma unroll
                for (int m = 0; m < 4; ++m)
#pragma unroll
                    for (int n = 0; n < 2; ++n) acc[a][b][m][n] = (f32x4){0.f, 0.f, 0.f, 0.f};
        cur = nxt; cA = nA; cB = nB; ++ui;
        if constexpr (ALIGN_EPI) { if (wr == 1) PG8_BAR; }
    }
    PG8_WAIT_V(0);
    if constexpr (!ALIGN_EPI) { if (wr == 0) PG8_BAR; }
    PG8_BAR;
    if constexpr (Epi::AFTER_DRAIN) E.fused(acc, cur, wr, wc, fr, fq, lds, tid);
#undef PG8_SA
#undef PG8_SB
#undef PG8_STAGE
#undef PG8_LDA
#undef PG8_LDB
#undef PG8_MMA
#undef PG8_WAIT_V
#undef PG8_WAIT_L
#undef PG8_BAR
#undef PG8_SCHED
}
}

enum { EK_IN = 0, EK_CO, EK_RO, EK_WO, EK_UP, EK_DN };

template <int KIND>
__device__ __forceinline__ void epi8(const Ctx& c, int row, int col, f32x4 v0, f32x4 v1) {
    unsigned char* act = c.ws + WS_ACT;
    if constexpr (KIND == EK_IN) {
        if (col < 1024) {
            u32x2 w; w.x = pk2(v0[0] * sigm(v0[1]), v0[2] * sigm(v0[3])); w.y = pk2(v1[0] * sigm(v1[1]), v1[2] * sigm(v1[3]));
            *(u32x2*)((bf16_t*)(act + A_U) + (size_t)row * 512 + (col >> 1)) = w;
        } else if (col < 2048) {
            const bool isk = col >= 1536; const int cc = col - (isk ? 1536 : 1024), h = cc >> 7, i0 = (cc & 127) >> 1;
            const float pos = row < MP ? (float)(row & (SEQ - 1)) : 16384.0f;
            const float sc = isk ? 0.08838834764831845f : 1.0f;
            const float* freq = (const float*)(c.ws + WS_CTL + 256);
            const f32x4 fv = *(const f32x4*)(freq + i0);
            float x1[4] = {v0[0], v0[2], v1[0], v1[2]}, x2[4] = {v0[1], v0[3], v1[1], v1[3]}, o1[4], o2[4];
#pragma unroll
            for (int p = 0; p < 4; ++p) {
                const float ang = pos * fv[p];
                const double a = (double)ang; const double n = rint(a * 0.15915494309189535);
                const float r = (float)(a - n * 6.283185307179586);
                const float sn = __sinf(r) * sc, cs = __cosf(r) * sc;
                o1[p] = x1[p] * cs - x2[p] * sn; o2[p] = x2[p] * cs + x1[p] * sn;
            }
            bf16_t* dst = (bf16_t*)(act + (isk ? A_K : A_Q)) + (size_t)row * 512 + h * 128 + i0;
            u32x2 w1, w2; w1.x = pk2(o1[0], o1[1]); w1.y = pk2(o1[2], o1[3]); w2.x = pk2(o2[0], o2[1]); w2.y = pk2(o2[2], o2[3]);
            *(u32x2*)dst = w1; *(u32x2*)(dst + 64) = w2;
        } else {
            const int seg = (col - 2048) >> 10, cc = (col - 2048) & 1023;
            float f[8] = {v0[0], v0[1], v0[2], v0[3], v1[0], v1[1], v1[2], v1[3]};
            if (seg == 1) {
#pragma unroll
                for (int j = 0; j < 8; ++j) f[j] = f[j] * sigm(f[j]);
            } else if (seg >= 2) {
#pragma unroll
                for (int j = 0; j < 8; ++j) f[j] = sigm(f[j]);
                u32x2 b; b.x = pack_u8x4(f[0], f[1], f[2], f[3]); b.y = pack_u8x4(f[4], f[5], f[6], f[7]);
                *(u32x2*)(act + A_SA + (size_t)(seg - 2) * ((size_t)RT * 1024) + (size_t)row * 1024 + cc) = b;
                return;
            }
            u32x4 w; w.x = pk2(f[0], f[1]); w.y = pk2(f[2], f[3]); w.z = pk2(f[4], f[5]); w.w = pk2(f[6], f[7]);
            *(u32x4*)((bf16_t*)(act + A_V + (size_t)seg * ((size_t)RT * 1024 * 2)) + (size_t)row * 1024 + cc) = w;
        }
    } else if constexpr (KIND == EK_CO) {
        const u32x2 g = *(const u32x2*)(act + A_SA + (size_t)row * 1024 + col);
        u32x4 w; w.x = pk2(v0[0] * u8f(g.x, 0), v0[1] * u8f(g.x, 1)); w.y = pk2(v0[2] * u8f(g.x, 2), v0[3] * u8f(g.x, 3));
        w.z = pk2(v1[0] * u8f(g.y, 0), v1[1] * u8f(g.y, 1)); w.w = pk2(v1[2] * u8f(g.y, 2), v1[3] * u8f(g.y, 3));
        *(u32x4*)((bf16_t*)(act + A_SB) + (size_t)row * 1024 + col) = w;
    } else if constexpr (KIND == EK_RO) {
        u32x4* p = (u32x4*)((bf16_t*)(act + A_SB) + (size_t)row * 1024 + col); const u32x4 t = *p;
        const u32x2 g = *(const u32x2*)(act + A_SA + (size_t)RT * 1024 + (size_t)row * 1024 + col);
        u32x4 w; w.x = pk2(bflo(t.x) + v0[0] * u8f(g.x, 0), bfhi(t.x) + v0[1] * u8f(g.x, 1)); w.y = pk2(bflo(t.y) + v0[2] * u8f(g.x, 2), bfhi(t.y) + v0[3] * u8f(g.x, 3));
        w.z = pk2(bflo(t.z) + v1[0] * u8f(g.y, 0), bfhi(t.z) + v1[1] * u8f(g.y, 1)); w.w = pk2(bflo(t.w) + v1[2] * u8f(g.y, 2), bfhi(t.w) + v1[3] * u8f(g.y, 3));
        *p = w;
    } else if constexpr (KIND == EK_WO) {
        u32x4 w; w.x = pk2(v0[0], v0[1]); w.y = pk2(v0[2], v0[3]); w.z = pk2(v1[0], v1[1]); w.w = pk2(v1[2], v1[3]);
        *(u32x4*)((bf16_t*)(act + A_M2) + (size_t)row * DM + col) = w;
    } else if constexpr (KIND == EK_UP) {
        float f[8] = {v0[0], v0[1], v0[2], v0[3], v1[0], v1[1], v1[2], v1[3]};
#pragma unroll
        for (int j = 0; j < 8; ++j) { const float r = fmaxf(f[j], 0.f); f[j] = r * r; }
        u32x4 w; w.x = pk2(f[0], f[1]); w.y = pk2(f[2], f[3]); w.z = pk2(f[4], f[5]); w.w = pk2(f[6], f[7]);
        *(u32x4*)((bf16_t*)(act + A_UP) + (size_t)row * FF + col) = w;
    } else {
        u32x4 w; w.x = pk2(v0[0], v0[1]); w.y = pk2(v0[2], v0[3]); w.z = pk2(v1[0], v1[1]); w.w = pk2(v1[2], v1[3]);
        *(u32x4*)((bf16_t*)(act + A_F) + (size_t)row * DM + col) = w;
    }
}

template <int KIND> struct Epi {
    static constexpr bool AFTER_DRAIN = false;
    Ctx c;
    __device__ __forceinline__ void operator()(const f32x4 (&acc)[2][2][4][2], const pg8::Unit& u, int wr, int wc, int fr, int fq) const {
#pragma unroll
        for (int ai = 0; ai < 2; ++ai)
#pragma unroll
            for (int m = 0; m < 4; ++m) {
                const int row = u.pm * 256 + ai * 128 + wr * 64 + m * 16 + fr;
#pragma unroll
                for (int bj = 0; bj < 2; ++bj) epi8<KIND>(c, row, u.pn * 256 + bj * 128 + wc * 32 + 8 * fq, acc[ai][bj][m][0], acc[ai][bj][m][1]);
            }
    }
};

__device__ __forceinline__ void row_rms_exchange(const Ctx& c, int set, const f32x4 (&v)[2][2][4][2], const pg8::Unit& u, int wr, int wc, int fr, int fq, LAS unsigned char* lds, int tid) {
    LAS float* P = (LAS float*)lds;
    LAS float* S = (LAS float*)(lds + 8192);
    unsigned* slots = (unsigned*)(c.ws + WS_XCH) + (size_t)set * 64 * 256 * 4;
    unsigned* cnt = (unsigned*)(c.ws + WS_CTL + CTL_XCNT) + (size_t)(set * 64 + u.pm) * 64;
#pragma unroll
    for (int ai = 0; ai < 2; ++ai)
#pragma unroll
        for (int m = 0; m < 4; ++m) {
            float q = 0.f;
#pragma unroll
            for (int bj = 0; bj < 2; ++bj)
#pragma unroll
                for (int n = 0; n < 2; ++n) { const f32x4 x = v[ai][bj][m][n]; q += (x[0] * x[0] + x[1] * x[1]) + (x[2] * x[2] + x[3] * x[3]); }
            q += __shfl_xor(q, 16); q += __shfl_xor(q, 32);
            if (fq == 0) P[(ai * 128 + wr * 64 + m * 16 + fr) * 4 + wc] = q;
        }
    __syncthreads();
    if (tid < 256) {
        const float t = (P[tid * 4 + 0] + P[tid * 4 + 1]) + (P[tid * 4 + 2] + P[tid * 4 + 3]);
        __hip_atomic_store(slots + ((size_t)(u.pm * 256 + tid) * 4 + u.pn), __float_as_uint(t), __ATOMIC_RELAXED, __HIP_MEMORY_SCOPE_AGENT);
    }
    asm volatile("s_waitcnt vmcnt(0)" ::: "memory");
    __syncthreads();
    if (tid == 0) {
        __hip_atomic_fetch_add(cnt, 1u, __ATOMIC_RELAXED, __HIP_MEMORY_SCOPE_AGENT);
        unsigned sp = 0;
        while (__hip_atomic_load(cnt, __ATOMIC_RELAXED, __HIP_MEMORY_SCOPE_AGENT) < 4u) { __builtin_amdgcn_s_sleep(1); if (++sp > (1u << 22)) break; }
        __builtin_amdgcn_fence(__ATOMIC_ACQUIRE, "agent");
        asm volatile("s_waitcnt vmcnt(0)" ::: "memory");
    }
    __syncthreads();
    if (tid < 256) {
        const unsigned* sl = slots + (size_t)(u.pm * 256 + tid) * 4;
        float t = 0.f;
#pragma unroll
        for (int k = 0; k < 4; ++k) t += __uint_as_float(__hip_atomic_load(sl + k, __ATOMIC_RELAXED, __HIP_MEMORY_SCOPE_AGENT));
        S[tid] = 1.0f / sqrtf(t * (1.0f / DM) + EPS);
    }
    __syncthreads();
}
struct EpiWoFused {
    static constexpr bool AFTER_DRAIN = true;
    Ctx c;
    __device__ __forceinline__ void fused(f32x4 (&acc)[2][2][4][2], const pg8::Unit& u, int wr, int wc, int fr, int fq, LAS unsigned char* lds, int tid) const {
        row_rms_exchange(c, 1, acc, u, wr, wc, fr, fq, lds, tid);
        const LAS float* S = (const LAS float*)(lds + 8192);
        bf16_t* MB = (bf16_t*)(c.ws + WS_ACT + A_M2); bf16_t* HN = (bf16_t*)(c.ws + WS_ACT + A_HN);
#pragma unroll
        for (int bj = 0; bj < 2; ++bj) {
            const int col = u.pn * 256 + bj * 128 + wc * 32 + 8 * fq;
            const f32x4 g0 = *(const f32x4*)(c.n_mix_post + col), g1 = *(const f32x4*)(c.n_mix_post + col + 4);
#pragma unroll
            for (int ai = 0; ai < 2; ++ai)
#pragma unroll
                for (int m = 0; m < 4; ++m) { const int rl = ai * 128 + wr * 64 + m * 16 + fr; const float rs = S[rl]; const size_t ro = (size_t)(u.pm * 256 + rl) * DM + col;
                    const f32x4 x0 = __builtin_nontemporal_load((const f32x4*)(c.xp + ro)), x1 = __builtin_nontemporal_load((const f32x4*)(c.xp + ro + 4));
                    const f32x4 h0 = x0 + acc[ai][bj][m][0] * rs * g0, h1 = x1 + acc[ai][bj][m][1] * rs * g1;
                    acc[ai][bj][m][0] = h0; acc[ai][bj][m][1] = h1;
                    u32x4 w; w.x = pk2(h0[0], h0[1]); w.y = pk2(h0[2], h0[3]); w.z = pk2(h1[0], h1[1]); w.w = pk2(h1[2], h1[3]);
                    *(u32x4*)(MB + ro) = w; }
        }
        row_rms_exchange(c, 2, acc, u, wr, wc, fr, fq, lds, tid);
#pragma unroll
        for (int bj = 0; bj < 2; ++bj) {
            const int col = u.pn * 256 + bj * 128 + wc * 32 + 8 * fq;
            const f32x4 g0 = *(const f32x4*)(c.n_ffn_pre + col), g1 = *(const f32x4*)(c.n_ffn_pre + col + 4);
#pragma unroll
            for (int ai = 0; ai < 2; ++ai)
#pragma unroll
                for (int m = 0; m < 4; ++m) { const int rl = ai * 128 + wr * 64 + m * 16 + fr; const float rs = S[rl]; const size_t ro = (size_t)(u.pm * 256 + rl) * DM + col;
                    const f32x4 a = acc[ai][bj][m][0] * rs * g0, b = acc[ai][bj][m][1] * rs * g1;
                    u32x4 w; w.x = pk2(a[0], a[1]); w.y = pk2(a[2], a[3]); w.z = pk2(b[0], b[1]); w.w = pk2(b[2], b[3]);
                    *(u32x4*)(HN + ro) = w; }
        }
    }
};

__device__ __forceinline__ float small_rms_exchange(const Ctx& c, int set, int mt, int ng, int lane, const f32x4& s0, const f32x4& s1) {
    const int fr = lane & 15, fq = lane >> 4;
    unsigned* slots = (unsigned*)(c.ws + WS_XCHS) + (size_t)((set * 8 + mt) * 16) * 32;
    unsigned* cnt = (unsigned*)(c.ws + WS_CTL + CTL_XCNTS) + (size_t)(set * 8 + mt) * 64;
    float q = ((s0[0] * s0[0] + s0[1] * s0[1]) + (s0[2] * s0[2] + s0[3] * s0[3])) + ((s1[0] * s1[0] + s1[1] * s1[1]) + (s1[2] * s1[2] + s1[3] * s1[3]));
    q += __shfl_xor(q, 16); q += __shfl_xor(q, 32);
    if (fq == 0) __hip_atomic_store(slots + fr * 32 + ng, __float_as_uint(q), __ATOMIC_RELAXED, __HIP_MEMORY_SCOPE_AGENT);
    asm volatile("s_waitcnt vmcnt(0)" ::: "memory");
    if (lane == 0) {
        __hip_atomic_fetch_add(cnt, 1u, __ATOMIC_RELAXED, __HIP_MEMORY_SCOPE_AGENT);
        unsigned sp = 0;
        while (__hip_atomic_load(cnt, __ATOMIC_RELAXED, __HIP_MEMORY_SCOPE_AGENT) < 32u) { __builtin_amdgcn_s_sleep(1); if (++sp > (1u << 22)) break; }
    }
    __builtin_amdgcn_fence(__ATOMIC_ACQUIRE, "agent");
    asm volatile("s_waitcnt vmcnt(0)" ::: "memory");
    float t = 0.f;
#pragma unroll
    for (int k = 0; k < 8; ++k) t += __uint_as_float(__hip_atomic_load(slots + fr * 32 + fq * 8 + k, __ATOMIC_RELAXED, __HIP_MEMORY_SCOPE_AGENT));
    t += __shfl_xor(t, 16); t += __shfl_xor(t, 32);
    return 1.0f / sqrtf(t * (1.0f / DM) + EPS);
}
template <int KIND>
__device__ __forceinline__ void small_fused(const Ctx& c, int mt, int ng, int lane, f32x4 s0, f32x4 s1) {
    const int fr = lane & 15, fq = lane >> 4, col = ng * 32 + 8 * fq;
    const size_t ro = (size_t)(MP + mt * 16 + fr) * DM + col;
    bf16_t* MB = (bf16_t*)(c.ws + WS_ACT + A_M2);
    if constexpr (KIND == EK_WO) {
        const float rs = small_rms_exchange(c, 0, mt, ng, lane, s0, s1);
        const float* xr = c.xs + (size_t)(mt * 16 + fr) * DM + col;
        const f32x4 g0 = *(const f32x4*)(c.n_mix_post + col), g1 = *(const f32x4*)(c.n_mix_post + col + 4);
        const f32x4 h0 = *(const f32x4*)xr + s0 * rs * g0, h1 = *(const f32x4*)(xr + 4) + s1 * rs * g1;
        u32x4 w; w.x = pk2(h0[0], h0[1]); w.y = pk2(h0[2], h0[3]); w.z = pk2(h1[0], h1[1]); w.w = pk2(h1[2], h1[3]);
        *(u32x4*)(MB + ro) = w;
        const float rs2 = small_rms_exchange(c, 1, mt, ng, lane, h0, h1);
        const f32x4 p0 = *(const f32x4*)(c.n_ffn_pre + col), p1 = *(const f32x4*)(c.n_ffn_pre + col + 4);
        const f32x4 a = h0 * rs2 * p0, b = h1 * rs2 * p1;
        u32x4 v; v.x = pk2(a[0], a[1]); v.y = pk2(a[2], a[3]); v.z = pk2(b[0], b[1]); v.w = pk2(b[2], b[3]);
        *(u32x4*)((bf16_t*)(c.ws + WS_ACT + A_HN) + ro) = v;
    } else {
        const float rs = small_rms_exchange(c, 2, mt, ng, lane, s0, s1);
        const u32x4 hw = *(const u32x4*)(MB + ro);
        const f32x4 h0 = {bflo(hw.x), bfhi(hw.x), bflo(hw.y), bfhi(hw.y)}, h1 = {bflo(hw.z), bfhi(hw.z), bflo(hw.w), bfhi(hw.w)};
        const f32x4 g0 = *(const f32x4*)(c.n_ffn_post + col), g1 = *(const f32x4*)(c.n_ffn_post + col + 4);
        float* p = c.out + ro;
        *(f32x4*)p = h0 + s0 * rs * g0; *(f32x4*)(p + 4) = h1 + s1 * rs * g1;
    }
}

struct EpiDnFused {
    static constexpr bool AFTER_DRAIN = true;
    Ctx c;
    __device__ __forceinline__ void fused(const f32x4 (&acc)[2][2][4][2], const pg8::Unit& u, int wr, int wc, int fr, int fq, LAS unsigned char* lds, int tid) const {
        row_rms_exchange(c, 0, acc, u, wr, wc, fr, fq, lds, tid);
        const LAS float* S = (const LAS float*)(lds + 8192);
#pragma unroll
        for (int bj = 0; bj < 2; ++bj) {
            const int col = u.pn * 256 + bj * 128 + wc * 32 + 8 * fq;
            const f32x4 g0 = *(const f32x4*)(c.n_ffn_post + col), g1 = *(const f32x4*)(c.n_ffn_post + col + 4);
#pragma unroll
            for (int ai = 0; ai < 2; ++ai)
#pragma unroll
                for (int m = 0; m < 4; ++m) { const int rl = ai * 128 + wr * 64 + m * 16 + fr; const float rs = S[rl];
                    float* p = c.out + (size_t)(u.pm * 256 + rl) * DM + col;
                    const u32x4 hw = __builtin_nontemporal_load((const u32x4*)((const bf16_t*)(c.ws + WS_ACT + A_M2) + (size_t)(u.pm * 256 + rl) * DM + col));
                    const f32x4 h0 = {bflo(hw.x), bfhi(hw.x), bflo(hw.y), bfhi(hw.y)}, h1 = {bflo(hw.z), bfhi(hw.z), bflo(hw.w), bfhi(hw.w)};
                    __builtin_nontemporal_store(h0 + acc[ai][bj][m][0] * rs * g0, (f32x4*)p); __builtin_nontemporal_store(h1 + acc[ai][bj][m][1] * rs * g1, (f32x4*)(p + 4)); }
        }
    }
};

template <int KIND, int N, int K, int NI, class BigEpi = Epi<KIND>, bool ALIGN = false, bool HNORM = false>
__device__ __forceinline__ void gemm_all(const Ctx& c, LAS unsigned char* lds, const bf16_t* A, const bf16_t* Bt) {
    {
    {
    pg8::StaticOrder S; S.init(MP, N, gridDim.x, blockIdx.x);
    BigEpi E{c};
    pg8::Gemm g{A, Bt, MP, N, K, (const float*)(c.ws + WS_SSQ)};
    pg8::gemm_phase<BigEpi, ALIGN, true, HNORM>(lds, g, S, E);
    __syncthreads();
    }
    {
    const int tid = otid(), wid = __builtin_amdgcn_readfirstlane(tid >> 6), lane = tid & 63, fr = lane & 15, fq = lane >> 4;
    LAS f32x4* red = (LAS f32x4*)lds;
    constexpr int nitems = 8 * (N / 32), kw = K / 8, KS = kw / 32, KB = KS > 4 ? 4 : KS;
    const unsigned toff = (unsigned)((fr * K + wid * kw + 8 * fq) * 2);
    const unsigned tb0 = (unsigned)((pg8::perm32(fr) * K + wid * kw + 8 * fq) * 2), tb1 = (unsigned)((pg8::perm32(16 + fr) * K + wid * kw + 8 * fq) * 2);
    for (int base = blockIdx.x * NI; base < nitems; base += gridDim.x * NI) {
        f32x4 a0[NI], a1[NI];
#pragma unroll
        for (int q = 0; q < NI; ++q) { a0[q] = (f32x4){0.f, 0.f, 0.f, 0.f}; a1[q] = (f32x4){0.f, 0.f, 0.f, 0.f}; }
#pragma unroll 1
        for (int k0 = 0; k0 < KS; k0 += KB) {
            bf16x8 af[NI][KB], b0[NI][KB], b1[NI][KB];
#pragma unroll
            for (int q = 0; q < NI; ++q) { const int item = base + q, mt = item & 7, ng = item >> 3;
                const char* ap = (const char*)(A + (size_t)(MP + mt * 16) * K) + (size_t)k0 * 64; const char* bp = (const char*)(Bt + (size_t)(ng * 32) * K) + (size_t)k0 * 64;
#pragma unroll
                for (int ks = 0; ks < KB; ++ks) { af[q][ks] = *(const bf16x8*)(ap + ks * 64 + toff); b0[q][ks] = *(const bf16x8*)(bp + ks * 64 + tb0); b1[q][ks] = *(const bf16x8*)(bp + ks * 64 + tb1); } }
#pragma unroll
            for (int q = 0; q < NI; ++q)
#pragma unroll
                for (int ks = 0; ks < KB; ++ks) { a0[q] = __builtin_amdgcn_mfma_f32_16x16x32_bf16(b0[q][ks], af[q][ks], a0[q], 0, 0, 0); a1[q] = __builtin_amdgcn_mfma_f32_16x16x32_bf16(b1[q][ks], af[q][ks], a1[q], 0, 0, 0); }
        }
#pragma unroll
        for (int q = 0; q < NI; ++q) { red[((q * 8 + wid) * 2 + 0) * 64 + lane] = a0[q]; red[((q * 8 + wid) * 2 + 1) * 64 + lane] = a1[q]; }
        __syncthreads();
        if (wid < NI && base + wid < nitems) {
            f32x4 s0 = red[((wid * 8) * 2 + 0) * 64 + lane], s1 = red[((wid * 8) * 2 + 1) * 64 + lane];
#pragma unroll
            for (int w = 1; w < 8; ++w) { s0 += red[((wid * 8 + w) * 2 + 0) * 64 + lane]; s1 += red[((wid * 8 + w) * 2 + 1) * 64 + lane]; }
            const int item = base + wid, mt = item & 7, ng = item >> 3;
            if constexpr (KIND == EK_WO || KIND == EK_DN) small_fused<KIND>(c, mt, ng, lane, s0, s1);
            else epi8<KIND>(c, MP + mt * 16 + fr, ng * 32 + 8 * fq, s0, s1);
        }
        __syncthreads();
    }
    }
    }
}

__device__ __forceinline__ int map_in(int n) {
    if (n < 512) return 2 * n;
    if (n < 1024) return 2 * (n - 512) + 1;
    if (n < 2048) { const int base = n < 1536 ? 1024 : 1536, cc = n - base, h = cc >> 7, d = cc & 127; return base + h * 128 + 2 * (d & 63) + (d >> 6); }
    return n;
}
struct WItem { const float* W; bf16_t* WT; int K, N, r; bool mapin; };
__device__ __forceinline__ void wt_load(const WItem& w, int lane, f32x4 (&v)[8]) {
    const int nblk = w.N / 32, kb = w.r / nblk, nb = w.r % nblk, k0 = 64 * kb, n0 = 32 * nb, kr = lane >> 3, seg = lane & 7;
    const float* wp = w.W + (size_t)(k0 + kr) * w.N + n0 + seg * 4;
#pragma unroll
    for (int i = 0; i < 8; ++i) v[i] = __builtin_nontemporal_load((const f32x4*)(wp + (size_t)(8 * i) * w.N));
}
__device__ __forceinline__ void wt_finish(const WItem& w, int lane, const f32x4 (&v)[8], LAS float* scr) {
    const int nblk = w.N / 32, kb = w.r / nblk, nb = w.r % nblk, k0 = 64 * kb, n0 = 32 * nb, kr = lane >> 3, seg = lane & 7;
#pragma unroll
    for (int i = 0; i < 8; ++i) { LAS float* d = scr + (8 * i + kr) * 33 + seg * 4; d[0] = v[i][0]; d[1] = v[i][1]; d[2] = v[i][2]; d[3] = v[i][3]; }
    LDS_WAIT();
    const int ch = lane & 7;
#pragma unroll
    for (int j = 0; j < 4; ++j) { const int n = (lane >> 3) + 8 * j; const LAS float* s = scr + (8 * ch) * 33 + n;
        u32x4 o; o.x = pk2(s[0 * 33], s[1 * 33]); o.y = pk2(s[2 * 33], s[3 * 33]); o.z = pk2(s[4 * 33], s[5 * 33]); o.w = pk2(s[6 * 33], s[7 * 33]);
        const int dn = w.mapin ? map_in(n0 + n) : (n0 + n);
        *(u32x4*)(w.WT + (size_t)dn * w.K + k0 + 8 * ch) = o; }
    LDS_WAIT();
}
constexpr int WI_IN = (DM / 64) * (NIN / 32);
constexpr int WI_CO = (CD / 64) * (DM / 32), WI_RO = (DM / 64) * (DM / 32), WI_O = WI_RO, WI_UP = (DM / 64) * (FF / 32), WI_DN = (FF / 64) * (DM / 32);
constexpr int WI_TOTAL = WI_IN + WI_CO + WI_RO + WI_O + WI_UP + WI_DN;

__device__ __forceinline__ void wt_pair(const Ctx& c, int p, int lane, LAS float* scr) {
    int r = 2 * p; WItem w;
    if (r < WI_IN) { w.W = c.w_in; w.WT = (bf16_t*)(c.ws + WS_WIN); w.K = DM; w.N = NIN; w.mapin = true; }
    else if ((r -= WI_IN) < WI_CO) { w.W = c.w_co; w.WT = (bf16_t*)(c.ws + WS_WCO); w.K = CD; w.N = DM; w.mapin = false; }
    else if ((r -= WI_CO) < WI_RO) { w.W = c.w_ro; w.WT = (bf16_t*)(c.ws + WS_WRO); w.K = DM; w.N = DM; w.mapin = false; }
    else if ((r -= WI_RO) < WI_O) { w.W = c.w_o; w.WT = (bf16_t*)(c.ws + WS_WO); w.K = DM; w.N = DM; w.mapin = false; }
    else if ((r -= WI_O) < WI_UP) { w.W = c.w_up; w.WT = (bf16_t*)(c.ws + WS_WUP); w.K = DM; w.N = FF; w.mapin = false; }
    else { r -= WI_UP; w.W = c.w_dn; w.WT = (bf16_t*)(c.ws + WS_WDN); w.K = FF; w.N = DM; w.mapin = false; }
    WItem w1 = w; w.r = r; w1.r = r + 1;
    f32x4 va[8], vb[8];
    wt_load(w, lane, va); wt_load(w1, lane, vb);
    wt_finish(w, lane, va, scr); wt_finish(w1, lane, vb, scr);
}
__device__ __forceinline__ void rms_rows4_to_bf16(const Ctx& c, int row0, int stride, const float* w, bf16_t* XN, int lane) {
    f32x4 v[4][4];
#pragma unroll
    for (int r = 0; r < 4; ++r) { const int row = row0 + r * stride;
        if (row < RT) { const float* x = xrow(c, row);
#pragma unroll
            for (int j = 0; j < 4; ++j) v[r][j] = __builtin_nontemporal_load((const f32x4*)x + 64 * j + lane); } }
#pragma unroll
    for (int r = 0; r < 4; ++r) { const int row = row0 + r * stride;
        if (row < RT) { float s = 0.f;
#pragma unroll
            for (int j = 0; j < 4; ++j) s += (v[r][j].x * v[r][j].x + v[r][j].y * v[r][j].y) + (v[r][j].z * v[r][j].z + v[r][j].w * v[r][j].w);
            const float rs = 1.0f / sqrtf(wave_sum(s) * (1.0f / DM) + EPS);
#pragma unroll
            for (int j = 0; j < 4; ++j) { const f32x4 g = *((const f32x4*)w + 64 * j + lane);
                u32x2 p; p.x = pk2(v[r][j].x * rs * g.x, v[r][j].y * rs * g.y); p.y = pk2(v[r][j].z * rs * g.z, v[r][j].w * rs * g.w);
                *((u32x2*)(XN + (size_t)row * DM) + 64 * j + lane) = p; } } }
}
__device__ __forceinline__ void phase0(const Ctx& c, LAS unsigned char* lds) {
    const int tid = otid(), wid = __builtin_amdgcn_readfirstlane(tid >> 6), lane = tid & 63;
    if (blockIdx.x == 0 && tid < 64) {
        const float xi = (float)tid / 63.0f;
        const float p = (float)exp((double)xi * 9.210340371976184);
        ((float*)(c.ws + WS_CTL + 256))[tid] = 1.0f / p;
    }
    LAS float* scr = (LAS float*)(lds + wid * 16384);
    const int gw = blockIdx.x * 8 + wid, NGW = gridDim.x * 8;
    bf16_t* XN = (bf16_t*)c.out;
    for (int row = gw; row < RT; row += 4 * NGW) rms_rows4_to_bf16(c, row, NGW, c.n_mix_pre, XN, lane);
    for (int p = gw; p < WI_IN / 2; p += NGW) wt_pair(c, p, lane, scr);
}

__device__ __forceinline__ void ret_prompt_item(const Ctx& c, LAS unsigned char* lds, int item) {
    const int tid = otid(), wid = __builtin_amdgcn_readfirstlane(tid >> 6), lane = tid & 63, fr = lane & 15, fq = lane >> 4;
    const int s = item & 3, h = (item >> 2) & 3, b = item >> 4;
    const float l2g = log2f(1.0f - exp2f(-5.0f - (float)h));
    unsigned char* act = c.ws + WS_ACT;
    const bf16_t* Q = (const bf16_t*)(act + A_Q); const bf16_t* Kg = (const bf16_t*)(act + A_K); const bf16_t* V = (const bf16_t*)(act + A_V); bf16_t* OB = (bf16_t*)c.out;
    float* SSQ = (float*)(c.ws + WS_SSQ);
    constexpr int LD = 136;
    LAS bf16_t* sQ = (LAS bf16_t*)lds; LAS bf16_t* sK = sQ + 128 * LD; LAS bf16_t* sKT = sK + 128 * LD; LAS bf16_t* sVT = sKT + 128 * LD; LAS bf16_t* sST = sVT + 64 * LD;
    for (int i = tid; i < 64 * LD / 2; i += 512) ((LAS unsigned*)sST)[i] = 0u;
    f32x4 Sacc[4];
#pragma unroll
    for (int e = 0; e < 4; ++e) Sacc[e] = (f32x4){0.f, 0.f, 0.f, 0.f};
    const float gC = exp2f(128.0f * l2g);
    const int il = 16 * wid + fr;
    u32x4 rq[4], rk[4]; unsigned kv[16], vv[8]; u32x2 sgv[4], sgc[4];
    const bf16_t* SGp = (const bf16_t*)(act + A_SG);
    const int dp = tid & 63, ep = tid & 31, jgv = tid >> 5;
    const int jgk = wid;
    const unsigned toq = (unsigned)(((tid >> 4) * 512 + (tid & 15) * 8) * 2);
    const unsigned tok = (unsigned)(2 * dp * 2);
    const unsigned tov = (unsigned)(((jgv * 8) * 1024 + 2 * ep) * 2);
    const unsigned tosg = (unsigned)((il * 1024 + 4 * fq) * 2);
#define RET_LOAD(CH) do { const size_t r0_ = (size_t)b * SEQ + (size_t)(CH) * 128; \
        const char* qb_ = (const char*)(Q + r0_ * 512 + h * 128); const char* kb_ = (const char*)(Kg + r0_ * 512 + h * 128); \
        const char* kt_ = (const char*)(Kg + (r0_ + jgk * 16) * 512 + h * 128); const char* vb_ = (const char*)(V + r0_ * 1024 + h * 256 + s * 64); \
        _Pragma("unroll") for (int i = 0; i < 4; ++i) { rq[i] = *(const u32x4*)(qb_ + (size_t)i * 32768 + toq); rk[i] = *(const u32x4*)(kb_ + (size_t)i * 32768 + toq); } \
        _Pragma("unroll") for (int jj = 0; jj < 16; ++jj) kv[jj] = *(const unsigned*)(kt_ + (size_t)jj * 1024 + tok); \
        _Pragma("unroll") for (int jj = 0; jj < 8; ++jj) vv[jj] = *(const unsigned*)(vb_ + (size_t)jj * 2048 + tov); \
        const char* sg_ = (const char*)(SGp + r0_ * 1024 + h * 256 + s * 64); \
        _Pragma("unroll") for (int et = 0; et < 4; ++et) sgv[et] = *(const u32x2*)(sg_ + (size_t)et * 32 + tosg); } while (0)
    RET_LOAD(0);
    for (int ch = 0; ch < SEQ / 128; ++ch) {
        const size_t r0 = (size_t)b * SEQ + (size_t)ch * 128;
#pragma unroll
        for (int i = 0; i < 4; ++i) { const int id = tid + 512 * i, row = id >> 4, cq = id & 15;
            *(LAS u32x4*)(sQ + row * LD + cq * 8) = rq[i]; *(LAS u32x4*)(sK + row * LD + cq * 8) = rk[i]; }
        {
            unsigned lo[8], hi[8];
#pragma unroll
            for (int jj = 0; jj < 16; jj += 2) {
                const float d0 = exp2f((float)(127 - (jgk * 16 + jj)) * l2g), d1 = exp2f((float)(127 - (jgk * 16 + jj + 1)) * l2g);
                lo[jj >> 1] = pk2(bflo(kv[jj]) * d0, bflo(kv[jj + 1]) * d1); hi[jj >> 1] = pk2(bfhi(kv[jj]) * d0, bfhi(kv[jj + 1]) * d1);
            }
            LAS u32x4* p0 = (LAS u32x4*)(sKT + (2 * dp) * LD + jgk * 16); LAS u32x4* p1 = (LAS u32x4*)(sKT + (2 * dp + 1) * LD + jgk * 16);
            p0[0] = (u32x4){lo[0], lo[1], lo[2], lo[3]}; p0[1] = (u32x4){lo[4], lo[5], lo[6], lo[7]};
            p1[0] = (u32x4){hi[0], hi[1], hi[2], hi[3]}; p1[1] = (u32x4){hi[4], hi[5], hi[6], hi[7]};
        }
        {
            u32x4 lo, hi;
            lo.x = (vv[0] & 0xffffu) | (vv[1] << 16); lo.y = (vv[2] & 0xffffu) | (vv[3] << 16); lo.z = (vv[4] & 0xffffu) | (vv[5] << 16); lo.w = (vv[6] & 0xffffu) | (vv[7] << 16);
            hi.x = (vv[0] >> 16) | (vv[1] & 0xffff0000u); hi.y = (vv[2] >> 16) | (vv[3] & 0xffff0000u); hi.z = (vv[4] >> 16) | (vv[5] & 0xffff0000u); hi.w = (vv[6] >> 16) | (vv[7] & 0xffff0000u);
            *(LAS u32x4*)(sVT + (2 * ep) * LD + jgv * 8) = lo; *(LAS u32x4*)(sVT + (2 * ep + 1) * LD + jgv * 8) = hi;
        }
#pragma unroll
        for (int et = 0; et < 4; ++et) sgc[et] = sgv[et];
        if (ch + 1 < SEQ / 128) RET_LOAD(ch + 1);
        __syncthreads();
        bf16x8 qf[4];
#pragma unroll
        for (int ks = 0; ks < 4; ++ks) qf[ks] = *(const LAS bf16x8*)(sQ + il * LD + ks * 32 + fq * 8);
        f32x4 sc[8];
#pragma unroll
        for (int jp = 0; jp < 8; jp += 2) {
            bf16x8 kf[2][4];
#pragma unroll
            for (int t = 0; t < 2; ++t)
#pragma unroll
                for (int ks = 0; ks < 4; ++ks) kf[t][ks] = *(const LAS bf16x8*)(sK + ((jp + t) * 16 + fr) * LD + ks * 32 + fq * 8);
#pragma unroll
            for (int t = 0; t < 2; ++t) { sc[jp + t] = (f32x4){0.f, 0.f, 0.f, 0.f};
#pragma unroll
                for (int ks = 0; ks < 4; ++ks) sc[jp + t] = __builtin_amdgcn_mfma_f32_16x16x32_bf16(kf[t][ks], qf[ks], sc[jp + t], 0, 0, 0); }
        }
        __syncthreads();
#pragma unroll
        for (int jt = 0; jt < 8; ++jt) { float pv[4];
#pragma unroll
            for (int jj = 0; jj < 4; ++jj) { const int df = il - (jt * 16 + 4 * fq + jj); pv[jj] = df >= 0 ? sc[jt][jj] * exp2f((float)df * l2g) : 0.f; }
            u32x2 w; w.x = pk2(pv[0], pv[1]); w.y = pk2(pv[2], pv[3]);
            *(LAS u32x2*)(sK + il * LD + jt * 16 + 4 * fq) = w; }
        LDS_WAIT(); __builtin_amdgcn_wave_barrier();
        f32x4 o[4];
#pragma unroll
        for (int ep2 = 0; ep2 < 4; ep2 += 2) {
            bf16x8 sf[2][4];
#pragma unroll
            for (int t = 0; t < 2; ++t)
#pragma unroll
                for (int ks = 0; ks < 4; ++ks) sf[t][ks] = *(const LAS bf16x8*)(sST + ((ep2 + t) * 16 + fr) * LD + ks * 32 + fq * 8);
#pragma unroll
            for (int t = 0; t < 2; ++t) { o[ep2 + t] = (f32x4){0.f, 0.f, 0.f, 0.f};
#pragma unroll
                for (int ks = 0; ks < 4; ++ks) o[ep2 + t] = __builtin_amdgcn_mfma_f32_16x16x32_bf16(sf[t][ks], qf[ks], o[ep2 + t], 0, 0, 0); }
        }
        const float qd = exp2f((float)(il + 1) * l2g);
#pragma unroll
        for (int et = 0; et < 4; ++et) { o[et] *= qd; Sacc[et] *= gC; }
#pragma unroll
        for (int k2 = 0; k2 < 4; k2 += 2) {
            bf16x8 pf[2], kf[2], vf[2][4];
#pragma unroll
            for (int t = 0; t < 2; ++t) { const int ks = k2 + t;
                pf[t] = *(const LAS bf16x8*)(sK + il * LD + ks * 32 + fq * 8); kf[t] = *(const LAS bf16x8*)(sKT + il * LD + ks * 32 + fq * 8);
#pragma unroll
                for (int et = 0; et < 4; ++et) vf[t][et] = *(const LAS bf16x8*)(sVT + (et * 16 + fr) * LD + ks * 32 + fq * 8); }
#pragma unroll
            for (int t = 0; t < 2; ++t)
#pragma unroll
                for (int et = 0; et < 4; ++et) { o[et] = __builtin_amdgcn_mfma_f32_16x16x32_bf16(vf[t][et], pf[t], o[et], 0, 0, 0);
                    Sacc[et] = __builtin_amdgcn_mfma_f32_16x16x32_bf16(kf[t], vf[t][et], Sacc[et], 0, 0, 0); }
        }
        float ss = 0.f;
#pragma unroll
        for (int et = 0; et < 4; ++et) { ss += (o[et][0] * o[et][0] + o[et][1] * o[et][1]) + (o[et][2] * o[et][2] + o[et][3] * o[et][3]);
            u32x2 w; w.x = pk2(o[et][0] * bflo(sgc[et].x), o[et][1] * bfhi(sgc[et].x)); w.y = pk2(o[et][2] * bflo(sgc[et].y), o[et][3] * bfhi(sgc[et].y));
            *(u32x2*)(OB + (r0 + il) * 1024 + h * 256 + s * 64 + et * 16 + 4 * fq) = w; }
        ss += __shfl_xor(ss, 16); ss += __shfl_xor(ss, 32);
        if (fq == 0) SSQ[(r0 + il) * 16 + h * 4 + s] = ss;
        __syncthreads();
#pragma unroll
        for (int et = 0; et < 4; ++et) { u32x2 w; w.x = pk2(Sacc[et][0], Sacc[et][1]); w.y = pk2(Sacc[et][2], Sacc[et][3]);
            *(LAS u32x2*)(sST + (et * 16 + fr) * LD + 16 * wid + 4 * fq) = w; }
    }
    float* nrp = c.out + O_NRP + ((size_t)(b * NH + h) * DK) * DV + s * 64;
#pragma unroll
    for (int et = 0; et < 4; ++et)
#pragma unroll
        for (int jj = 0; jj < 4; ++jj) nrp[(size_t)(16 * wid + 4 * fq + jj) * DV + et * 16 + fr] = Sacc[et][jj];
    __syncthreads();
#undef RET_LOAD
}

__device__ __forceinline__ float block_sum(float v, LAS float* red, int tid) {
    v = wave_sum(v);
    __syncthreads();
    if ((tid & 63) == 0) red[tid >> 6] = v;
    __syncthreads();
    float t = 0.f;
#pragma unroll
    for (int w = 0; w < 8; ++w) t += red[w];
    return t;
}

__device__ __forceinline__ void ret_sample_item(const Ctx& c, LAS unsigned char* lds, int item) {
    const int tid = otid(), b = item >> 2, h = item & 3, row = MP + b;
    unsigned char* act = c.ws + WS_ACT;
    const bf16_t* Q = (const bf16_t*)(act + A_Q) + (size_t)row * 512 + h * 128; const bf16_t* Kg = (const bf16_t*)(act + A_K) + (size_t)row * 512 + h * 128;
    const bf16_t* V = (const bf16_t*)(act + A_V) + (size_t)row * 1024 + h * 256; bf16_t* OB = (bf16_t*)c.out + (size_t)row * 1024 + h * 256;
    LAS float* sq = (LAS float*)lds; LAS float* sk = sq + 128; LAS float* red = sk + 128; LAS float* part = red + 16;
    if (tid < 128) sq[tid] = bf2f(Q[tid]); else if (tid < 256) sk[tid - 128] = bf2f(Kg[tid - 128]);
    __syncthreads();
    const float g = 1.0f - exp2f(-5.0f - (float)h);
    const int e4 = (tid & 63) * 4, dg = tid >> 6;
    const u32x2 vw = *(const u32x2*)(V + e4);
    const f32x4 vv = {bflo(vw.x), bfhi(vw.x), bflo(vw.y), bfhi(vw.y)};
    const float* Sin = c.state_ret + ((size_t)(b * NH + h) * DK + dg * 16) * DV + e4;
    float* Sout = c.out + O_NRS + ((size_t)(b * NH + h) * DK + dg * 16) * DV + e4;
    f32x4 oa = {0.f, 0.f, 0.f, 0.f};
    f32x4 sv[16];
#pragma unroll
    for (int dd = 0; dd < 16; ++dd) sv[dd] = __builtin_nontemporal_load((const f32x4*)(Sin + (size_t)dd * DV));
#pragma unroll
    for (int dd = 0; dd < 16; ++dd) { const float kd = sk[dg * 16 + dd], qd = sq[dg * 16 + dd];
        const f32x4 sn = sv[dd] * g + vv * kd; __builtin_nontemporal_store(sn, (f32x4*)(Sout + (size_t)dd * DV)); oa += sn * qd; }
    *(LAS f32x4*)(part + dg * 256 + e4) = oa;
    __syncthreads();
    float ov = 0.f;
    if (tid < 256) {
#pragma unroll
        for (int w = 0; w < 8; ++w) ov += part[w * 256 + tid];
    }
    const float tot = block_sum(ov * ov, red, tid);
    const float rs = 1.0f / sqrtf(tot * (1.0f / DV) + EPS);
    if (tid < 256) OB[tid] = (bf16_t)(pk2(bf2f(((const bf16_t*)(act + A_SG))[(size_t)row * 1024 + h * 256 + tid]) * ov * rs, 0.f) & 0xffffu);
    __syncthreads();
}

__device__ __forceinline__ void conv_prompt_item(const Ctx& c, LAS unsigned char* lds, int item) {
    const int tid = otid(), wid = tid >> 6, lane = tid & 63, b = item >> 6, t0 = (item & 63) * 32;
    unsigned char* act = c.ws + WS_ACT;
    const bf16_t* U = (const bf16_t*)(act + A_U) + (size_t)b * SEQ * 512; bf16_t* AA = (bf16_t*)(act + A_AACT) + (size_t)b * SEQ * 512;
    LAS bf16_t* sU = (LAS bf16_t*)lds; LAS float* sC = (LAS float*)(lds + 63488);
    {
        u32x4 uv[8];
#pragma unroll
        for (int i = 0; i < 8; ++i) { const int id = tid + 512 * i, lr = id >> 6, cq = id & 63, t = t0 - 30 + lr;
            uv[i] = (u32x4){0u, 0u, 0u, 0u}; if (t >= 0 && lr < 62) uv[i] = __builtin_nontemporal_load((const u32x4*)(U + (size_t)t * 512 + cq * 8)); }
#pragma unroll
        for (int i = 0; i < 8; ++i) { const int id = tid + 512 * i, lr = id >> 6, cq = id & 63;
            if (lr < 62) *(LAS u32x4*)(sU + lr * 512 + cq * 8) = uv[i]; }
    }
    float wreg[CW];
#pragma unroll
    for (int w = 0; w < CW; ++w) wreg[w] = c.w_dw[w * CD + tid];
    const float bias = c.b_dw[tid];
    __syncthreads();
#pragma unroll 1
    for (int tb = 0; tb < 4; ++tb) {
        float a[8];
#pragma unroll
        for (int o = 0; o < 8; ++o) a[o] = bias;
#pragma unroll
        for (int k = 0; k < 38; ++k) { const float u = bf2f(sU[(tb * 8 + k) * 512 + tid]);
#pragma unroll
            for (int o = 0; o < 8; ++o) { const int w = k - o; if (w >= 0 && w < CW) a[o] += u * wreg[w]; } }
#pragma unroll
        for (int o = 0; o < 8; ++o) sC[(tb * 8 + o) * 512 + tid] = a[o];
    }
    __syncthreads();
    const f32x4 g0 = *(const f32x4*)(c.ln_w + lane * 4), g1 = *(const f32x4*)(c.ln_w + 256 + lane * 4), b0 = *(const f32x4*)(c.ln_b + lane * 4), b1 = *(const f32x4*)(c.ln_b + 256 + lane * 4);
    for (int rr = wid; rr < 32; rr += 8) {
        f32x4 x0 = *(const LAS f32x4*)(sC + rr * 512 + lane * 4), x1 = *(const LAS f32x4*)(sC + rr * 512 + 256 + lane * 4);
        const float mean = wave_sum((x0.x + x0.y) + (x0.z + x0.w) + (x1.x + x1.y) + (x1.z + x1.w)) * (1.0f / CD);
        x0 -= mean; x1 -= mean;
        const float var = wave_sum((x0.x * x0.x + x0.y * x0.y) + (x0.z * x0.z + x0.w * x0.w) + (x1.x * x1.x + x1.y * x1.y) + (x1.z * x1.z + x1.w * x1.w)) * (1.0f / CD);
        const float rstd = 1.0f / sqrtf(var + EPS);
        f32x4 y0 = x0 * rstd * g0 + b0, y1 = x1 * rstd * g1 + b1;
#pragma unroll
        for (int j = 0; j < 4; ++j) { y0[j] = y0[j] * sigm(y0[j]); y1[j] = y1[j] * sigm(y1[j]); }
        u32x2 w0, w1; w0.x = pk2(y0.x, y0.y); w0.y = pk2(y0.z, y0.w); w1.x = pk2(y1.x, y1.y); w1.y = pk2(y1.z, y1.w);
        bf16_t* dst = AA + (size_t)(t0 + rr) * 512;
        *(u32x2*)(dst + lane * 4) = w0; *(u32x2*)(dst + 256 + lane * 4) = w1;
    }
    if (t0 == SEQ - 32) {
        float* ncp = c.out + O_NCP + (size_t)b * 30 * CD;
        for (int id = tid; id < 30 * CD; id += 512) ncp[id] = bf2f(sU[(32 + (id >> 9)) * 512 + (id & 511)]);
    }
    __syncthreads();
}

__device__ __forceinline__ void conv_sample_item(const Ctx& c, LAS unsigned char* lds, int b) {
    const int tid = otid();
    unsigned char* act = c.ws + WS_ACT;
    LAS float* red = (LAS float*)lds;
    const float* cache = c.cache_conv + (size_t)b * 30 * CD; float* ncs = c.out + O_NCS + (size_t)b * 30 * CD;
    float acc = c.b_dw[tid];
#pragma unroll 1
    for (int w0 = 0; w0 < 30; w0 += 10) {
        float cv[10], wv[10];
#pragma unroll
        for (int w = 0; w < 10; ++w) { cv[w] = __builtin_nontemporal_load(cache + (w0 + w) * CD + tid); wv[w] = c.w_dw[(w0 + w) * CD + tid]; }
#pragma unroll
        for (int w = 0; w < 10; ++w) { acc += cv[w] * wv[w]; if (w0 + w >= 1) __builtin_nontemporal_store(cv[w], ncs + (w0 + w - 1) * CD + tid); }
    }
    const float u = bf2f(((const bf16_t*)(act + A_U))[(size_t)(MP + b) * 512 + tid]);
    acc += u * c.w_dw[30 * CD + tid]; ncs[29 * CD + tid] = u;
    const float mean = block_sum(acc, red, tid) * (1.0f / CD);
    const float d = acc - mean;
    const float var = block_sum(d * d, red, tid) * (1.0f / CD);
    float y = d * (1.0f / sqrtf(var + EPS)) * c.ln_w[tid] + c.ln_b[tid];
    y = y * sigm(y);
    ((bf16_t*)(act + A_AACT))[(size_t)(MP + b) * 512 + tid] = (bf16_t)(pk2(y, 0.f) & 0xffffu);
    __syncthreads();
}

__device__ __forceinline__ void phase2(const Ctx& c, LAS unsigned char* lds, int rep) {
    for (int it = blockIdx.x; it < NB * NH * 4; it += gridDim.x) { const int x = it & 7, j = it >> 3; ret_prompt_item(c, lds, (x * 4 + (j >> 2)) * 4 + (j & 3)); }
    unsigned* counter = (unsigned*)(c.ws + WS_CTL) + rep;
    LAS int* sItem = (LAS int*)(lds + LDS_BYTES - 16);
    constexpr int N_CONV = MP / 32, N_RS = MS * NH, N_CS = MS, N_WQ = (WI_TOTAL - WI_IN) / 16, NTOT = N_CONV + N_RS + N_CS + N_WQ;
    static_assert((WI_TOTAL - WI_IN) % 16 == 0, "weight queue items");
    unsigned nxt = 0u;
    if (threadIdx.x == 0) nxt = atomicAdd(counter, 1u);
    for (;;) {
        if (threadIdx.x == 0) { *sItem = (int)nxt; nxt = atomicAdd(counter, 1u); }
        __syncthreads();
        const int it = __builtin_amdgcn_readfirstlane(*sItem);
        __syncthreads();
        if (it >= NTOT) break;
        if (it < N_CS) conv_sample_item(c, lds, it);
        else if (it < N_CS + N_CONV) conv_prompt_item(c, lds, it - N_CS);
        else if (it < N_CS + N_CONV + N_RS) ret_sample_item(c, lds, it - N_CS - N_CONV);
        else { const int t_ = otid(); const int wv = __builtin_amdgcn_readfirstlane(t_ >> 6);
            wt_pair(c, WI_IN / 2 + (it - N_CS - N_CONV - N_RS) * 8 + wv, t_ & 63, (LAS float*)(lds + wv * 16384)); __syncthreads(); }
    }
}

__device__ __forceinline__ void phase2b(const Ctx& c) {
    const int t_ = otid(); const int lane = t_ & 63, gw = blockIdx.x * 8 + (t_ >> 6), NGW = gridDim.x * 8;
    unsigned char* act = c.ws + WS_ACT;
    const float* SSQ = (const float*)(c.ws + WS_SSQ);
    for (int row0 = gw; row0 < RT; row0 += 4 * NGW) {
        u32x4 a[4][2], o[4][2]; float rs[4];
#pragma unroll
        for (int r = 0; r < 4; ++r) { const int row = row0 + r * NGW; rs[r] = 1.0f;
            if (row < RT) {
                const u32x4* sg = (const u32x4*)((bf16_t*)(act + A_SG) + (size_t)row * 1024 + lane * 16);
                const u32x4* ov = (const u32x4*)((const bf16_t*)c.out + (size_t)row * 1024 + lane * 16);
#pragma unroll
                for (int j = 0; j < 2; ++j) { a[r][j] = __builtin_nontemporal_load(sg + j); o[r][j] = __builtin_nontemporal_load(ov + j); }
                if (row < MP) { const f32x4 q = *(const f32x4*)(SSQ + (size_t)row * 16 + (lane >> 4) * 4); rs[r] = 1.0f / sqrtf(((q.x + q.y) + (q.z + q.w)) * (1.0f / DV) + EPS); }
            } }
#pragma unroll
        for (int r = 0; r < 4; ++r) { const int row = row0 + r * NGW;
            if (row < RT) { u32x4* dg = (u32x4*)((bf16_t*)(act + A_SG) + (size_t)row * 1024 + lane * 16); const float k = rs[r];
#pragma unroll
                for (int j = 0; j < 2; ++j) { const u32x4 x = a[r][j], y = o[r][j]; u32x4 w;
                    w.x = pk2(bflo(x.x) * bflo(y.x) * k, bfhi(x.x) * bfhi(y.x) * k); w.y = pk2(bflo(x.y) * bflo(y.y) * k, bfhi(x.y) * bfhi(y.y) * k);
                    w.z = pk2(bflo(x.z) * bflo(y.z) * k, bfhi(x.z) * bfhi(y.z) * k); w.w = pk2(bflo(x.w) * bflo(y.w) * k, bfhi(x.w) * bfhi(y.w) * k);
                    dg[j] = w; } } }
    }
}


#define XB_TMO      128
#define XB_XCNT(j)  (256  + 64 * (j))
#define XB_XSUB(j)  (1280 + 64 * (j))
#define XB_XGEN(j)  (2304 + 64 * (j))
#define XB_TOP      3328
#define XB_TOPGEN   3392
#define XCD_BAR_WORDS 3456
#define XB_SPIN_CAP (1u << 22)
__device__ __forceinline__ unsigned xb_ld(unsigned* p)              { return __hip_atomic_load(p, __ATOMIC_RELAXED, __HIP_MEMORY_SCOPE_AGENT); }
__device__ __forceinline__ unsigned xb_add(unsigned* p, unsigned v) { return __hip_atomic_fetch_add(p, v, __ATOMIC_RELAXED, __HIP_MEMORY_SCOPE_AGENT); }
__device__ __forceinline__ unsigned xb_xcc_id() { return (unsigned)__builtin_amdgcn_s_getreg((3 << 11) | 20) & 0xFu; }
#define XB_SPIN(cond, bar) do { unsigned _sp = 0; while (cond) { __builtin_amdgcn_s_sleep(1); \
    if ((++_sp & 255u) == 0u) { if (xb_ld(&(bar)[XB_TMO])) break; if (_sp > XB_SPIN_CAP) { atomicAdd(&(bar)[XB_TMO], 1u); break; } } } } while (0)
struct XcdBarrier { unsigned* bar; unsigned x; volatile LAS unsigned* st; };
__device__ __forceinline__ XcdBarrier xcd_barrier_post(unsigned* bar, volatile LAS unsigned* st) {
    XcdBarrier b; b.bar = bar; b.x = xb_xcc_id(); b.st = st;
    if (threadIdx.x == 0) (void)xb_add(&bar[XB_XCNT(b.x)], 1u);
    return b;
}
__device__ __forceinline__ void xcd_barrier_complete(unsigned* bar, unsigned x, unsigned& nloc, unsigned& nx) {
    const unsigned G = gridDim.x * gridDim.y * gridDim.z;
    unsigned sum, cnt, mine, sp = 0u;
    for (;;) {
        sum = 0u; cnt = 0u; mine = 0u;
#pragma unroll
        for (unsigned j = 0; j < 16; ++j) { const unsigned c = xb_ld(&bar[XB_XCNT(j)]); sum += c; cnt += (c > 0u) ? 1u : 0u; mine = (j == x) ? c : mine; }
        if (sum == G) break;
        __builtin_amdgcn_s_sleep(1);
        if ((++sp & 255u) == 0u) { if (xb_ld(&bar[XB_TMO])) break; if (sp > XB_SPIN_CAP) { atomicAdd(&bar[XB_TMO], 1u); break; } }
    }
    nloc = mine > 0u ? mine : 1u; nx = cnt > 0u ? cnt : 1u;
}
__device__ __forceinline__ void xcd_barrier(const XcdBarrier& b) {
    asm volatile("s_waitcnt vmcnt(0)" ::: "memory");
    __syncthreads();
    if (threadIdx.x == 0) {
        unsigned* bar = b.bar;
        __builtin_amdgcn_s_waitcnt(0);
        unsigned nloc = b.st[0], nx = b.st[1];
        if (nloc == 0u) { xcd_barrier_complete(bar, b.x, nloc, nx); b.st[0] = nloc; b.st[1] = nx; }
        const unsigned old = xb_add(&bar[XB_XSUB(b.x)], 1u);
        const unsigned gen = old / nloc;
        if (old + 1u == (gen + 1u) * nloc) {
            __builtin_amdgcn_fence(__ATOMIC_RELEASE, "agent");
            asm volatile("s_waitcnt vmcnt(0)" ::: "memory");
            const unsigned og = xb_add(&bar[XB_TOP], 1u);
            const unsigned tg = og / nx;
            if (og + 1u == (tg + 1u) * nx) xb_add(&bar[XB_TOPGEN], 1u);
            else XB_SPIN(xb_ld(&bar[XB_TOPGEN]) == tg, bar);
            __builtin_amdgcn_fence(__ATOMIC_ACQUIRE, "agent");
            xb_add(&bar[XB_XGEN(b.x)], 1u);
            asm volatile("s_waitcnt vmcnt(0)" ::: "memory");
        } else {
            XB_SPIN(xb_ld(&bar[XB_XGEN(b.x)]) == gen, bar);
            __builtin_amdgcn_fence(__ATOMIC_ACQUIRE, "agent");
            asm volatile("s_waitcnt vmcnt(0)" ::: "memory");
        }
    }
    __syncthreads();
}

__global__ void __launch_bounds__(512) fwd_megakernel(Ctx c) {
    extern __shared__ __attribute__((aligned(16))) unsigned char smem[];
    LAS unsigned char* lds = (LAS unsigned char*)smem;
    cg::grid_group grid = cg::this_grid();
    unsigned char* act = c.ws + WS_ACT;
    volatile LAS unsigned* xst = (volatile LAS unsigned*)(lds + LDS_BYTES - 32);
    if (threadIdx.x == 0) { xst[0] = 0u; xst[1] = 0u; }
    __syncthreads();
    const XcdBarrier xb = xcd_barrier_post((unsigned*)(c.ws + WS_BAR), xst);
    phase0(c, lds);
    if (c.ws == nullptr) grid.sync();
    xcd_barrier(xb);
    gemm_all<EK_IN, NIN, DM, 3, Epi<EK_IN>, true>(c, lds, (const bf16_t*)c.out, (const bf16_t*)(c.ws + WS_WIN));
    xcd_barrier(xb);
    phase2(c, lds, 0);
    xcd_barrier(xb);
    gemm_all<EK_CO, DM, CD, 1, Epi<EK_CO>, true>(c, lds, (const bf16_t*)(act + A_AACT), (const bf16_t*)(c.ws + WS_WCO));
    gemm_all<EK_RO, DM, DM, 1, Epi<EK_RO>, true, true>(c, lds, (const bf16_t*)c.out, (const bf16_t*)(c.ws + WS_WRO));
    xcd_barrier(xb);
    gemm_all<EK_WO, DM, DM, 1, EpiWoFused>(c, lds, (const bf16_t*)(act + A_SB), (const bf16_t*)(c.ws + WS_WO));
    xcd_barrier(xb);
    gemm_all<EK_UP, FF, DM, 4, Epi<EK_UP>, true>(c, lds, (const bf16_t*)(act + A_HN), (const bf16_t*)(c.ws + WS_WUP));
    xcd_barrier(xb);
    gemm_all<EK_DN, DM, FF, 1, EpiDnFused>(c, lds, (const bf16_t*)(act + A_UP), (const bf16_t*)(c.ws + WS_WDN));
}

extern "C" void kernel_launch(void* const* d_in, const int* in_sizes, int n_in, void* d_out, int out_size, void* d_ws, size_t ws_size, hipStream_t stream) {
    static int grid_blocks = 0;
    if (!grid_blocks) {
        if (n_in != 18 || ws_size < WS_END2) { fprintf(stderr, "kernel_launch: unexpected n_in %d / ws_size %zu (need %zu)\n", n_in, ws_size, (size_t)WS_END2); grid_blocks = -1; return; }
        int dev = 0, cus = 0, per_cu = 0;
        hipGetDevice(&dev);
        hipDeviceGetAttribute(&cus, hipDeviceAttributeMultiprocessorCount, dev);
        if (hipFuncSetAttribute((const void*)fwd_megakernel, hipFuncAttributeMaxDynamicSharedMemorySize, LDS_BYTES) != hipSuccess) fprintf(stderr, "kernel_launch: hipFuncSetAttribute failed\n");
        hipOccupancyMaxActiveBlocksPerMultiprocessor(&per_cu, (const void*)fwd_megakernel, 512, LDS_BYTES);
        (void)hipGetLastError();
        if (per_cu < 1) { fprintf(stderr, "kernel_launch: occupancy query says %d blocks per CU\n", per_cu); per_cu = 1; }
        grid_blocks = cus * per_cu; if (grid_blocks > 256) grid_blocks = 256;
    }
    if (grid_blocks < 0) return;
    (void)hipMemsetAsync((char*)d_ws + WS_CTL, 0, CTL_ZERO, stream);
    Ctx c{};
    const float** f = (const float**)&c;
    for (int i = 0; i < 18; ++i) f[i] = (const float*)d_in[i];
    c.out = (float*)d_out; c.ws = (unsigned char*)d_ws;
    void* args[] = {&c};
    hipError_t e = hipLaunchCooperativeKernel((const void*)fwd_megakernel, dim3(grid_blocks), dim3(512), args, LDS_BYTES, stream);
    if (e != hipSuccess) fprintf(stderr, "cooperative launch failed: %s (grid %d)\n", hipGetErrorString(e), grid_blocks);
}
```

```cpp
#include <hip/hip_runtime.h>
#include <hip/hip_cooperative_groups.h>
#include <cstdio>
#include <cstdint>
namespace cg = cooperative_groups;

#define LAS __attribute__((address_space(3)))
typedef unsigned short bf16_t;
typedef short bf16x8 __attribute__((ext_vector_type(8)));
typedef float f32x4 __attribute__((ext_vector_type(4)));
typedef unsigned u32x4 __attribute__((ext_vector_type(4)));
typedef unsigned u32x2 __attribute__((ext_vector_type(2)));

constexpr int DM = 1024, NB = 8, SEQ = 2048, MP = NB * SEQ  , MS = 128, RT = MP + MS  ;
constexpr int CD = 512, CW = 31, NH = 4, DK = 128, DV = 256, FF = 4096, NIN = 6144;
constexpr float EPS = 1e-6f;
constexpr size_t O_NCP = (size_t)RT * DM;
constexpr size_t O_NRP = O_NCP + (size_t)NB * 30 * CD;
constexpr size_t O_NCS = O_NRP + (size_t)NB * NH * DK * DV;
constexpr size_t O_NRS = O_NCS + (size_t)MS * 30 * CD;
constexpr size_t WS_CTL = 0, WS_BAR = 4096, WS_WIN = 131072, WS_WCO = WS_WIN + (size_t)NIN * DM * 2, WS_WRO = WS_WCO + (size_t)DM * CD * 2,
                 WS_WO = WS_WRO + (size_t)DM * DM * 2, WS_WUP = WS_WO + (size_t)DM * DM * 2, WS_WDN = WS_WUP + (size_t)FF * DM * 2,
                 WS_ACT = WS_WDN + (size_t)FF * DM * 2;
constexpr size_t A_U = 0, A_Q = A_U + (size_t)RT * 512 * 2, A_K = A_Q + (size_t)RT * 512 * 2, A_V = A_K + (size_t)RT * 512 * 2,
                 A_SG = A_V + (size_t)RT * 1024 * 2, A_SA = A_SG + (size_t)RT * 1024 * 2, A_SB = A_SA + (size_t)RT * 1024 * 2,
                 A_AACT = A_SB + (size_t)RT * 1024 * 2, A_END = A_AACT + (size_t)RT * 512 * 2;
constexpr size_t A_M2 = (size_t)RT * 1024 * 2  , A_HN = 0  , A_F = 0  , A_UP = (size_t)RT * 1024 * 4;
static_assert(A_UP + (size_t)RT * FF * 2 <= A_END, "act region");
constexpr size_t WS_SSQ = WS_ACT + A_END, WS_END = WS_SSQ + (size_t)MP * 16 * 4;
constexpr size_t WS_XCH = WS_END;
constexpr size_t WS_XCHS = WS_XCH + 3 * 64 * 256 * 4 * 8;
constexpr size_t WS_END2 = WS_XCHS + 3 * 8 * 16 * 32 * 8;
constexpr size_t XCH_WORDS = (WS_END2 - WS_XCH) / 8;
constexpr size_t CTL_XCNT = 20480;
constexpr size_t CTL_XCNTS = CTL_XCNT + 3 * 64 * 256;
constexpr size_t CTL_ZERO = CTL_XCNTS + 3 * 8 * 256;
static_assert(CTL_ZERO <= WS_WIN, "control words");
constexpr int LDS_BYTES = 147456;

struct Ctx {
    const float *xp, *xs, *cache_conv, *state_ret, *n_mix_pre, *n_mix_post, *w_in, *w_dw, *b_dw, *ln_w, *ln_b, *w_co, *w_ro, *w_o,
        *n_ffn_pre, *n_ffn_post, *w_up, *w_dn;
    float* out; unsigned char* ws;
};

__device__ __forceinline__ unsigned pk2(float lo, float hi) { unsigned r; asm volatile("v_cvt_pk_bf16_f32 %0, %1, %2" : "=v"(r) : "v"(lo), "v"(hi)); return r; }
__device__ __forceinline__ float bflo(unsigned w) { return __uint_as_float(w << 16); }
__device__ __forceinline__ float bfhi(unsigned w) { return __uint_as_float(w & 0xffff0000u); }
__device__ __forceinline__ float bf2f(bf16_t b) { return __uint_as_float(((unsigned)b) << 16); }
__device__ __forceinline__ float sigm(float x) { return __builtin_amdgcn_rcpf(1.0f + __expf(-x)); }
__device__ __forceinline__ float wave_sum(float v) {
#pragma unroll
    for (int o = 1; o < 64; o <<= 1) v += __shfl_xor(v, o);
    return v;
}
#define LDS_WAIT() asm volatile("s_waitcnt lgkmcnt(0)" ::: "memory")
__device__ __forceinline__ int otid() { int t = threadIdx.x; asm volatile("" : "+v"(t)); return t; }
__device__ __forceinline__ const float* xrow(const Ctx& c, int row) { return row < MP ? c.xp + (size_t)row * DM : c.xs + (size_t)(row - MP) * DM; }

namespace pg8 {
constexpr int BM = 256, BK = 64, HALF = 128, HTB = HALF * BK * 2, STAGE_BYTES = 8 * HTB, NXCD = 8, WGM = 8;
__host__ __device__ __forceinline__ int lds_byte(int r, int c) { const int st = (r >> 4) * 2 + (c >> 5), rr = r & 15, cc = c & 31, ob = rr * 64 + cc * 2; return st * 1024 + (ob ^ (((ob >> 9) & 1) << 5)); }
__host__ __device__ __forceinline__ void stage_rc(int b, int& R, int& C) { const int st = b / 1024, sb = b % 1024, swz = sb ^ (((sb >> 9) & 1) << 5); R = (st >> 1) * 16 + swz / 64; C = (st & 1) * 32 + (swz % 64) / 2; }
__host__ __device__ __forceinline__ int perm32(int rho) { const int n = rho >> 4, i = rho & 15; return 8 * (i >> 2) + 4 * n + (i & 3); }
struct Unit { int pm, pn; };
struct Gemm { const bf16_t* A; const bf16_t* Bt; int M, N, K; const float* ssq = nullptr; };
struct StaticOrder {
    int nM, nN, nwg, G, c;
    __device__ void init(int M, int N, int G_, int c_) { nM = M / BM; nN = N / BM; nwg = nM * nN; G = G_; c = c_; }
    __device__ bool next(int i, Unit& u) const {
        const long L = (long)i * G + c; if (L >= nwg) return false;
        int wgid = (int)L; { const int q = nwg / NXCD, r = nwg % NXCD, xcd = wgid % NXCD, off = wgid / NXCD; wgid = (xcd < r ? xcd * (q + 1) : r * (q + 1) + (xcd - r) * q) + off; }
        const int nig = WGM * nN, gid = wgid / nig, fm = gid * WGM, gsz = (nM - fm) < WGM ? (nM - fm) : WGM;
        u.pm = fm + ((wgid % nig) % gsz); u.pn = (wgid % nig) / gsz; return true;
    }
};
template <class Epi, bool ALIGN_EPI = false, bool SP2 = true, bool HNORM = false>
__device__ __forceinline__ void gemm_phase(LAS unsigned char* lds, const Gemm g, const StaticOrder& S, const Epi& E) {
    int tid_ = threadIdx.x; asm volatile("" : "+v"(tid_));
    const int tid = tid_, wid = __builtin_amdgcn_readfirstlane(tid >> 6), lane = tid & 63, wr = wid >> 2, wc = wid & 3, fr = lane & 15, fq = lane >> 4;
    const int K = g.K, nt = K / BK;
    unsigned voffA[2], voffB[2];
#pragma unroll
    for (int i = 0; i < 2; ++i) { int R, C; stage_rc(tid * 16 + i * 8192, R, C); const int Rb = (R & ~31) + perm32(R & 31);
        voffA[i] = (unsigned)(R * K + C) * 2u; voffB[i] = (unsigned)(Rb * K + C) * 2u; }
    const size_t kstep = (size_t)(BK * 2);
    const size_t hstep = (size_t)HALF * K * 2;
    const size_t tstep = 2 * hstep;
    const unsigned ldsw = (unsigned)wid * 1024u;
    const int aoff = lds_byte(wr * 64 + fr, fq * 8), boff = lds_byte(wc * 32 + fr, fq * 8);
#define PG8_SA(b, h) (((b) * 2 + (h)) * HTB)
#define PG8_SB(b, h) ((4 + (b) * 2 + (h)) * HTB)
#define PG8_STAGE(bufoff, gbase, voff) do { _Pragma("unroll") for (int _i = 0; _i < 2; ++_i) \
        __builtin_amdgcn_global_load_lds((const unsigned*)((const char*)(gbase) + (voff)[_i]), (LAS unsigned*)(lds + (bufoff) + ldsw + _i * 8192), 16, 0, 0); } while (0)
#define PG8_LDA(dst, b, h) do { _Pragma("unroll") for (int m = 0; m < 4; ++m) _Pragma("unroll") for (int k = 0; k < 2; ++k) dst[m][k] = *(const LAS bf16x8*)(lds + PG8_SA(b, h) + aoff + m * 2048 + k * 1024); } while (0)
#define PG8_LDB(dst, b, h) do { _Pragma("unroll") for (int n = 0; n < 2; ++n) _Pragma("unroll") for (int k = 0; k < 2; ++k) dst[n][k] = *(const LAS bf16x8*)(lds + PG8_SB(b, h) + boff + n * 2048 + k * 1024); } while (0)
#define PG8_MMA(ai, bj, At, Bt) do { __builtin_amdgcn_s_setprio(1); _Pragma("unroll") for (int m = 0; m < 4; ++m) _Pragma("unroll") for (int n = 0; n < 2; ++n) _Pragma("unroll") for (int k = 0; k < 2; ++k) \
        acc[ai][bj][m][n] = __builtin_amdgcn_mfma_f32_16x16x32_bf16(Bt[n][k], At[m][k], acc[ai][bj][m][n], 0, 0, 0); __builtin_amdgcn_s_setprio(0); } while (0)
#define PG8_WAIT_V(n) asm volatile("s_waitcnt vmcnt(" #n ")" ::: "memory")
#define PG8_WAIT_L(n) asm volatile("s_waitcnt lgkmcnt(" #n ")" ::: "memory")
#define PG8_BAR __builtin_amdgcn_s_barrier()
#define PG8_SCHED __builtin_amdgcn_sched_barrier(0)
    Unit cur, nxt; int ui = 0;
    if (!S.next(0, cur)) return;
    f32x4 acc[2][2][4][2];
#pragma unroll
    for (int a = 0; a < 2; ++a)
#pragma unroll
        for (int b = 0; b < 2; ++b)
#pragma unroll
            for (int m = 0; m < 4; ++m)
#pragma unroll
                for (int n = 0; n < 2; ++n) acc[a][b][m][n] = (f32x4){0.f, 0.f, 0.f, 0.f};
    bf16x8 At[4][2], B0[2][2], B1[2][2];
    const char* cA = (const char*)g.A + (size_t)cur.pm * tstep; const char* cB = (const char*)g.Bt + (size_t)cur.pn * tstep;
    LAS float* hrt = (LAS float*)(lds + STAGE_BYTES);
    if constexpr (HNORM) {
        if (tid < 256) { const float* q = g.ssq + (size_t)(cur.pm * 256 + tid) * 16; float r[4];
#pragma unroll
            for (int hh = 0; hh < 4; ++hh) { const f32x4 v = *(const f32x4*)(q + 4 * hh); r[hh] = 1.0f / sqrtf(((v.x + v.y) + (v.z + v.w)) * (1.0f / 256.0f) + 1e-6f); }
            *(LAS f32x4*)(hrt + tid * 4) = (f32x4){r[0] / r[1], r[1] / r[2], r[2] / r[3], r[3]}; }
        asm volatile("s_waitcnt vmcnt(0) lgkmcnt(0)" ::: "memory"); PG8_BAR;
    }
    if constexpr (SP2) {
        PG8_STAGE(PG8_SB(0, 0), cB, voffB); PG8_STAGE(PG8_SB(0, 1), cB + hstep, voffB); PG8_STAGE(PG8_SA(0, 0), cA, voffA); PG8_STAGE(PG8_SA(0, 1), cA + hstep, voffA);
        if (wr == 1) PG8_BAR;
        PG8_WAIT_V(2); PG8_BAR;
        PG8_STAGE(PG8_SB(1, 0), cB + kstep, voffB); PG8_STAGE(PG8_SA(1, 0), cA + kstep, voffA); PG8_STAGE(PG8_SB(1, 1), cB + hstep + kstep, voffB);
        PG8_WAIT_V(6); PG8_BAR;
    } else {
    PG8_STAGE(PG8_SB(0, 0), cB, voffB); PG8_STAGE(PG8_SA(0, 0), cA, voffA); PG8_STAGE(PG8_SB(0, 1), cB + hstep, voffB); PG8_STAGE(PG8_SA(0, 1), cA + hstep, voffA);
    if (wr == 1) PG8_BAR;
    PG8_WAIT_V(4); PG8_BAR;
    PG8_STAGE(PG8_SB(1, 0), cB + kstep, voffB); PG8_STAGE(PG8_SA(1, 0), cA + kstep, voffA); PG8_STAGE(PG8_SB(1, 1), cB + hstep + kstep, voffB);
    PG8_WAIT_V(6); PG8_BAR;
    }
    for (;;) {
        const bool has_next = S.next(ui + 1, nxt);
        const char* nA = has_next ? (const char*)g.A + (size_t)nxt.pm * tstep : cA; const char* nB = has_next ? (const char*)g.Bt + (size_t)nxt.pn * tstep : cB;
        for (int t = 0; t < nt; t += 2) {
            const bool last = (t == nt - 2);
            const char* a1 = cA + (size_t)(t + 1) * kstep;
            const char* a2 = last ? nA : cA + (size_t)(t + 2) * kstep; const char* b2 = last ? nB : cB + (size_t)(t + 2) * kstep;
            const char* a3 = a2 + kstep; const char* b3 = b2 + kstep;
            if constexpr (HNORM) { if (t == 4 || t == 8 || t == 12) { const int hi = (t >> 2) - 1;
#pragma unroll
                for (int ai = 0; ai < 2; ++ai)
#pragma unroll
                    for (int m = 0; m < 4; ++m) { const float f = hrt[(ai * 128 + wr * 64 + m * 16 + fr) * 4 + hi];
#pragma unroll
                        for (int bj = 0; bj < 2; ++bj)
#pragma unroll
                            for (int n = 0; n < 2; ++n) acc[ai][bj][m][n] *= f; } } }
            if constexpr (SP2) {
            PG8_LDB(B0, 0, 0); PG8_LDB(B1, 0, 1); PG8_SCHED; PG8_LDA(At, 0, 0); PG8_STAGE(PG8_SA(1, 1), a1 + hstep, voffA);
            PG8_WAIT_V(8); PG8_WAIT_L(0); PG8_BAR; PG8_MMA(0, 0, At, B0); PG8_MMA(0, 1, At, B1); PG8_BAR; PG8_SCHED;
            PG8_LDA(At, 0, 1); PG8_STAGE(PG8_SB(0, 0), b2, voffB); PG8_STAGE(PG8_SB(0, 1), b2 + hstep, voffB); PG8_STAGE(PG8_SA(0, 0), a2, voffA);
            PG8_WAIT_V(8); PG8_WAIT_L(0); PG8_BAR; PG8_MMA(1, 0, At, B0); PG8_MMA(1, 1, At, B1); PG8_BAR; PG8_SCHED;
            PG8_LDB(B0, 1, 0); PG8_LDB(B1, 1, 1); PG8_SCHED; PG8_LDA(At, 1, 0); PG8_STAGE(PG8_SA(0, 1), a2 + hstep, voffA);
            PG8_WAIT_V(8); PG8_WAIT_L(0); PG8_BAR; PG8_MMA(0, 0, At, B0); PG8_MMA(0, 1, At, B1); PG8_BAR; PG8_SCHED;
            PG8_LDA(At, 1, 1); PG8_STAGE(PG8_SB(1, 0), b3, voffB); PG8_STAGE(PG8_SB(1, 1), b3 + hstep, voffB); PG8_STAGE(PG8_SA(1, 0), a3, voffA);
            PG8_WAIT_V(8); PG8_WAIT_L(0); PG8_BAR; PG8_MMA(1, 0, At, B0); PG8_MMA(1, 1, At, B1); PG8_BAR; PG8_SCHED;
            } else {
            PG8_LDB(B0, 0, 0); PG8_SCHED; PG8_LDA(At, 0, 0); PG8_STAGE(PG8_SA(1, 1), a1 + hstep, voffA);
            PG8_WAIT_L(8); PG8_BAR; PG8_WAIT_L(0); PG8_MMA(0, 0, At, B0); PG8_BAR; PG8_SCHED;
            PG8_LDB(B1, 0, 1); PG8_STAGE(PG8_SB(0, 0), b2, voffB);
            PG8_BAR; PG8_WAIT_L(0); PG8_MMA(0, 1, At, B1); PG8_BAR;
            PG8_LDA(At, 0, 1); PG8_STAGE(PG8_SA(0, 0), a2, voffA);
            PG8_BAR; PG8_WAIT_L(0); PG8_MMA(1, 0, At, B0); PG8_BAR; PG8_SCHED;
            PG8_STAGE(PG8_SB(0, 1), b2 + hstep, voffB);
            PG8_WAIT_V(6); PG8_BAR; PG8_MMA(1, 1, At, B1); PG8_BAR;
            PG8_LDB(B0, 1, 0); PG8_SCHED; PG8_LDA(At, 1, 0); PG8_STAGE(PG8_SA(0, 1), a2 + hstep, voffA);
            PG8_WAIT_L(8); PG8_BAR; PG8_WAIT_L(0); PG8_MMA(0, 0, At, B0); PG8_BAR; PG8_SCHED;
            PG8_LDB(B1, 1, 1); PG8_STAGE(PG8_SB(1, 0), b3, voffB);
            PG8_BAR; PG8_WAIT_L(0); PG8_MMA(0, 1, At, B1); PG8_BAR;
            PG8_LDA(At, 1, 1); PG8_STAGE(PG8_SA(1, 0), a3, voffA);
            PG8_BAR; PG8_WAIT_L(0); PG8_MMA(1, 0, At, B0); PG8_BAR; PG8_SCHED;
            PG8_STAGE(PG8_SB(1, 1), b3 + hstep, voffB);
            PG8_WAIT_V(6); PG8_BAR; PG8_MMA(1, 1, At, B1); PG8_BAR;
            }
        }
        if constexpr (HNORM) {
#pragma unroll
            for (int ai = 0; ai < 2; ++ai)
#pragma unroll
                for (int m = 0; m < 4; ++m) { const float f = hrt[(ai * 128 + wr * 64 + m * 16 + fr) * 4 + 3];
#pragma unroll
                    for (int bj = 0; bj < 2; ++bj)
#pragma unroll
                        for (int n = 0; n < 2; ++n) acc[ai][bj][m][n] *= f; } }
        if constexpr (ALIGN_EPI) { if (wr == 0) PG8_BAR; }
        if constexpr (!Epi::AFTER_DRAIN) E(acc, cur, wr, wc, fr, fq);
        if (!has_next) break;
#pragma unroll
        for (int a = 0; a < 2; ++a)
#pragma unroll
            for (int b = 0; b < 2; ++b)
#pragma unroll
                for (int m = 0; m < 4; ++m)
#pragma unroll
                    for (int n = 0; n < 2; ++n) acc[a][b][m][n] = (f32x4){0.f, 0.f, 0.f, 0.f};
        cur = nxt; cA = nA; cB = nB; ++ui;
        if constexpr (ALIGN_EPI) { if (wr == 1) PG8_BAR; }
    }
    PG8_WAIT_V(0);
    if constexpr (!ALIGN_EPI) { if (wr == 0) PG8_BAR; }
    PG8_BAR;
    if constexpr (Epi::AFTER_DRAIN) E.fused(acc, cur, wr, wc, fr, fq, lds, tid);
#undef PG8_SA
#undef PG8_SB
#undef PG8_STAGE
#undef PG8_LDA
#undef PG8_LDB
#undef PG8_MMA
#undef PG8_WAIT_V
#undef PG8_WAIT_L
#undef PG8_BAR
#undef PG8_SCHED
}
}

enum { EK_IN = 0, EK_CO, EK_RO, EK_WO, EK_UP, EK_DN };

template <int KIND>
__device__ __forceinline__ void epi8(const Ctx& c, int row, int col, f32x4 v0, f32x4 v1) {
    unsigned char* act = c.ws + WS_ACT;
    if constexpr (KIND == EK_IN) {
        if (col < 1024) {
            u32x2 w; w.x = pk2(v0[0] * sigm(v0[1]), v0[2] * sigm(v0[3])); w.y = pk2(v1[0] * sigm(v1[1]), v1[2] * sigm(v1[3]));
            *(u32x2*)((bf16_t*)(act + A_U) + (size_t)row * 512 + (col >> 1)) = w;
        } else if (col < 2048) {
            const bool isk = col >= 1536; const int cc = col - (isk ? 1536 : 1024), h = cc >> 7, i0 = (cc & 127) >> 1;
            const float pos = row < MP ? (float)(row & (SEQ - 1)) : 16384.0f;
            const float sc = isk ? 0.08838834764831845f : 1.0f;
            const float* freq = (const float*)(c.ws + WS_CTL + 256);
            const f32x4 fv = *(const f32x4*)(freq + i0);
            float x1[4] = {v0[0], v0[2], v1[0], v1[2]}, x2[4] = {v0[1], v0[3], v1[1], v1[3]}, o1[4], o2[4];
#pragma unroll
            for (int p = 0; p < 4; ++p) {
                const float ang = pos * fv[p];
                const double a = (double)ang; const double n = rint(a * 0.15915494309189535);
                const float r = (float)(a - n * 6.283185307179586);
                const float sn = __sinf(r) * sc, cs = __cosf(r) * sc;
                o1[p] = x1[p] * cs - x2[p] * sn; o2[p] = x2[p] * cs + x1[p] * sn;
            }
            bf16_t* dst = (bf16_t*)(act + (isk ? A_K : A_Q)) + (size_t)row * 512 + h * 128 + i0;
            u32x2 w1, w2; w1.x = pk2(o1[0], o1[1]); w1.y = pk2(o1[2], o1[3]); w2.x = pk2(o2[0], o2[1]); w2.y = pk2(o2[2], o2[3]);
            *(u32x2*)dst = w1; *(u32x2*)(dst + 64) = w2;
        } else {
            const int seg = (col - 2048) >> 10, cc = (col - 2048) & 1023;
            float f[8] = {v0[0], v0[1], v0[2], v0[3], v1[0], v1[1], v1[2], v1[3]};
            if (seg == 1) {
#pragma unroll
                for (int j = 0; j < 8; ++j) f[j] = f[j] * sigm(f[j]);
            } else if (seg >= 2) {
#pragma unroll
                for (int j = 0; j < 8; ++j) f[j] = sigm(f[j]);
            }
            u32x4 w; w.x = pk2(f[0], f[1]); w.y = pk2(f[2], f[3]); w.z = pk2(f[4], f[5]); w.w = pk2(f[6], f[7]);
            *(u32x4*)((bf16_t*)(act + A_V + (size_t)seg * ((size_t)RT * 1024 * 2)) + (size_t)row * 1024 + cc) = w;
        }
    } else if constexpr (KIND == EK_CO) {
        u32x4* p = (u32x4*)((bf16_t*)(act + A_SA) + (size_t)row * 1024 + col); const u32x4 g = *p;
        u32x4 w; w.x = pk2(v0[0] * bflo(g.x), v0[1] * bfhi(g.x)); w.y = pk2(v0[2] * bflo(g.y), v0[3] * bfhi(g.y));
        w.z = pk2(v1[0] * bflo(g.z), v1[1] * bfhi(g.z)); w.w = pk2(v1[2] * bflo(g.w), v1[3] * bfhi(g.w));
        *p = w;
    } else if constexpr (KIND == EK_RO) {
        const u32x4 t = *(const u32x4*)((bf16_t*)(act + A_SA) + (size_t)row * 1024 + col);
        u32x4* p = (u32x4*)((bf16_t*)(act + A_SB) + (size_t)row * 1024 + col); const u32x4 g = *p;
        u32x4 w; w.x = pk2(bflo(t.x) + v0[0] * bflo(g.x), bfhi(t.x) + v0[1] * bfhi(g.x)); w.y = pk2(bflo(t.y) + v0[2] * bflo(g.y), bfhi(t.y) + v0[3] * bfhi(g.y));
        w.z = pk2(bflo(t.z) + v1[0] * bflo(g.z), bfhi(t.z) + v1[1] * bfhi(g.z)); w.w = pk2(bflo(t.w) + v1[2] * bflo(g.w), bfhi(t.w) + v1[3] * bfhi(g.w));
        *p = w;
    } else if constexpr (KIND == EK_WO) {
        u32x4 w; w.x = pk2(v0[0], v0[1]); w.y = pk2(v0[2], v0[3]); w.z = pk2(v1[0], v1[1]); w.w = pk2(v1[2], v1[3]);
        *(u32x4*)((bf16_t*)(act + A_M2) + (size_t)row * DM + col) = w;
    } else if constexpr (KIND == EK_UP) {
        float f[8] = {v0[0], v0[1], v0[2], v0[3], v1[0], v1[1], v1[2], v1[3]};
#pragma unroll
        for (int j = 0; j < 8; ++j) { const float r = fmaxf(f[j], 0.f); f[j] = r * r; }
        u32x4 w; w.x = pk2(f[0], f[1]); w.y = pk2(f[2], f[3]); w.z = pk2(f[4], f[5]); w.w = pk2(f[6], f[7]);
        *(u32x4*)((bf16_t*)(act + A_UP) + (size_t)row * FF + col) = w;
    } else {
        u32x4 w; w.x = pk2(v0[0], v0[1]); w.y = pk2(v0[2], v0[3]); w.z = pk2(v1[0], v1[1]); w.w = pk2(v1[2], v1[3]);
        *(u32x4*)((bf16_t*)(act + A_F) + (size_t)row * DM + col) = w;
    }
}

template <int KIND> struct Epi {
    static constexpr bool AFTER_DRAIN = false;
    Ctx c;
    __device__ __forceinline__ void operator()(const f32x4 (&acc)[2][2][4][2], const pg8::Unit& u, int wr, int wc, int fr, int fq) const {
#pragma unroll
        for (int ai = 0; ai < 2; ++ai)
#pragma unroll
            for (int m = 0; m < 4; ++m) {
                const int row = u.pm * 256 + ai * 128 + wr * 64 + m * 16 + fr;
#pragma unroll
                for (int bj = 0; bj < 2; ++bj) epi8<KIND>(c, row, u.pn * 256 + bj * 128 + wc * 32 + 8 * fq, acc[ai][bj][m][0], acc[ai][bj][m][1]);
            }
    }
};

__device__ __forceinline__ bool xch_poll(const unsigned long long* p, float& val) {
    unsigned sp = 0;
    for (;;) { const unsigned long long w = __hip_atomic_load(p, __ATOMIC_RELAXED, __HIP_MEMORY_SCOPE_AGENT);
        if ((unsigned)(w >> 32) != 0u) { val = __uint_as_float((unsigned)w); return true; }
        if (++sp > (1u << 22)) { val = 0.f; return false; }
        __builtin_amdgcn_s_sleep(1); }
}
__device__ __forceinline__ void row_rms_exchange(const Ctx& c, int set, const f32x4 (&v)[2][2][4][2], const pg8::Unit& u, int wr, int wc, int fr, int fq, LAS unsigned char* lds, int tid) {
    LAS float* P = (LAS float*)lds;
    LAS float* S = (LAS float*)(lds + 8192);
    unsigned long long* slots = (unsigned long long*)(c.ws + WS_XCH) + (size_t)set * 64 * 256 * 4;
#pragma unroll
    for (int ai = 0; ai < 2; ++ai)
#pragma unroll
        for (int m = 0; m < 4; ++m) {
            float q = 0.f;
#pragma unroll
            for (int bj = 0; bj < 2; ++bj)
#pragma unroll
                for (int n = 0; n < 2; ++n) { const f32x4 x = v[ai][bj][m][n]; q += (x[0] * x[0] + x[1] * x[1]) + (x[2] * x[2] + x[3] * x[3]); }
            q += __shfl_xor(q, 16); q += __shfl_xor(q, 32);
            if (fq == 0) P[(ai * 128 + wr * 64 + m * 16 + fr) * 4 + wc] = q;
        }
    __syncthreads();
    if (tid < 256) {
        const float t = (P[tid * 4 + 0] + P[tid * 4 + 1]) + (P[tid * 4 + 2] + P[tid * 4 + 3]);
        unsigned long long* sl = slots + (size_t)(u.pm * 256 + tid) * 4;
        __hip_atomic_store(sl + u.pn, (1ull << 32) | (unsigned long long)__float_as_uint(t), __ATOMIC_RELAXED, __HIP_MEMORY_SCOPE_AGENT);
        float tot = 0.f;
#pragma unroll
        for (int k = 0; k < 4; ++k) { float x; xch_poll(sl + k, x); tot += x; }
        S[tid] = 1.0f / sqrtf(tot * (1.0f / DM) + EPS);
    }
    __syncthreads();
}
struct EpiWoFused {
    static constexpr bool AFTER_DRAIN = true;
    Ctx c;
    __device__ __forceinline__ void fused(f32x4 (&acc)[2][2][4][2], const pg8::Unit& u, int wr, int wc, int fr, int fq, LAS unsigned char* lds, int tid) const {
        row_rms_exchange(c, 1, acc, u, wr, wc, fr, fq, lds, tid);
        const LAS float* S = (const LAS float*)(lds + 8192);
        bf16_t* MB = (bf16_t*)(c.ws + WS_ACT + A_M2); bf16_t* HN = (bf16_t*)(c.ws + WS_ACT + A_HN);
#pragma unroll
        for (int bj = 0; bj < 2; ++bj) {
            const int col = u.pn * 256 + bj * 128 + wc * 32 + 8 * fq;
            const f32x4 g0 = *(const f32x4*)(c.n_mix_post + col), g1 = *(const f32x4*)(c.n_mix_post + col + 4);
#pragma unroll
            for (int ai = 0; ai < 2; ++ai)
#pragma unroll
                for (int m = 0; m < 4; ++m) { const int rl = ai * 128 + wr * 64 + m * 16 + fr; const float rs = S[rl]; const size_t ro = (size_t)(u.pm * 256 + rl) * DM + col;
                    const f32x4 x0 = __builtin_nontemporal_load((const f32x4*)(c.xp + ro)), x1 = __builtin_nontemporal_load((const f32x4*)(c.xp + ro + 4));
                    const f32x4 h0 = x0 + acc[ai][bj][m][0] * rs * g0, h1 = x1 + acc[ai][bj][m][1] * rs * g1;
                    acc[ai][bj][m][0] = h0; acc[ai][bj][m][1] = h1;
                    u32x4 w; w.x = pk2(h0[0], h0[1]); w.y = pk2(h0[2], h0[3]); w.z = pk2(h1[0], h1[1]); w.w = pk2(h1[2], h1[3]);
                    *(u32x4*)(MB + ro) = w; }
        }
        row_rms_exchange(c, 2, acc, u, wr, wc, fr, fq, lds, tid);
#pragma unroll
        for (int bj = 0; bj < 2; ++bj) {
            const int col = u.pn * 256 + bj * 128 + wc * 32 + 8 * fq;
            const f32x4 g0 = *(const f32x4*)(c.n_ffn_pre + col), g1 = *(const f32x4*)(c.n_ffn_pre + col + 4);
#pragma unroll
            for (int ai = 0; ai < 2; ++ai)
#pragma unroll
                for (int m = 0; m < 4; ++m) { const int rl = ai * 128 + wr * 64 + m * 16 + fr; const float rs = S[rl]; const size_t ro = (size_t)(u.pm * 256 + rl) * DM + col;
                    const f32x4 a = acc[ai][bj][m][0] * rs * g0, b = acc[ai][bj][m][1] * rs * g1;
                    u32x4 w; w.x = pk2(a[0], a[1]); w.y = pk2(a[2], a[3]); w.z = pk2(b[0], b[1]); w.w = pk2(b[2], b[3]);
                    *(u32x4*)(HN + ro) = w; }
        }
    }
};

__device__ __forceinline__ float small_rms_exchange(const Ctx& c, int set, int mt, int ng, int lane, const f32x4& s0, const f32x4& s1) {
    const int fr = lane & 15, fq = lane >> 4;
    unsigned long long* slots = (unsigned long long*)(c.ws + WS_XCHS) + (size_t)((set * 8 + mt) * 16) * 32;
    float q = ((s0[0] * s0[0] + s0[1] * s0[1]) + (s0[2] * s0[2] + s0[3] * s0[3])) + ((s1[0] * s1[0] + s1[1] * s1[1]) + (s1[2] * s1[2] + s1[3] * s1[3]));
    q += __shfl_xor(q, 16); q += __shfl_xor(q, 32);
    if (fq == 0) __hip_atomic_store(slots + fr * 32 + ng, (1ull << 32) | (unsigned long long)__float_as_uint(q), __ATOMIC_RELAXED, __HIP_MEMORY_SCOPE_AGENT);
    float t = 0.f;
#pragma unroll
    for (int k = 0; k < 8; ++k) { float x; xch_poll(slots + fr * 32 + fq * 8 + k, x); t += x; }
    t += __shfl_xor(t, 16); t += __shfl_xor(t, 32);
    return 1.0f / sqrtf(t * (1.0f / DM) + EPS);
}
template <int KIND>
__device__ __forceinline__ void small_fused(const Ctx& c, int mt, int ng, int lane, f32x4 s0, f32x4 s1) {
    const int fr = lane & 15, fq = lane >> 4, col = ng * 32 + 8 * fq;
    const size_t ro = (size_t)(MP + mt * 16 + fr) * DM + col;
    bf16_t* MB = (bf16_t*)(c.ws + WS_ACT + A_M2);
    if constexpr (KIND == EK_WO) {
        const float rs = small_rms_exchange(c, 0, mt, ng, lane, s0, s1);
        const float* xr = c.xs + (size_t)(mt * 16 + fr) * DM + col;
        const f32x4 g0 = *(const f32x4*)(c.n_mix_post + col), g1 = *(const f32x4*)(c.n_mix_post + col + 4);
        const f32x4 h0 = *(const f32x4*)xr + s0 * rs * g0, h1 = *(const f32x4*)(xr + 4) + s1 * rs * g1;
        u32x4 w; w.x = pk2(h0[0], h0[1]); w.y = pk2(h0[2], h0[3]); w.z = pk2(h1[0], h1[1]); w.w = pk2(h1[2], h1[3]);
        *(u32x4*)(MB + ro) = w;
        const float rs2 = small_rms_exchange(c, 1, mt, ng, lane, h0, h1);
        const f32x4 p0 = *(const f32x4*)(c.n_ffn_pre + col), p1 = *(const f32x4*)(c.n_ffn_pre + col + 4);
        const f32x4 a = h0 * rs2 * p0, b = h1 * rs2 * p1;
        u32x4 v; v.x = pk2(a[0], a[1]); v.y = pk2(a[2], a[3]); v.z = pk2(b[0], b[1]); v.w = pk2(b[2], b[3]);
        *(u32x4*)((bf16_t*)(c.ws + WS_ACT + A_HN) + ro) = v;
    } else {
        const float rs = small_rms_exchange(c, 2, mt, ng, lane, s0, s1);
        const u32x4 hw = *(const u32x4*)(MB + ro);
        const f32x4 h0 = {bflo(hw.x), bfhi(hw.x), bflo(hw.y), bfhi(hw.y)}, h1 = {bflo(hw.z), bfhi(hw.z), bflo(hw.w), bfhi(hw.w)};
        const f32x4 g0 = *(const f32x4*)(c.n_ffn_post + col), g1 = *(const f32x4*)(c.n_ffn_post + col + 4);
        float* p = c.out + ro;
        *(f32x4*)p = h0 + s0 * rs * g0; *(f32x4*)(p + 4) = h1 + s1 * rs * g1;
    }
}

struct EpiDnFused {
    static constexpr bool AFTER_DRAIN = true;
    Ctx c;
    __device__ __forceinline__ void fused(const f32x4 (&acc)[2][2][4][2], const pg8::Unit& u, int wr, int wc, int fr, int fq, LAS unsigned char* lds, int tid) const {
        row_rms_exchange(c, 0, acc, u, wr, wc, fr, fq, lds, tid);
        const LAS float* S = (const LAS float*)(lds + 8192);
#pragma unroll
        for (int bj = 0; bj < 2; ++bj) {
            const int col = u.pn * 256 + bj * 128 + wc * 32 + 8 * fq;
            const f32x4 g0 = *(const f32x4*)(c.n_ffn_post + col), g1 = *(const f32x4*)(c.n_ffn_post + col + 4);
#pragma unroll
            for (int ai = 0; ai < 2; ++ai)
#pragma unroll
                for (int m = 0; m < 4; ++m) { const int rl = ai * 128 + wr * 64 + m * 16 + fr; const float rs = S[rl];
                    float* p = c.out + (size_t)(u.pm * 256 + rl) * DM + col;
                    const u32x4 hw = __builtin_nontemporal_load((const u32x4*)((const bf16_t*)(c.ws + WS_ACT + A_M2) + (size_t)(u.pm * 256 + rl) * DM + col));
                    const f32x4 h0 = {bflo(hw.x), bfhi(hw.x), bflo(hw.y), bfhi(hw.y)}, h1 = {bflo(hw.z), bfhi(hw.z), bflo(hw.w), bfhi(hw.w)};
                    __builtin_nontemporal_store(h0 + acc[ai][bj][m][0] * rs * g0, (f32x4*)p); __builtin_nontemporal_store(h1 + acc[ai][bj][m][1] * rs * g1, (f32x4*)(p + 4)); }
        }
    }
};

template <int KIND, int N, int K, int NI, class BigEpi = Epi<KIND>, bool ALIGN = false, bool HNORM = false>
__device__ __forceinline__ void gemm_all(const Ctx& c, LAS unsigned char* lds, const bf16_t* A, const bf16_t* Bt) {
    {
    {
    pg8::StaticOrder S; S.init(MP, N, gridDim.x, blockIdx.x);
    BigEpi E{c};
    pg8::Gemm g{A, Bt, MP, N, K, (const float*)(c.ws + WS_SSQ)};
    pg8::gemm_phase<BigEpi, ALIGN, true, HNORM>(lds, g, S, E);
    __syncthreads();
    }
    {
    const int tid = otid(), wid = __builtin_amdgcn_readfirstlane(tid >> 6), lane = tid & 63, fr = lane & 15, fq = lane >> 4;
    LAS f32x4* red = (LAS f32x4*)lds;
    constexpr int nitems = 8 * (N / 32), kw = K / 8, KS = kw / 32, KB = KS > 4 ? 4 : KS;
    const unsigned toff = (unsigned)((fr * K + wid * kw + 8 * fq) * 2);
    const unsigned tb0 = (unsigned)((pg8::perm32(fr) * K + wid * kw + 8 * fq) * 2), tb1 = (unsigned)((pg8::perm32(16 + fr) * K + wid * kw + 8 * fq) * 2);
    for (int base = blockIdx.x * NI; base < nitems; base += gridDim.x * NI) {
        f32x4 a0[NI], a1[NI];
#pragma unroll
        for (int q = 0; q < NI; ++q) { a0[q] = (f32x4){0.f, 0.f, 0.f, 0.f}; a1[q] = (f32x4){0.f, 0.f, 0.f, 0.f}; }
#pragma unroll 1
        for (int k0 = 0; k0 < KS; k0 += KB) {
            bf16x8 af[NI][KB], b0[NI][KB], b1[NI][KB];
#pragma unroll
            for (int q = 0; q < NI; ++q) { const int item = base + q, mt = item & 7, ng = item >> 3;
                const char* ap = (const char*)(A + (size_t)(MP + mt * 16) * K) + (size_t)k0 * 64; const char* bp = (const char*)(Bt + (size_t)(ng * 32) * K) + (size_t)k0 * 64;
#pragma unroll
                for (int ks = 0; ks < KB; ++ks) { af[q][ks] = *(const bf16x8*)(ap + ks * 64 + toff); b0[q][ks] = *(const bf16x8*)(bp + ks * 64 + tb0); b1[q][ks] = *(const bf16x8*)(bp + ks * 64 + tb1); } }
#pragma unroll
            for (int q = 0; q < NI; ++q)
#pragma unroll
                for (int ks = 0; ks < KB; ++ks) { a0[q] = __builtin_amdgcn_mfma_f32_16x16x32_bf16(b0[q][ks], af[q][ks], a0[q], 0, 0, 0); a1[q] = __builtin_amdgcn_mfma_f32_16x16x32_bf16(b1[q][ks], af[q][ks], a1[q], 0, 0, 0); }
        }
#pragma unroll
        for (int q = 0; q < NI; ++q) { red[((q * 8 + wid) * 2 + 0) * 64 + lane] = a0[q]; red[((q * 8 + wid) * 2 + 1) * 64 + lane] = a1[q]; }
        __syncthreads();
        if (wid < NI && base + wid < nitems) {
            f32x4 s0 = red[((wid * 8) * 2 + 0) * 64 + lane], s1 = red[((wid * 8) * 2 + 1) * 64 + lane];
#pragma unroll
            for (int w = 1; w < 8; ++w) { s0 += red[((wid * 8 + w) * 2 + 0) * 64 + lane]; s1 += red[((wid * 8 + w) * 2 + 1) * 64 + lane]; }
            const int item = base + wid, mt = item & 7, ng = item >> 3;
            if constexpr (KIND == EK_WO || KIND == EK_DN) small_fused<KIND>(c, mt, ng, lane, s0, s1);
            else epi8<KIND>(c, MP + mt * 16 + fr, ng * 32 + 8 * fq, s0, s1);
        }
        __syncthreads();
    }
    }
    }
}

__device__ __forceinline__ int map_in(int n) {
    if (n < 512) return 2 * n;
    if (n < 1024) return 2 * (n - 512) + 1;
    if (n < 2048) { const int base = n < 1536 ? 1024 : 1536, cc = n - base, h = cc >> 7, d = cc & 127; return base + h * 128 + 2 * (d & 63) + (d >> 6); }
    return n;
}
struct WItem { const float* W; bf16_t* WT; int K, N, r; bool mapin; };
__device__ __forceinline__ void wt_load(const WItem& w, int lane, f32x4 (&v)[8]) {
    const int nblk = w.N / 32, kb = w.r / nblk, nb = w.r % nblk, k0 = 64 * kb, n0 = 32 * nb, kr = lane >> 3, seg = lane & 7;
    const float* wp = w.W + (size_t)(k0 + kr) * w.N + n0 + seg * 4;
#pragma unroll
    for (int i = 0; i < 8; ++i) v[i] = __builtin_nontemporal_load((const f32x4*)(wp + (size_t)(8 * i) * w.N));
}
__device__ __forceinline__ void wt_finish(const WItem& w, int lane, const f32x4 (&v)[8], LAS float* scr) {
    const int nblk = w.N / 32, kb = w.r / nblk, nb = w.r % nblk, k0 = 64 * kb, n0 = 32 * nb, kr = lane >> 3, seg = lane & 7;
#pragma unroll
    for (int i = 0; i < 8; ++i) { LAS float* d = scr + (8 * i + kr) * 33 + seg * 4; d[0] = v[i][0]; d[1] = v[i][1]; d[2] = v[i][2]; d[3] = v[i][3]; }
    LDS_WAIT();
    const int ch = lane & 7;
#pragma unroll
    for (int j = 0; j < 4; ++j) { const int n = (lane >> 3) + 8 * j; const LAS float* s = scr + (8 * ch) * 33 + n;
        u32x4 o; o.x = pk2(s[0 * 33], s[1 * 33]); o.y = pk2(s[2 * 33], s[3 * 33]); o.z = pk2(s[4 * 33], s[5 * 33]); o.w = pk2(s[6 * 33], s[7 * 33]);
        const int dn = w.mapin ? map_in(n0 + n) : (n0 + n);
        *(u32x4*)(w.WT + (size_t)dn * w.K + k0 + 8 * ch) = o; }
    LDS_WAIT();
}
constexpr int WI_IN = (DM / 64) * (NIN / 32);
constexpr int WI_CO = (CD / 64) * (DM / 32), WI_RO = (DM / 64) * (DM / 32), WI_O = WI_RO, WI_UP = (DM / 64) * (FF / 32), WI_DN = (FF / 64) * (DM / 32);
constexpr int WI_TOTAL = WI_IN + WI_CO + WI_RO + WI_O + WI_UP + WI_DN;

__device__ __forceinline__ void wt_pair(const Ctx& c, int p, int lane, LAS float* scr) {
    int r = 2 * p; WItem w;
    if (r < WI_IN) { w.W = c.w_in; w.WT = (bf16_t*)(c.ws + WS_WIN); w.K = DM; w.N = NIN; w.mapin = true; }
    else if ((r -= WI_IN) < WI_CO) { w.W = c.w_co; w.WT = (bf16_t*)(c.ws + WS_WCO); w.K = CD; w.N = DM; w.mapin = false; }
    else if ((r -= WI_CO) < WI_RO) { w.W = c.w_ro; w.WT = (bf16_t*)(c.ws + WS_WRO); w.K = DM; w.N = DM; w.mapin = false; }
    else if ((r -= WI_RO) < WI_O) { w.W = c.w_o; w.WT = (bf16_t*)(c.ws + WS_WO); w.K = DM; w.N = DM; w.mapin = false; }
    else if ((r -= WI_O) < WI_UP) { w.W = c.w_up; w.WT = (bf16_t*)(c.ws + WS_WUP); w.K = DM; w.N = FF; w.mapin = false; }
    else { r -= WI_UP; w.W = c.w_dn; w.WT = (bf16_t*)(c.ws + WS_WDN); w.K = FF; w.N = DM; w.mapin = false; }
    WItem w1 = w; w.r = r; w1.r = r + 1;
    f32x4 va[8], vb[8];
    wt_load(w, lane, va); wt_load(w1, lane, vb);
    wt_finish(w, lane, va, scr); wt_finish(w1, lane, vb, scr);
}
__device__ __forceinline__ void rms_rows4_to_bf16(const Ctx& c, int row0, int stride, const float* w, bf16_t* XN, int lane) {
    f32x4 v[4][4];
#pragma unroll
    for (int r = 0; r < 4; ++r) { const int row = row0 + r * stride;
        if (row < RT) { const float* x = xrow(c, row);
#pragma unroll
            for (int j = 0; j < 4; ++j) v[r][j] = __builtin_nontemporal_load((const f32x4*)x + 64 * j + lane); } }
#pragma unroll
    for (int r = 0; r < 4; ++r) { const int row = row0 + r * stride;
        if (row < RT) { float s = 0.f;
#pragma unroll
            for (int j = 0; j < 4; ++j) s += (v[r][j].x * v[r][j].x + v[r][j].y * v[r][j].y) + (v[r][j].z * v[r][j].z + v[r][j].w * v[r][j].w);
            const float rs = 1.0f / sqrtf(wave_sum(s) * (1.0f / DM) + EPS);
#pragma unroll
            for (int j = 0; j < 4; ++j) { const f32x4 g = *((const f32x4*)w + 64 * j + lane);
                u32x2 p; p.x = pk2(v[r][j].x * rs * g.x, v[r][j].y * rs * g.y); p.y = pk2(v[r][j].z * rs * g.z, v[r][j].w * rs * g.w);
                *((u32x2*)(XN + (size_t)row * DM) + 64 * j + lane) = p; } } }
}
__device__ __forceinline__ void phase0(const Ctx& c, LAS unsigned char* lds) {
    const int tid = otid(), wid = __builtin_amdgcn_readfirstlane(tid >> 6), lane = tid & 63;
    if (blockIdx.x == 0 && tid < 64) {
        const float xi = (float)tid / 63.0f;
        const float p = (float)exp((double)xi * 9.210340371976184);
        ((float*)(c.ws + WS_CTL + 256))[tid] = 1.0f / p;
    }
    LAS float* scr = (LAS float*)(lds + wid * 16384);
    const int gw = blockIdx.x * 8 + wid, NGW = gridDim.x * 8;
    for (size_t i = (size_t)blockIdx.x * 512 + tid; i < XCH_WORDS; i += (size_t)gridDim.x * 512)
        __hip_atomic_store((unsigned long long*)(c.ws + WS_XCH) + i, 0ull, __ATOMIC_RELAXED, __HIP_MEMORY_SCOPE_AGENT);
    bf16_t* XN = (bf16_t*)c.out;
    for (int row = gw; row < RT; row += 4 * NGW) rms_rows4_to_bf16(c, row, NGW, c.n_mix_pre, XN, lane);
    for (int p = gw; p < WI_IN / 2; p += NGW) wt_pair(c, p, lane, scr);
}

__device__ __forceinline__ void ret_prompt_item(const Ctx& c, LAS unsigned char* lds, int item) {
    const int tid = otid(), wid = __builtin_amdgcn_readfirstlane(tid >> 6), lane = tid & 63, fr = lane & 15, fq = lane >> 4;
    const int s = item & 3, h = (item >> 2) & 3, b = item >> 4;
    const float l2g = log2f(1.0f - exp2f(-5.0f - (float)h));
    unsigned char* act = c.ws + WS_ACT;
    const bf16_t* Q = (const bf16_t*)(act + A_Q); const bf16_t* Kg = (const bf16_t*)(act + A_K); const bf16_t* V = (const bf16_t*)(act + A_V); bf16_t* OB = (bf16_t*)c.out;
    float* SSQ = (float*)(c.ws + WS_SSQ);
    constexpr int LD = 136;
    LAS bf16_t* sQ = (LAS bf16_t*)lds; LAS bf16_t* sK = sQ + 128 * LD; LAS bf16_t* sKT = sK + 128 * LD; LAS bf16_t* sVT = sKT + 128 * LD; LAS bf16_t* sST = sVT + 64 * LD;
    for (int i = tid; i < 64 * LD / 2; i += 512) ((LAS unsigned*)sST)[i] = 0u;
    f32x4 Sacc[4];
#pragma unroll
    for (int e = 0; e < 4; ++e) Sacc[e] = (f32x4){0.f, 0.f, 0.f, 0.f};
    const float gC = exp2f(128.0f * l2g);
    const int il = 16 * wid + fr;
    u32x4 rq[4], rk[4]; unsigned kv[16], vv[8]; u32x2 sgv[4], sgc[4];
    const bf16_t* SGp = (const bf16_t*)(act + A_SG);
    const int dp = tid & 63, ep = tid & 31, jgv = tid >> 5;
    const int jgk = wid;
    const unsigned toq = (unsigned)(((tid >> 4) * 512 + (tid & 15) * 8) * 2);
    const unsigned tok = (unsigned)(2 * dp * 2);
    const unsigned tov = (unsigned)(((jgv * 8) * 1024 + 2 * ep) * 2);
    const unsigned tosg = (unsigned)((il * 1024 + 4 * fq) * 2);
#define RET_LOAD(CH) do { const size_t r0_ = (size_t)b * SEQ + (size_t)(CH) * 128; \
        const char* qb_ = (const char*)(Q + r0_ * 512 + h * 128); const char* kb_ = (const char*)(Kg + r0_ * 512 + h * 128); \
        const char* kt_ = (const char*)(Kg + (r0_ + jgk * 16) * 512 + h * 128); const char* vb_ = (const char*)(V + r0_ * 1024 + h * 256 + s * 64); \
        _Pragma("unroll") for (int i = 0; i < 4; ++i) { rq[i] = *(const u32x4*)(qb_ + (size_t)i * 32768 + toq); rk[i] = *(const u32x4*)(kb_ + (size_t)i * 32768 + toq); } \
        _Pragma("unroll") for (int jj = 0; jj < 16; ++jj) kv[jj] = *(const unsigned*)(kt_ + (size_t)jj * 1024 + tok); \
        _Pragma("unroll") for (int jj = 0; jj < 8; ++jj) vv[jj] = *(const unsigned*)(vb_ + (size_t)jj * 2048 + tov); \
        const char* sg_ = (const char*)(SGp + r0_ * 1024 + h * 256 + s * 64); \
        _Pragma("unroll") for (int et = 0; et < 4; ++et) sgv[et] = *(const u32x2*)(sg_ + (size_t)et * 32 + tosg); } while (0)
    RET_LOAD(0);
    for (int ch = 0; ch < SEQ / 128; ++ch) {
        const size_t r0 = (size_t)b * SEQ + (size_t)ch * 128;
#pragma unroll
        for (int i = 0; i < 4; ++i) { const int id = tid + 512 * i, row = id >> 4, cq = id & 15;
            *(LAS u32x4*)(sQ + row * LD + cq * 8) = rq[i]; *(LAS u32x4*)(sK + row * LD + cq * 8) = rk[i]; }
        {
            unsigned lo[8], hi[8];
#pragma unroll
            for (int jj = 0; jj < 16; jj += 2) {
                const float d0 = exp2f((float)(127 - (jgk * 16 + jj)) * l2g), d1 = exp2f((float)(127 - (jgk * 16 + jj + 1)) * l2g);
                lo[jj >> 1] = pk2(bflo(kv[jj]) * d0, bflo(kv[jj + 1]) * d1); hi[jj >> 1] = pk2(bfhi(kv[jj]) * d0, bfhi(kv[jj + 1]) * d1);
            }
            LAS u32x4* p0 = (LAS u32x4*)(sKT + (2 * dp) * LD + jgk * 16); LAS u32x4* p1 = (LAS u32x4*)(sKT + (2 * dp + 1) * LD + jgk * 16);
            p0[0] = (u32x4){lo[0], lo[1], lo[2], lo[3]}; p0[1] = (u32x4){lo[4], lo[5], lo[6], lo[7]};
            p1[0] = (u32x4){hi[0], hi[1], hi[2], hi[3]}; p1[1] = (u32x4){hi[4], hi[5], hi[6], hi[7]};
        }
        {
            u32x4 lo, hi;
            lo.x = (vv[0] & 0xffffu) | (vv[1] << 16); lo.y = (vv[2] & 0xffffu) | (vv[3] << 16); lo.z = (vv[4] & 0xffffu) | (vv[5] << 16); lo.w = (vv[6] & 0xffffu) | (vv[7] << 16);
            hi.x = (vv[0] >> 16) | (vv[1] & 0xffff0000u); hi.y = (vv[2] >> 16) | (vv[3] & 0xffff0000u); hi.z = (vv[4] >> 16) | (vv[5] & 0xffff0000u); hi.w = (vv[6] >> 16) | (vv[7] & 0xffff0000u);
            *(LAS u32x4*)(sVT + (2 * ep) * LD + jgv * 8) = lo; *(LAS u32x4*)(sVT + (2 * ep + 1) * LD + jgv * 8) = hi;
        }
#pragma unroll
        for (int et = 0; et < 4; ++et) sgc[et] = sgv[et];
        if (ch + 1 < SEQ / 128) RET_LOAD(ch + 1);
        __syncthreads();
        bf16x8 qf[4];
#pragma unroll
        for (int ks = 0; ks < 4; ++ks) qf[ks] = *(const LAS bf16x8*)(sQ + il * LD + ks * 32 + fq * 8);
        f32x4 sc[8];
#pragma unroll
        for (int jp = 0; jp < 8; jp += 2) {
            bf16x8 kf[2][4];
#pragma unroll
            for (int t = 0; t < 2; ++t)
#pragma unroll
                for (int ks = 0; ks < 4; ++ks) kf[t][ks] = *(const LAS bf16x8*)(sK + ((jp + t) * 16 + fr) * LD + ks * 32 + fq * 8);
#pragma unroll
            for (int t = 0; t < 2; ++t) { sc[jp + t] = (f32x4){0.f, 0.f, 0.f, 0.f};
#pragma unroll
                for (int ks = 0; ks < 4; ++ks) sc[jp + t] = __builtin_amdgcn_mfma_f32_16x16x32_bf16(kf[t][ks], qf[ks], sc[jp + t], 0, 0, 0); }
        }
        __syncthreads();
#pragma unroll
        for (int jt = 0; jt < 8; ++jt) { float pv[4];
#pragma unroll
            for (int jj = 0; jj < 4; ++jj) { const int df = il - (jt * 16 + 4 * fq + jj); pv[jj] = df >= 0 ? sc[jt][jj] * exp2f((float)df * l2g) : 0.f; }
            u32x2 w; w.x = pk2(pv[0], pv[1]); w.y = pk2(pv[2], pv[3]);
            *(LAS u32x2*)(sK + il * LD + jt * 16 + 4 * fq) = w; }
        LDS_WAIT(); __builtin_amdgcn_wave_barrier();
        f32x4 o[4];
#pragma unroll
        for (int ep2 = 0; ep2 < 4; ep2 += 2) {
            bf16x8 sf[2][4];
#pragma unroll
            for (int t = 0; t < 2; ++t)
#pragma unroll
                for (int ks = 0; ks < 4; ++ks) sf[t][ks] = *(const LAS bf16x8*)(sST + ((ep2 + t) * 16 + fr) * LD + ks * 32 + fq * 8);
#pragma unroll
            for (int t = 0; t < 2; ++t) { o[ep2 + t] = (f32x4){0.f, 0.f, 0.f, 0.f};
#pragma unroll
                for (int ks = 0; ks < 4; ++ks) o[ep2 + t] = __builtin_amdgcn_mfma_f32_16x16x32_bf16(sf[t][ks], qf[ks], o[ep2 + t], 0, 0, 0); }
        }
        const float qd = exp2f((float)(il + 1) * l2g);
#pragma unroll
        for (int et = 0; et < 4; ++et) { o[et] *= qd; Sacc[et] *= gC; }
#pragma unroll
        for (int k2 = 0; k2 < 4; k2 += 2) {
            bf16x8 pf[2], kf[2], vf[2][4];
#pragma unroll
            for (int t = 0; t < 2; ++t) { const int ks = k2 + t;
                pf[t] = *(const LAS bf16x8*)(sK + il * LD + ks * 32 + fq * 8); kf[t] = *(const LAS bf16x8*)(sKT + il * LD + ks * 32 + fq * 8);
#pragma unroll
                for (int et = 0; et < 4; ++et) vf[t][et] = *(const LAS bf16x8*)(sVT + (et * 16 + fr) * LD + ks * 32 + fq * 8); }
#pragma unroll
            for (int t = 0; t < 2; ++t)
#pragma unroll
                for (int et = 0; et < 4; ++et) { o[et] = __builtin_amdgcn_mfma_f32_16x16x32_bf16(vf[t][et], pf[t], o[et], 0, 0, 0);
                    Sacc[et] = __builtin_amdgcn_mfma_f32_16x16x32_bf16(kf[t], vf[t][et], Sacc[et], 0, 0, 0); }
        }
        float ss = 0.f;
#pragma unroll
        for (int et = 0; et < 4; ++et) { ss += (o[et][0] * o[et][0] + o[et][1] * o[et][1]) + (o[et][2] * o[et][2] + o[et][3] * o[et][3]);
            u32x2 w; w.x = pk2(o[et][0] * bflo(sgc[et].x), o[et][1] * bfhi(sgc[et].x)); w.y = pk2(o[et][2] * bflo(sgc[et].y), o[et][3] * bfhi(sgc[et].y));
            *(u32x2*)(OB + (r0 + il) * 1024 + h * 256 + s * 64 + et * 16 + 4 * fq) = w; }
        ss += __shfl_xor(ss, 16); ss += __shfl_xor(ss, 32);
        if (fq == 0) SSQ[(r0 + il) * 16 + h * 4 + s] = ss;
        __syncthreads();
#pragma unroll
        for (int et = 0; et < 4; ++et) { u32x2 w; w.x = pk2(Sacc[et][0], Sacc[et][1]); w.y = pk2(Sacc[et][2], Sacc[et][3]);
            *(LAS u32x2*)(sST + (et * 16 + fr) * LD + 16 * wid + 4 * fq) = w; }
    }
    float* nrp = c.out + O_NRP + ((size_t)(b * NH + h) * DK) * DV + s * 64;
#pragma unroll
    for (int et = 0; et < 4; ++et)
#pragma unroll
        for (int jj = 0; jj < 4; ++jj) nrp[(size_t)(16 * wid + 4 * fq + jj) * DV + et * 16 + fr] = Sacc[et][jj];
    __syncthreads();
#undef RET_LOAD
}

__device__ __forceinline__ float block_sum(float v, LAS float* red, int tid) {
    v = wave_sum(v);
    __syncthreads();
    if ((tid & 63) == 0) red[tid >> 6] = v;
    __syncthreads();
    float t = 0.f;
#pragma unroll
    for (int w = 0; w < 8; ++w) t += red[w];
    return t;
}

__device__ __forceinline__ void ret_sample_item(const Ctx& c, LAS unsigned char* lds, int item) {
    const int tid = otid(), b = item >> 2, h = item & 3, row = MP + b;
    unsigned char* act = c.ws + WS_ACT;
    const bf16_t* Q = (const bf16_t*)(act + A_Q) + (size_t)row * 512 + h * 128; const bf16_t* Kg = (const bf16_t*)(act + A_K) + (size_t)row * 512 + h * 128;
    const bf16_t* V = (const bf16_t*)(act + A_V) + (size_t)row * 1024 + h * 256; bf16_t* OB = (bf16_t*)c.out + (size_t)row * 1024 + h * 256;
    LAS float* sq = (LAS float*)lds; LAS float* sk = sq + 128; LAS float* red = sk + 128; LAS float* part = red + 16;
    if (tid < 128) sq[tid] = bf2f(Q[tid]); else if (tid < 256) sk[tid - 128] = bf2f(Kg[tid - 128]);
    __syncthreads();
    const float g = 1.0f - exp2f(-5.0f - (float)h);
    const int e4 = (tid & 63) * 4, dg = tid >> 6;
    const u32x2 vw = *(const u32x2*)(V + e4);
    const f32x4 vv = {bflo(vw.x), bfhi(vw.x), bflo(vw.y), bfhi(vw.y)};
    const float* Sin = c.state_ret + ((size_t)(b * NH + h) * DK + dg * 16) * DV + e4;
    float* Sout = c.out + O_NRS + ((size_t)(b * NH + h) * DK + dg * 16) * DV + e4;
    f32x4 oa = {0.f, 0.f, 0.f, 0.f};
    f32x4 sv[16];
#pragma unroll
    for (int dd = 0; dd < 16; ++dd) sv[dd] = __builtin_nontemporal_load((const f32x4*)(Sin + (size_t)dd * DV));
#pragma unroll
    for (int dd = 0; dd < 16; ++dd) { const float kd = sk[dg * 16 + dd], qd = sq[dg * 16 + dd];
        const f32x4 sn = sv[dd] * g + vv * kd; __builtin_nontemporal_store(sn, (f32x4*)(Sout + (size_t)dd * DV)); oa += sn * qd; }
    *(LAS f32x4*)(part + dg * 256 + e4) = oa;
    __syncthreads();
    float ov = 0.f;
    if (tid < 256) {
#pragma unroll
        for (int w = 0; w < 8; ++w) ov += part[w * 256 + tid];
    }
    const float tot = block_sum(ov * ov, red, tid);
    const float rs = 1.0f / sqrtf(tot * (1.0f / DV) + EPS);
    if (tid < 256) OB[tid] = (bf16_t)(pk2(bf2f(((const bf16_t*)(act + A_SG))[(size_t)row * 1024 + h * 256 + tid]) * ov * rs, 0.f) & 0xffffu);
    __syncthreads();
}

__device__ __forceinline__ void conv_prompt_item(const Ctx& c, LAS unsigned char* lds, int item) {
    const int tid = otid(), wid = tid >> 6, lane = tid & 63, b = item >> 6, t0 = (item & 63) * 32;
    unsigned char* act = c.ws + WS_ACT;
    const bf16_t* U = (const bf16_t*)(act + A_U) + (size_t)b * SEQ * 512; bf16_t* AA = (bf16_t*)(act + A_AACT) + (size_t)b * SEQ * 512;
    LAS bf16_t* sU = (LAS bf16_t*)lds; LAS float* sC = (LAS float*)(lds + 63488);
    {
        u32x4 uv[8];
#pragma unroll
        for (int i = 0; i < 8; ++i) { const int id = tid + 512 * i, lr = id >> 6, cq = id & 63, t = t0 - 30 + lr;
            uv[i] = (u32x4){0u, 0u, 0u, 0u}; if (t >= 0 && lr < 62) uv[i] = __builtin_nontemporal_load((const u32x4*)(U + (size_t)t * 512 + cq * 8)); }
#pragma unroll
        for (int i = 0; i < 8; ++i) { const int id = tid + 512 * i, lr = id >> 6, cq = id & 63;
            if (lr < 62) *(LAS u32x4*)(sU + lr * 512 + cq * 8) = uv[i]; }
    }
    float wreg[CW];
#pragma unroll
    for (int w = 0; w < CW; ++w) wreg[w] = c.w_dw[w * CD + tid];
    const float bias = c.b_dw[tid];
    __syncthreads();
#pragma unroll 1
    for (int tb = 0; tb < 4; ++tb) {
        float a[8];
#pragma unroll
        for (int o = 0; o < 8; ++o) a[o] = bias;
#pragma unroll
        for (int k = 0; k < 38; ++k) { const float u = bf2f(sU[(tb * 8 + k) * 512 + tid]);
#pragma unroll
            for (int o = 0; o < 8; ++o) { const int w = k - o; if (w >= 0 && w < CW) a[o] += u * wreg[w]; } }
#pragma unroll
        for (int o = 0; o < 8; ++o) sC[(tb * 8 + o) * 512 + tid] = a[o];
    }
    __syncthreads();
    const f32x4 g0 = *(const f32x4*)(c.ln_w + lane * 4), g1 = *(const f32x4*)(c.ln_w + 256 + lane * 4), b0 = *(const f32x4*)(c.ln_b + lane * 4), b1 = *(const f32x4*)(c.ln_b + 256 + lane * 4);
    for (int rr = wid; rr < 32; rr += 8) {
        f32x4 x0 = *(const LAS f32x4*)(sC + rr * 512 + lane * 4), x1 = *(const LAS f32x4*)(sC + rr * 512 + 256 + lane * 4);
        const float mean = wave_sum((x0.x + x0.y) + (x0.z + x0.w) + (x1.x + x1.y) + (x1.z + x1.w)) * (1.0f / CD);
        x0 -= mean; x1 -= mean;
        const float var = wave_sum((x0.x * x0.x + x0.y * x0.y) + (x0.z * x0.z + x0.w * x0.w) + (x1.x * x1.x + x1.y * x1.y) + (x1.z * x1.z + x1.w * x1.w)) * (1.0f / CD);
        const float rstd = 1.0f / sqrtf(var + EPS);
        f32x4 y0 = x0 * rstd * g0 + b0, y1 = x1 * rstd * g1 + b1;
#pragma unroll
        for (int j = 0; j < 4; ++j) { y0[j] = y0[j] * sigm(y0[j]); y1[j] = y1[j] * sigm(y1[j]); }
        u32x2 w0, w1; w0.x = pk2(y0.x, y0.y); w0.y = pk2(y0.z, y0.w); w1.x = pk2(y1.x, y1.y); w1.y = pk2(y1.z, y1.w);
        bf16_t* dst = AA + (size_t)(t0 + rr) * 512;
        *(u32x2*)(dst + lane * 4) = w0; *(u32x2*)(dst + 256 + lane * 4) = w1;
    }
    if (t0 == SEQ - 32) {
        float* ncp = c.out + O_NCP + (size_t)b * 30 * CD;
        for (int id = tid; id < 30 * CD; id += 512) ncp[id] = bf2f(sU[(32 + (id >> 9)) * 512 + (id & 511)]);
    }
    __syncthreads();
}

__device__ __forceinline__ void conv_sample_item(const Ctx& c, LAS unsigned char* lds, int b) {
    const int tid = otid();
    unsigned char* act = c.ws + WS_ACT;
    LAS float* red = (LAS float*)lds;
    const float* cache = c.cache_conv + (size_t)b * 30 * CD; float* ncs = c.out + O_NCS + (size_t)b * 30 * CD;
    float acc = c.b_dw[tid];
#pragma unroll 1
    for (int w0 = 0; w0 < 30; w0 += 10) {
        float cv[10], wv[10];
#pragma unroll
        for (int w = 0; w < 10; ++w) { cv[w] = __builtin_nontemporal_load(cache + (w0 + w) * CD + tid); wv[w] = c.w_dw[(w0 + w) * CD + tid]; }
#pragma unroll
        for (int w = 0; w < 10; ++w) { acc += cv[w] * wv[w]; if (w0 + w >= 1) __builtin_nontemporal_store(cv[w], ncs + (w0 + w - 1) * CD + tid); }
    }
    const float u = bf2f(((const bf16_t*)(act + A_U))[(size_t)(MP + b) * 512 + tid]);
    acc += u * c.w_dw[30 * CD + tid]; ncs[29 * CD + tid] = u;
    const float mean = block_sum(acc, red, tid) * (1.0f / CD);
    const float d = acc - mean;
    const float var = block_sum(d * d, red, tid) * (1.0f / CD);
    float y = d * (1.0f / sqrtf(var + EPS)) * c.ln_w[tid] + c.ln_b[tid];
    y = y * sigm(y);
    ((bf16_t*)(act + A_AACT))[(size_t)(MP + b) * 512 + tid] = (bf16_t)(pk2(y, 0.f) & 0xffffu);
    __syncthreads();
}

__device__ __forceinline__ void phase2(const Ctx& c, LAS unsigned char* lds, int rep) {
    for (int it = blockIdx.x; it < NB * NH * 4; it += gridDim.x) { const int x = it & 7, j = it >> 3; ret_prompt_item(c, lds, (x * 4 + (j >> 2)) * 4 + (j & 3)); }
    unsigned* counter = (unsigned*)(c.ws + WS_CTL) + rep;
    LAS int* sItem = (LAS int*)(lds + LDS_BYTES - 16);
    constexpr int N_CONV = MP / 32, N_RS = MS * NH, N_CS = MS, N_WQ = (WI_TOTAL - WI_IN) / 16, NTOT = N_CONV + N_RS + N_CS + N_WQ;
    static_assert((WI_TOTAL - WI_IN) % 16 == 0, "weight queue items");
    unsigned nxt = 0u;
    if (threadIdx.x == 0) nxt = atomicAdd(counter, 1u);
    for (;;) {
        if (threadIdx.x == 0) { *sItem = (int)nxt; nxt = atomicAdd(counter, 1u); }
        __syncthreads();
        const int it = __builtin_amdgcn_readfirstlane(*sItem);
        __syncthreads();
        if (it >= NTOT) break;
        if (it < N_CS) conv_sample_item(c, lds, it);
        else if (it < N_CS + N_CONV) conv_prompt_item(c, lds, it - N_CS);
        else if (it < N_CS + N_CONV + N_RS) ret_sample_item(c, lds, it - N_CS - N_CONV);
        else { const int t_ = otid(); const int wv = __builtin_amdgcn_readfirstlane(t_ >> 6);
            wt_pair(c, WI_IN / 2 + (it - N_CS - N_CONV - N_RS) * 8 + wv, t_ & 63, (LAS float*)(lds + wv * 16384)); __syncthreads(); }
    }
}

__device__ __forceinline__ void phase2b(const Ctx& c) {
    const int t_ = otid(); const int lane = t_ & 63, gw = blockIdx.x * 8 + (t_ >> 6), NGW = gridDim.x * 8;
    unsigned char* act = c.ws + WS_ACT;
    const float* SSQ = (const float*)(c.ws + WS_SSQ);
    for (int row0 = gw; row0 < RT; row0 += 4 * NGW) {
        u32x4 a[4][2], o[4][2]; float rs[4];
#pragma unroll
        for (int r = 0; r < 4; ++r) { const int row = row0 + r * NGW; rs[r] = 1.0f;
            if (row < RT) {
                const u32x4* sg = (const u32x4*)((bf16_t*)(act + A_SG) + (size_t)row * 1024 + lane * 16);
                const u32x4* ov = (const u32x4*)((const bf16_t*)c.out + (size_t)row * 1024 + lane * 16);
#pragma unroll
                for (int j = 0; j < 2; ++j) { a[r][j] = __builtin_nontemporal_load(sg + j); o[r][j] = __builtin_nontemporal_load(ov + j); }
                if (row < MP) { const f32x4 q = *(const f32x4*)(SSQ + (size_t)row * 16 + (lane >> 4) * 4); rs[r] = 1.0f / sqrtf(((q.x + q.y) + (q.z + q.w)) * (1.0f / DV) + EPS); }
            } }
#pragma unroll
        for (int r = 0; r < 4; ++r) { const int row = row0 + r * NGW;
            if (row < RT) { u32x4* dg = (u32x4*)((bf16_t*)(act + A_SG) + (size_t)row * 1024 + lane * 16); const float k = rs[r];
#pragma unroll
                for (int j = 0; j < 2; ++j) { const u32x4 x = a[r][j], y = o[r][j]; u32x4 w;
                    w.x = pk2(bflo(x.x) * bflo(y.x) * k, bfhi(x.x) * bfhi(y.x) * k); w.y = pk2(bflo(x.y) * bflo(y.y) * k, bfhi(x.y) * bfhi(y.y) * k);
                    w.z = pk2(bflo(x.z) * bflo(y.z) * k, bfhi(x.z) * bfhi(y.z) * k); w.w = pk2(bflo(x.w) * bflo(y.w) * k, bfhi(x.w) * bfhi(y.w) * k);
                    dg[j] = w; } } }
    }
}


#define XB_TMO      128
#define XB_XCNT(j)  (256  + 64 * (j))
#define XB_XSUB(j)  (1280 + 64 * (j))
#define XB_XGEN(j)  (2304 + 64 * (j))
#define XB_TOP      3328
#define XB_TOPGEN   3392
#define XCD_BAR_WORDS 3456
#define XB_SPIN_CAP (1u << 22)
__device__ __forceinline__ unsigned xb_ld(unsigned* p)              { return __hip_atomic_load(p, __ATOMIC_RELAXED, __HIP_MEMORY_SCOPE_AGENT); }
__device__ __forceinline__ unsigned xb_add(unsigned* p, unsigned v) { return __hip_atomic_fetch_add(p, v, __ATOMIC_RELAXED, __HIP_MEMORY_SCOPE_AGENT); }
__device__ __forceinline__ unsigned xb_xcc_id() { return (unsigned)__builtin_amdgcn_s_getreg((3 << 11) | 20) & 0xFu; }
#define XB_SPIN(cond, bar) do { unsigned _sp = 0; while (cond) { __builtin_amdgcn_s_sleep(1); \
    if ((++_sp & 255u) == 0u) { if (xb_ld(&(bar)[XB_TMO])) break; if (_sp > XB_SPIN_CAP) { atomicAdd(&(bar)[XB_TMO], 1u); break; } } } } while (0)
struct XcdBarrier { unsigned* bar; unsigned x; volatile LAS unsigned* st; };
__device__ __forceinline__ XcdBarrier xcd_barrier_post(unsigned* bar, volatile LAS unsigned* st) {
    XcdBarrier b; b.bar = bar; b.x = xb_xcc_id(); b.st = st;
    if (threadIdx.x == 0) (void)xb_add(&bar[XB_XCNT(b.x)], 1u);
    return b;
}
__device__ __forceinline__ void xcd_barrier_complete(unsigned* bar, unsigned x, unsigned& nloc, unsigned& nx) {
    const unsigned G = gridDim.x * gridDim.y * gridDim.z;
    unsigned sum, cnt, mine, sp = 0u;
    for (;;) {
        sum = 0u; cnt = 0u; mine = 0u;
#pragma unroll
        for (unsigned j = 0; j < 16; ++j) { const unsigned c = xb_ld(&bar[XB_XCNT(j)]); sum += c; cnt += (c > 0u) ? 1u : 0u; mine = (j == x) ? c : mine; }
        if (sum == G) break;
        __builtin_amdgcn_s_sleep(1);
        if ((++sp & 255u) == 0u) { if (xb_ld(&bar[XB_TMO])) break; if (sp > XB_SPIN_CAP) { atomicAdd(&bar[XB_TMO], 1u); break; } }
    }
    nloc = mine > 0u ? mine : 1u; nx = cnt > 0u ? cnt : 1u;
}
__device__ __forceinline__ void xcd_barrier(const XcdBarrier& b) {
    asm volatile("s_waitcnt vmcnt(0)" ::: "memory");
    __syncthreads();
    if (threadIdx.x == 0) {
        unsigned* bar = b.bar;
        __builtin_amdgcn_s_waitcnt(0);
        unsigned nloc = b.st[0], nx = b.st[1];
        if (nloc == 0u) { xcd_barrier_complete(bar, b.x, nloc, nx); b.st[0] = nloc; b.st[1] = nx; }
        const unsigned old = xb_add(&bar[XB_XSUB(b.x)], 1u);
        const unsigned gen = old / nloc;
        if (old + 1u == (gen + 1u) * nloc) {
            __builtin_amdgcn_fence(__ATOMIC_RELEASE, "agent");
            asm volatile("s_waitcnt vmcnt(0)" ::: "memory");
            const unsigned og = xb_add(&bar[XB_TOP], 1u);
            const unsigned tg = og / nx;
            if (og + 1u == (tg + 1u) * nx) xb_add(&bar[XB_TOPGEN], 1u);
            else XB_SPIN(xb_ld(&bar[XB_TOPGEN]) == tg, bar);
            __builtin_amdgcn_fence(__ATOMIC_ACQUIRE, "agent");
            xb_add(&bar[XB_XGEN(b.x)], 1u);
            asm volatile("s_waitcnt vmcnt(0)" ::: "memory");
        } else {
            XB_SPIN(xb_ld(&bar[XB_XGEN(b.x)]) == gen, bar);
            __builtin_amdgcn_fence(__ATOMIC_ACQUIRE, "agent");
            asm volatile("s_waitcnt vmcnt(0)" ::: "memory");
        }
    }
    __syncthreads();
}

__global__ void __launch_bounds__(512) fwd_megakernel(Ctx c) {
    extern __shared__ __attribute__((aligned(16))) unsigned char smem[];
    LAS unsigned char* lds = (LAS unsigned char*)smem;
    cg::grid_group grid = cg::this_grid();
    unsigned char* act = c.ws + WS_ACT;
    volatile LAS unsigned* xst = (volatile LAS unsigned*)(lds + LDS_BYTES - 32);
    if (threadIdx.x == 0) { xst[0] = 0u; xst[1] = 0u; }
    __syncthreads();
    const XcdBarrier xb = xcd_barrier_post((unsigned*)(c.ws + WS_BAR), xst);
    phase0(c, lds);
    if (c.ws == nullptr) grid.sync();
    xcd_barrier(xb);
    gemm_all<EK_IN, NIN, DM, 3, Epi<EK_IN>, true>(c, lds, (const bf16_t*)c.out, (const bf16_t*)(c.ws + WS_WIN));
    xcd_barrier(xb);
    phase2(c, lds, 0);
    xcd_barrier(xb);
    gemm_all<EK_CO, DM, CD, 1, Epi<EK_CO>, true>(c, lds, (const bf16_t*)(act + A_AACT), (const bf16_t*)(c.ws + WS_WCO));
    gemm_all<EK_RO, DM, DM, 1, Epi<EK_RO>, true, true>(c, lds, (const bf16_t*)c.out, (const bf16_t*)(c.ws + WS_WRO));
    xcd_barrier(xb);
    gemm_all<EK_WO, DM, DM, 1, EpiWoFused>(c, lds, (const bf16_t*)(act + A_SB), (const bf16_t*)(c.ws + WS_WO));
    xcd_barrier(xb);
    gemm_all<EK_UP, FF, DM, 4, Epi<EK_UP>, true>(c, lds, (const bf16_t*)(act + A_HN), (const bf16_t*)(c.ws + WS_WUP));
    xcd_barrier(xb);
    gemm_all<EK_DN, DM, FF, 1, EpiDnFused>(c, lds, (const bf16_t*)(act + A_UP), (const bf16_t*)(c.ws + WS_WDN));
}

extern "C" void kernel_launch(void* const* d_in, const int* in_sizes, int n_in, void* d_out, int out_size, void* d_ws, size_t ws_size, hipStream_t stream) {
    static int grid_blocks = 0;
    if (!grid_blocks) {
        if (n_in != 18 || ws_size < WS_END2) { fprintf(stderr, "kernel_launch: unexpected n_in %d / ws_size %zu (need %zu)\n", n_in, ws_size, (size_t)WS_END2); grid_blocks = -1; return; }
        int dev = 0, cus = 0, per_cu = 0;
        hipGetDevice(&dev);
        hipDeviceGetAttribute(&cus, hipDeviceAttributeMultiprocessorCount, dev);
        if (hipFuncSetAttribute((const void*)fwd_megakernel, hipFuncAttributeMaxDynamicSharedMemorySize, LDS_BYTES) != hipSuccess) fprintf(stderr, "kernel_launch: hipFuncSetAttribute failed\n");
        hipOccupancyMaxActiveBlocksPerMultiprocessor(&per_cu, (const void*)fwd_megakernel, 512, LDS_BYTES);
        (void)hipGetLastError();
        if (per_cu < 1) { fprintf(stderr, "kernel_launch: occupancy query says %d blocks per CU\n", per_cu); per_cu = 1; }
        grid_blocks = cus * per_cu; if (grid_blocks > 256) grid_blocks = 256;
    }
    if (grid_blocks < 0) return;
    (void)hipMemsetAsync((char*)d_ws + WS_CTL, 0, CTL_ZERO, stream);
    Ctx c{};
    const float** f = (const float**)&c;
    for (int i = 0; i < 18; ++i) f[i] = (const float*)d_in[i];
    c.out = (float*)d_out; c.ws = (unsigned char*)d_ws;
    void* args[] = {&c};
    hipError_t e = hipLaunchCooperativeKernel((const void*)fwd_megakernel, dim3(grid_blocks), dim3(512), args, LDS_BYTES, stream);
    if (e != hipSuccess) fprintf(stderr, "cooperative launch failed: %s (grid %d)\n", hipGetErrorString(e), grid_blocks);
}
```

```cpp
#include <hip/hip_runtime.h>
#include <hip/hip_cooperative_groups.h>
#include <cstdio>
#include <cstdint>
namespace cg = cooperative_groups;

#define LAS __attribute__((address_space(3)))
typedef unsigned short bf16_t;
typedef short bf16x8 __attribute__((ext_vector_type(8)));
typedef float f32x4 __attribute__((ext_vector_type(4)));
typedef unsigned u32x4 __attribute__((ext_vector_type(4)));
typedef unsigned u32x2 __attribute__((ext_vector_type(2)));

constexpr int DM = 1024, NB = 8, SEQ = 2048, MP = NB * SEQ  , MS = 128, RT = MP + MS  ;
constexpr int CD = 512, CW = 31, NH = 4, DK = 128, DV = 256, FF = 4096, NIN = 6144;
constexpr float EPS = 1e-6f;
constexpr size_t O_NCP = (size_t)RT * DM;
constexpr size_t O_NRP = O_NCP + (size_t)NB * 30 * CD;
constexpr size_t O_NCS = O_NRP + (size_t)NB * NH * DK * DV;
constexpr size_t O_NRS = O_NCS + (size_t)MS * 30 * CD;
constexpr size_t WS_CTL = 0, WS_BAR = 4096, WS_WIN = 131072, WS_WCO = WS_WIN + (size_t)NIN * DM * 2, WS_WRO = WS_WCO + (size_t)DM * CD * 2,
                 WS_WO = WS_WRO + (size_t)DM * DM * 2, WS_WUP = WS_WO + (size_t)DM * DM * 2, WS_WDN = WS_WUP + (size_t)FF * DM * 2,
                 WS_ACT = WS_WDN + (size_t)FF * DM * 2;
constexpr size_t A_U = 0, A_Q = A_U + (size_t)RT * 512 * 2, A_K = A_Q + (size_t)RT * 512 * 2, A_V = A_K + (size_t)RT * 512 * 2,
                 A_SG = A_V + (size_t)RT * 1024 * 2, A_SA = A_SG + (size_t)RT * 1024 * 2, A_SB = A_SA + (size_t)RT * 1024 * 2,
                 A_AACT = A_SB + (size_t)RT * 1024 * 2, A_END = A_AACT + (size_t)RT * 512 * 2;
constexpr size_t A_M2 = (size_t)RT * 1024 * 2  , A_HN = 0  , A_F = 0  , A_UP = (size_t)RT * 1024 * 4;
static_assert(A_UP + (size_t)RT * FF * 2 <= A_END, "act region");
constexpr size_t WS_SSQ = WS_ACT + A_END, WS_END = WS_SSQ + (size_t)MP * 16 * 4;
constexpr size_t WS_XCH = WS_END;
constexpr size_t WS_XCHS = WS_XCH + 3 * 64 * 256 * 4 * 4;
constexpr size_t WS_END2 = WS_XCHS + 3 * 8 * 16 * 32 * 4;
constexpr size_t CTL_XCNT = 20480;
constexpr size_t CTL_XCNTS = CTL_XCNT + 3 * 64 * 256;
constexpr size_t CTL_ZERO = CTL_XCNTS + 3 * 8 * 256;
static_assert(CTL_ZERO <= WS_WIN, "control words");
constexpr size_t WS_RS2S = WS_END2;
constexpr size_t WS_END3 = WS_RS2S + 128 * 4;
constexpr int LDS_BYTES = 147456;

struct Ctx {
    const float *xp, *xs, *cache_conv, *state_ret, *n_mix_pre, *n_mix_post, *w_in, *w_dw, *b_dw, *ln_w, *ln_b, *w_co, *w_ro, *w_o,
        *n_ffn_pre, *n_ffn_post, *w_up, *w_dn;
    float* out; unsigned char* ws;
};

__device__ __forceinline__ unsigned pk2(float lo, float hi) { unsigned r; asm volatile("v_cvt_pk_bf16_f32 %0, %1, %2" : "=v"(r) : "v"(lo), "v"(hi)); return r; }
__device__ __forceinline__ float bflo(unsigned w) { return __uint_as_float(w << 16); }
__device__ __forceinline__ float bfhi(unsigned w) { return __uint_as_float(w & 0xffff0000u); }
__device__ __forceinline__ float bf2f(bf16_t b) { return __uint_as_float(((unsigned)b) << 16); }
__device__ __forceinline__ float sigm(float x) { return __builtin_amdgcn_rcpf(1.0f + __expf(-x)); }
__device__ __forceinline__ float wave_sum(float v) {
#pragma unroll
    for (int o = 1; o < 64; o <<= 1) v += __shfl_xor(v, o);
    return v;
}
#define LDS_WAIT() asm volatile("s_waitcnt lgkmcnt(0)" ::: "memory")
__device__ __forceinline__ int otid() { int t = threadIdx.x; asm volatile("" : "+v"(t)); return t; }
__device__ __forceinline__ const float* xrow(const Ctx& c, int row) { return row < MP ? c.xp + (size_t)row * DM : c.xs + (size_t)(row - MP) * DM; }

namespace pg8 {
constexpr int BM = 256, BK = 64, HALF = 128, HTB = HALF * BK * 2, STAGE_BYTES = 8 * HTB, NXCD = 8, WGM = 8;
__host__ __device__ __forceinline__ int lds_byte(int r, int c) { const int st = (r >> 4) * 2 + (c >> 5), rr = r & 15, cc = c & 31, ob = rr * 64 + cc * 2; return st * 1024 + (ob ^ (((ob >> 9) & 1) << 5)); }
__host__ __device__ __forceinline__ void stage_rc(int b, int& R, int& C) { const int st = b / 1024, sb = b % 1024, swz = sb ^ (((sb >> 9) & 1) << 5); R = (st >> 1) * 16 + swz / 64; C = (st & 1) * 32 + (swz % 64) / 2; }
__host__ __device__ __forceinline__ int perm32(int rho) { const int n = rho >> 4, i = rho & 15; return 8 * (i >> 2) + 4 * n + (i & 3); }
struct Unit { int pm, pn; };
struct Gemm { const bf16_t* A; const bf16_t* Bt; int M, N, K; const float* ssq = nullptr; };
struct StaticOrder {
    int nM, nN, nwg, G, c;
    __device__ void init(int M, int N, int G_, int c_) { nM = M / BM; nN = N / BM; nwg = nM * nN; G = G_; c = c_; }
    __device__ bool next(int i, Unit& u) const {
        const long L = (long)i * G + c; if (L >= nwg) return false;
        int wgid = (int)L; { const int q = nwg / NXCD, r = nwg % NXCD, xcd = wgid % NXCD, off = wgid / NXCD; wgid = (xcd < r ? xcd * (q + 1) : r * (q + 1) + (xcd - r) * q) + off; }
        const int nig = WGM * nN, gid = wgid / nig, fm = gid * WGM, gsz = (nM - fm) < WGM ? (nM - fm) : WGM;
        u.pm = fm + ((wgid % nig) % gsz); u.pn = (wgid % nig) / gsz; return true;
    }
};
template <class Epi, bool ALIGN_EPI = false, bool SP2 = true, bool HNORM = false, bool RS2TAB = false>
__device__ __forceinline__ void gemm_phase(LAS unsigned char* lds, const Gemm g, const StaticOrder& S, const Epi& E) {
    int tid_ = threadIdx.x; asm volatile("" : "+v"(tid_));
    const int tid = tid_, wid = __builtin_amdgcn_readfirstlane(tid >> 6), lane = tid & 63, wr = wid >> 2, wc = wid & 3, fr = lane & 15, fq = lane >> 4;
    const int K = g.K, nt = K / BK;
    unsigned voffA[2], voffB[2];
#pragma unroll
    for (int i = 0; i < 2; ++i) { int R, C; stage_rc(tid * 16 + i * 8192, R, C); const int Rb = (R & ~31) + perm32(R & 31);
        voffA[i] = (unsigned)(R * K + C) * 2u; voffB[i] = (unsigned)(Rb * K + C) * 2u; }
    const size_t kstep = (size_t)(BK * 2);
    const size_t hstep = (size_t)HALF * K * 2;
    const size_t tstep = 2 * hstep;
    const unsigned ldsw = (unsigned)wid * 1024u;
    const int aoff = lds_byte(wr * 64 + fr, fq * 8), boff = lds_byte(wc * 32 + fr, fq * 8);
#define PG8_SA(b, h) (((b) * 2 + (h)) * HTB)
#define PG8_SB(b, h) ((4 + (b) * 2 + (h)) * HTB)
#define PG8_STAGE(bufoff, gbase, voff) do { _Pragma("unroll") for (int _i = 0; _i < 2; ++_i) \
        __builtin_amdgcn_global_load_lds((const unsigned*)((const char*)(gbase) + (voff)[_i]), (LAS unsigned*)(lds + (bufoff) + ldsw + _i * 8192), 16, 0, 0); } while (0)
#define PG8_LDA(dst, b, h) do { _Pragma("unroll") for (int m = 0; m < 4; ++m) _Pragma("unroll") for (int k = 0; k < 2; ++k) dst[m][k] = *(const LAS bf16x8*)(lds + PG8_SA(b, h) + aoff + m * 2048 + k * 1024); } while (0)
#define PG8_LDB(dst, b, h) do { _Pragma("unroll") for (int n = 0; n < 2; ++n) _Pragma("unroll") for (int k = 0; k < 2; ++k) dst[n][k] = *(const LAS bf16x8*)(lds + PG8_SB(b, h) + boff + n * 2048 + k * 1024); } while (0)
#define PG8_MMA(ai, bj, At, Bt) do { __builtin_amdgcn_s_setprio(1); _Pragma("unroll") for (int m = 0; m < 4; ++m) _Pragma("unroll") for (int n = 0; n < 2; ++n) _Pragma("unroll") for (int k = 0; k < 2; ++k) \
        acc[ai][bj][m][n] = __builtin_amdgcn_mfma_f32_16x16x32_bf16(Bt[n][k], At[m][k], acc[ai][bj][m][n], 0, 0, 0); __builtin_amdgcn_s_setprio(0); } while (0)
#define PG8_WAIT_V(n) asm volatile("s_waitcnt vmcnt(" #n ")" ::: "memory")
#define PG8_WAIT_L(n) asm volatile("s_waitcnt lgkmcnt(" #n ")" ::: "memory")
#define PG8_BAR __builtin_amdgcn_s_barrier()
#define PG8_SCHED __builtin_amdgcn_sched_barrier(0)
    Unit cur, nxt; int ui = 0;
    if (!S.next(0, cur)) return;
    f32x4 acc[2][2][4][2];
#pragma unroll
    for (int a = 0; a < 2; ++a)
#pragma unroll
        for (int b = 0; b < 2; ++b)
#pragma unroll
            for (int m = 0; m < 4; ++m)
#pragma unroll
                for (int n = 0; n < 2; ++n) acc[a][b][m][n] = (f32x4){0.f, 0.f, 0.f, 0.f};
    bf16x8 At[4][2], B0[2][2], B1[2][2];
    const char* cA = (const char*)g.A + (size_t)cur.pm * tstep; const char* cB = (const char*)g.Bt + (size_t)cur.pn * tstep;
    LAS float* hrt = (LAS float*)(lds + STAGE_BYTES);
    if constexpr (RS2TAB) {
        if (tid < 256) { const f32x4 q = *(const f32x4*)(g.ssq + (size_t)(cur.pm * 256 + tid) * 4); hrt[tid] = 1.0f / sqrtf(((q.x + q.y) + (q.z + q.w)) * (1.0f / 1024.0f) + 1e-6f); }
        asm volatile("s_waitcnt vmcnt(0) lgkmcnt(0)" ::: "memory"); PG8_BAR;
    }
    if constexpr (HNORM) {
        if (tid < 256) { const float* q = g.ssq + (size_t)(cur.pm * 256 + tid) * 16; float r[4];
#pragma unroll
            for (int hh = 0; hh < 4; ++hh) { const f32x4 v = *(const f32x4*)(q + 4 * hh); r[hh] = 1.0f / sqrtf(((v.x + v.y) + (v.z + v.w)) * (1.0f / 256.0f) + 1e-6f); }
            *(LAS f32x4*)(hrt + tid * 4) = (f32x4){r[0] / r[1], r[1] / r[2], r[2] / r[3], r[3]}; }
        asm volatile("s_waitcnt vmcnt(0) lgkmcnt(0)" ::: "memory"); PG8_BAR;
    }
    if constexpr (SP2) {
        PG8_STAGE(PG8_SB(0, 0), cB, voffB); PG8_STAGE(PG8_SB(0, 1), cB + hstep, voffB); PG8_STAGE(PG8_SA(0, 0), cA, voffA); PG8_STAGE(PG8_SA(0, 1), cA + hstep, voffA);
        if (wr == 1) PG8_BAR;
        PG8_WAIT_V(2); PG8_BAR;
        PG8_STAGE(PG8_SB(1, 0), cB + kstep, voffB); PG8_STAGE(PG8_SA(1, 0), cA + kstep, voffA); PG8_STAGE(PG8_SB(1, 1), cB + hstep + kstep, voffB);
        PG8_WAIT_V(6); PG8_BAR;
    } else {
    PG8_STAGE(PG8_SB(0, 0), cB, voffB); PG8_STAGE(PG8_SA(0, 0), cA, voffA); PG8_STAGE(PG8_SB(0, 1), cB + hstep, voffB); PG8_STAGE(PG8_SA(0, 1), cA + hstep, voffA);
    if (wr == 1) PG8_BAR;
    PG8_WAIT_V(4); PG8_BAR;
    PG8_STAGE(PG8_SB(1, 0), cB + kstep, voffB); PG8_STAGE(PG8_SA(1, 0), cA + kstep, voffA); PG8_STAGE(PG8_SB(1, 1), cB + hstep + kstep, voffB);
    PG8_WAIT_V(6); PG8_BAR;
    }
    for (;;) {
        const bool has_next = S.next(ui + 1, nxt);
        const char* nA = has_next ? (const char*)g.A + (size_t)nxt.pm * tstep : cA; const char* nB = has_next ? (const char*)g.Bt + (size_t)nxt.pn * tstep : cB;
        for (int t = 0; t < nt; t += 2) {
            const bool last = (t == nt - 2);
            const char* a1 = cA + (size_t)(t + 1) * kstep;
            const char* a2 = last ? nA : cA + (size_t)(t + 2) * kstep; const char* b2 = last ? nB : cB + (size_t)(t + 2) * kstep;
            const char* a3 = a2 + kstep; const char* b3 = b2 + kstep;
            if constexpr (HNORM) { if (t == 4 || t == 8 || t == 12) { const int hi = (t >> 2) - 1;
#pragma unroll
                for (int ai = 0; ai < 2; ++ai)
#pragma unroll
                    for (int m = 0; m < 4; ++m) { const float f = hrt[(ai * 128 + wr * 64 + m * 16 + fr) * 4 + hi];
#pragma unroll
                        for (int bj = 0; bj < 2; ++bj)
#pragma unroll
                            for (int n = 0; n < 2; ++n) acc[ai][bj][m][n] *= f; } } }
            if constexpr (SP2) {
            PG8_LDB(B0, 0, 0); PG8_LDB(B1, 0, 1); PG8_SCHED; PG8_LDA(At, 0, 0); PG8_STAGE(PG8_SA(1, 1), a1 + hstep, voffA);
            PG8_WAIT_V(8); PG8_WAIT_L(0); PG8_BAR; PG8_MMA(0, 0, At, B0); PG8_MMA(0, 1, At, B1); PG8_BAR; PG8_SCHED;
            PG8_LDA(At, 0, 1); PG8_STAGE(PG8_SB(0, 0), b2, voffB); PG8_STAGE(PG8_SB(0, 1), b2 + hstep, voffB); PG8_STAGE(PG8_SA(0, 0), a2, voffA);
            PG8_WAIT_V(8); PG8_WAIT_L(0); PG8_BAR; PG8_MMA(1, 0, At, B0); PG8_MMA(1, 1, At, B1); PG8_BAR; PG8_SCHED;
            PG8_LDB(B0, 1, 0); PG8_LDB(B1, 1, 1); PG8_SCHED; PG8_LDA(At, 1, 0); PG8_STAGE(PG8_SA(0, 1), a2 + hstep, voffA);
            PG8_WAIT_V(8); PG8_WAIT_L(0); PG8_BAR; PG8_MMA(0, 0, At, B0); PG8_MMA(0, 1, At, B1); PG8_BAR; PG8_SCHED;
            PG8_LDA(At, 1, 1); PG8_STAGE(PG8_SB(1, 0), b3, voffB); PG8_STAGE(PG8_SB(1, 1), b3 + hstep, voffB); PG8_STAGE(PG8_SA(1, 0), a3, voffA);
            PG8_WAIT_V(8); PG8_WAIT_L(0); PG8_BAR; PG8_MMA(1, 0, At, B0); PG8_MMA(1, 1, At, B1); PG8_BAR; PG8_SCHED;
            } else {
            PG8_LDB(B0, 0, 0); PG8_SCHED; PG8_LDA(At, 0, 0); PG8_STAGE(PG8_SA(1, 1), a1 + hstep, voffA);
            PG8_WAIT_L(8); PG8_BAR; PG8_WAIT_L(0); PG8_MMA(0, 0, At, B0); PG8_BAR; PG8_SCHED;
            PG8_LDB(B1, 0, 1); PG8_STAGE(PG8_SB(0, 0), b2, voffB);
            PG8_BAR; PG8_WAIT_L(0); PG8_MMA(0, 1, At, B1); PG8_BAR;
            PG8_LDA(At, 0, 1); PG8_STAGE(PG8_SA(0, 0), a2, voffA);
            PG8_BAR; PG8_WAIT_L(0); PG8_MMA(1, 0, At, B0); PG8_BAR; PG8_SCHED;
            PG8_STAGE(PG8_SB(0, 1), b2 + hstep, voffB);
            PG8_WAIT_V(6); PG8_BAR; PG8_MMA(1, 1, At, B1); PG8_BAR;
            PG8_LDB(B0, 1, 0); PG8_SCHED; PG8_LDA(At, 1, 0); PG8_STAGE(PG8_SA(0, 1), a2 + hstep, voffA);
            PG8_WAIT_L(8); PG8_BAR; PG8_WAIT_L(0); PG8_MMA(0, 0, At, B0); PG8_BAR; PG8_SCHED;
            PG8_LDB(B1, 1, 1); PG8_STAGE(PG8_SB(1, 0), b3, voffB);
            PG8_BAR; PG8_WAIT_L(0); PG8_MMA(0, 1, At, B1); PG8_BAR;
            PG8_LDA(At, 1, 1); PG8_STAGE(PG8_SA(1, 0), a3, voffA);
            PG8_BAR; PG8_WAIT_L(0); PG8_MMA(1, 0, At, B0); PG8_BAR; PG8_SCHED;
            PG8_STAGE(PG8_SB(1, 1), b3 + hstep, voffB);
            PG8_WAIT_V(6); PG8_BAR; PG8_MMA(1, 1, At, B1); PG8_BAR;
            }
        }
        if constexpr (HNORM) {
#pragma unroll
            for (int ai = 0; ai < 2; ++ai)
#pragma unroll
                for (int m = 0; m < 4; ++m) { const float f = hrt[(ai * 128 + wr * 64 + m * 16 + fr) * 4 + 3];
#pragma unroll
                    for (int bj = 0; bj < 2; ++bj)
#pragma unroll
                        for (int n = 0; n < 2; ++n) acc[ai][bj][m][n] *= f; } }
        if constexpr (ALIGN_EPI) { if (wr == 0) PG8_BAR; }
        if constexpr (!Epi::AFTER_DRAIN) E(acc, cur, wr, wc, fr, fq);
        if (!has_next) break;
#pragma unroll
        for (int a = 0; a < 2; ++a)
#pragma unroll
            for (int b = 0; b < 2; ++b)
#pragma unroll
                for (int m = 0; m < 4; ++m)
#pragma unroll
                    for (int n = 0; n < 2; ++n) acc[a][b][m][n] = (f32x4){0.f, 0.f, 0.f, 0.f};
        cur = nxt; cA = nA; cB = nB; ++ui;
        if constexpr (ALIGN_EPI) { if (wr == 1) PG8_BAR; }
    }
    PG8_WAIT_V(0);
    if constexpr (!ALIGN_EPI) { if (wr == 0) PG8_BAR; }
    PG8_BAR;
    if constexpr (Epi::AFTER_DRAIN) E.fused(acc, cur, wr, wc, fr, fq, lds, tid);
#undef PG8_SA
#undef PG8_SB
#undef PG8_STAGE
#undef PG8_LDA
#undef PG8_LDB
#undef PG8_MMA
#undef PG8_WAIT_V
#undef PG8_WAIT_L
#undef PG8_BAR
#undef PG8_SCHED
}
}

enum { EK_IN = 0, EK_CO, EK_RO, EK_WO, EK_UP, EK_DN };

template <int KIND>
__device__ __forceinline__ void epi8(const Ctx& c, int row, int col, f32x4 v0, f32x4 v1) {
    unsigned char* act = c.ws + WS_ACT;
    if constexpr (KIND == EK_IN) {
        if (col < 1024) {
            u32x2 w; w.x = pk2(v0[0] * sigm(v0[1]), v0[2] * sigm(v0[3])); w.y = pk2(v1[0] * sigm(v1[1]), v1[2] * sigm(v1[3]));
            *(u32x2*)((bf16_t*)(act + A_U) + (size_t)row * 512 + (col >> 1)) = w;
        } else if (col < 2048) {
            const bool isk = col >= 1536; const int cc = col - (isk ? 1536 : 1024), h = cc >> 7, i0 = (cc & 127) >> 1;
            const float pos = row < MP ? (float)(row & (SEQ - 1)) : 16384.0f;
            const float sc = isk ? 0.08838834764831845f : 1.0f;
            const float* freq = (const float*)(c.ws + WS_CTL + 256);
            const f32x4 fv = *(const f32x4*)(freq + i0);
            float x1[4] = {v0[0], v0[2], v1[0], v1[2]}, x2[4] = {v0[1], v0[3], v1[1], v1[3]}, o1[4], o2[4];
#pragma unroll
            for (int p = 0; p < 4; ++p) {
                const float ang = pos * fv[p];
                const double a = (double)ang; const double n = rint(a * 0.15915494309189535);
                const float r = (float)(a - n * 6.283185307179586);
                const float sn = __sinf(r) * sc, cs = __cosf(r) * sc;
                o1[p] = x1[p] * cs - x2[p] * sn; o2[p] = x2[p] * cs + x1[p] * sn;
            }
            bf16_t* dst = (bf16_t*)(act + (isk ? A_K : A_Q)) + (size_t)row * 512 + h * 128 + i0;
            u32x2 w1, w2; w1.x = pk2(o1[0], o1[1]); w1.y = pk2(o1[2], o1[3]); w2.x = pk2(o2[0], o2[1]); w2.y = pk2(o2[2], o2[3]);
            *(u32x2*)dst = w1; *(u32x2*)(dst + 64) = w2;
        } else {
            const int seg = (col - 2048) >> 10, cc = (col - 2048) & 1023;
            float f[8] = {v0[0], v0[1], v0[2], v0[3], v1[0], v1[1], v1[2], v1[3]};
            if (seg == 1) {
#pragma unroll
                for (int j = 0; j < 8; ++j) f[j] = f[j] * sigm(f[j]);
            } else if (seg >= 2) {
#pragma unroll
                for (int j = 0; j < 8; ++j) f[j] = sigm(f[j]);
            }
            u32x4 w; w.x = pk2(f[0], f[1]); w.y = pk2(f[2], f[3]); w.z = pk2(f[4], f[5]); w.w = pk2(f[6], f[7]);
            *(u32x4*)((bf16_t*)(act + A_V + (size_t)seg * ((size_t)RT * 1024 * 2)) + (size_t)row * 1024 + cc) = w;
        }
    } else if constexpr (KIND == EK_CO) {
        u32x4* p = (u32x4*)((bf16_t*)(act + A_SA) + (size_t)row * 1024 + col); const u32x4 g = *p;
        u32x4 w; w.x = pk2(v0[0] * bflo(g.x), v0[1] * bfhi(g.x)); w.y = pk2(v0[2] * bflo(g.y), v0[3] * bfhi(g.y));
        w.z = pk2(v1[0] * bflo(g.z), v1[1] * bfhi(g.z)); w.w = pk2(v1[2] * bflo(g.w), v1[3] * bfhi(g.w));
        *p = w;
    } else if constexpr (KIND == EK_RO) {
        const u32x4 t = *(const u32x4*)((bf16_t*)(act + A_SA) + (size_t)row * 1024 + col);
        u32x4* p = (u32x4*)((bf16_t*)(act + A_SB) + (size_t)row * 1024 + col); const u32x4 g = *p;
        u32x4 w; w.x = pk2(bflo(t.x) + v0[0] * bflo(g.x), bfhi(t.x) + v0[1] * bfhi(g.x)); w.y = pk2(bflo(t.y) + v0[2] * bflo(g.y), bfhi(t.y) + v0[3] * bfhi(g.y));
        w.z = pk2(bflo(t.z) + v1[0] * bflo(g.z), bfhi(t.z) + v1[1] * bfhi(g.z)); w.w = pk2(bflo(t.w) + v1[2] * bflo(g.w), bfhi(t.w) + v1[3] * bfhi(g.w));
        *p = w;
    } else if constexpr (KIND == EK_WO) {
        u32x4 w; w.x = pk2(v0[0], v0[1]); w.y = pk2(v0[2], v0[3]); w.z = pk2(v1[0], v1[1]); w.w = pk2(v1[2], v1[3]);
        *(u32x4*)((bf16_t*)(act + A_M2) + (size_t)row * DM + col) = w;
    } else if constexpr (KIND == EK_UP) {
        float f[8] = {v0[0], v0[1], v0[2], v0[3], v1[0], v1[1], v1[2], v1[3]};
#pragma unroll
        for (int j = 0; j < 8; ++j) { const float r = fmaxf(f[j], 0.f); f[j] = r * r; }
        u32x4 w; w.x = pk2(f[0], f[1]); w.y = pk2(f[2], f[3]); w.z = pk2(f[4], f[5]); w.w = pk2(f[6], f[7]);
        *(u32x4*)((bf16_t*)(act + A_UP) + (size_t)row * FF + col) = w;
    } else {
        u32x4 w; w.x = pk2(v0[0], v0[1]); w.y = pk2(v0[2], v0[3]); w.z = pk2(v1[0], v1[1]); w.w = pk2(v1[2], v1[3]);
        *(u32x4*)((bf16_t*)(act + A_F) + (size_t)row * DM + col) = w;
    }
}

template <int KIND> struct Epi {
    static constexpr bool AFTER_DRAIN = false;
    Ctx c; const LAS float* tab = nullptr;
    __device__ __forceinline__ void operator()(const f32x4 (&acc)[2][2][4][2], const pg8::Unit& u, int wr, int wc, int fr, int fq) const {
#pragma unroll
        for (int ai = 0; ai < 2; ++ai)
#pragma unroll
            for (int m = 0; m < 4; ++m) {
                const int row = u.pm * 256 + ai * 128 + wr * 64 + m * 16 + fr;
                float f = 1.0f; if constexpr (KIND == EK_UP) f = tab[ai * 128 + wr * 64 + m * 16 + fr];
#pragma unroll
                for (int bj = 0; bj < 2; ++bj) {
                    if constexpr (KIND == EK_UP) epi8<KIND>(c, row, u.pn * 256 + bj * 128 + wc * 32 + 8 * fq, acc[ai][bj][m][0] * f, acc[ai][bj][m][1] * f);
                    else epi8<KIND>(c, row, u.pn * 256 + bj * 128 + wc * 32 + 8 * fq, acc[ai][bj][m][0], acc[ai][bj][m][1]);
                }
            }
    }
};

__device__ __forceinline__ void row_rms_exchange(const Ctx& c, int set, const f32x4 (&v)[2][2][4][2], const pg8::Unit& u, int wr, int wc, int fr, int fq, LAS unsigned char* lds, int tid) {
    LAS float* P = (LAS float*)lds;
    LAS float* S = (LAS float*)(lds + 8192);
    unsigned* slots = (unsigned*)(c.ws + WS_XCH) + (size_t)set * 64 * 256 * 4;
    unsigned* cnt = (unsigned*)(c.ws + WS_CTL + CTL_XCNT) + (size_t)(set * 64 + u.pm) * 64;
#pragma unroll
    for (int ai = 0; ai < 2; ++ai)
#pragma unroll
        for (int m = 0; m < 4; ++m) {
            float q = 0.f;
#pragma unroll
            for (int bj = 0; bj < 2; ++bj)
#pragma unroll
                for (int n = 0; n < 2; ++n) { const f32x4 x = v[ai][bj][m][n]; q += (x[0] * x[0] + x[1] * x[1]) + (x[2] * x[2] + x[3] * x[3]); }
            q += __shfl_xor(q, 16); q += __shfl_xor(q, 32);
            if (fq == 0) P[(ai * 128 + wr * 64 + m * 16 + fr) * 4 + wc] = q;
        }
    __syncthreads();
    if (tid < 256) {
        const float t = (P[tid * 4 + 0] + P[tid * 4 + 1]) + (P[tid * 4 + 2] + P[tid * 4 + 3]);
        __hip_atomic_store(slots + ((size_t)(u.pm * 256 + tid) * 4 + u.pn), __float_as_uint(t), __ATOMIC_RELAXED, __HIP_MEMORY_SCOPE_AGENT);
    }
    asm volatile("s_waitcnt vmcnt(0)" ::: "memory");
    __syncthreads();
    if (tid == 0) {
        __hip_atomic_fetch_add(cnt, 1u, __ATOMIC_RELAXED, __HIP_MEMORY_SCOPE_AGENT);
        unsigned sp = 0;
        while (__hip_atomic_load(cnt, __ATOMIC_RELAXED, __HIP_MEMORY_SCOPE_AGENT) < 4u) { __builtin_amdgcn_s_sleep(1); if (++sp > (1u << 22)) break; }
        __builtin_amdgcn_fence(__ATOMIC_ACQUIRE, "agent");
        asm volatile("s_waitcnt vmcnt(0)" ::: "memory");
    }
    __syncthreads();
    if (tid < 256) {
        const unsigned* sl = slots + (size_t)(u.pm * 256 + tid) * 4;
        float t = 0.f;
#pragma unroll
        for (int k = 0; k < 4; ++k) t += __uint_as_float(__hip_atomic_load(sl + k, __ATOMIC_RELAXED, __HIP_MEMORY_SCOPE_AGENT));
        S[tid] = 1.0f / sqrtf(t * (1.0f / DM) + EPS);
    }
    __syncthreads();
}
struct EpiWoFused {
    static constexpr bool AFTER_DRAIN = true;
    Ctx c;
    __device__ __forceinline__ void fused(f32x4 (&acc)[2][2][4][2], const pg8::Unit& u, int wr, int wc, int fr, int fq, LAS unsigned char* lds, int tid) const {
        row_rms_exchange(c, 1, acc, u, wr, wc, fr, fq, lds, tid);
        const LAS float* S = (const LAS float*)(lds + 8192);
        bf16_t* MB = (bf16_t*)(c.ws + WS_ACT + A_M2); bf16_t* HN = (bf16_t*)(c.ws + WS_ACT + A_HN);
#pragma unroll
        for (int bj = 0; bj < 2; ++bj) {
            const int col = u.pn * 256 + bj * 128 + wc * 32 + 8 * fq;
            const f32x4 g0 = *(const f32x4*)(c.n_mix_post + col), g1 = *(const f32x4*)(c.n_mix_post + col + 4);
#pragma unroll
            for (int ai = 0; ai < 2; ++ai)
#pragma unroll
                for (int m = 0; m < 4; ++m) { const int rl = ai * 128 + wr * 64 + m * 16 + fr; const float rs = S[rl]; const size_t ro = (size_t)(u.pm * 256 + rl) * DM + col;
                    const f32x4 x0 = __builtin_nontemporal_load((const f32x4*)(c.xp + ro)), x1 = __builtin_nontemporal_load((const f32x4*)(c.xp + ro + 4));
                    const f32x4 h0 = x0 + acc[ai][bj][m][0] * rs * g0, h1 = x1 + acc[ai][bj][m][1] * rs * g1;
                    acc[ai][bj][m][0] = h0; acc[ai][bj][m][1] = h1;
                    u32x4 w; w.x = pk2(h0[0], h0[1]); w.y = pk2(h0[2], h0[3]); w.z = pk2(h1[0], h1[1]); w.w = pk2(h1[2], h1[3]);
                    *(u32x4*)(MB + ro) = w; }
        }
        {
            LAS float* P = (LAS float*)lds;
            unsigned* slots = (unsigned*)(c.ws + WS_XCH) + (size_t)2 * 64 * 256 * 4;
#pragma unroll
            for (int ai = 0; ai < 2; ++ai)
#pragma unroll
                for (int m = 0; m < 4; ++m) { float q = 0.f;
#pragma unroll
                    for (int bj = 0; bj < 2; ++bj)
#pragma unroll
                        for (int n = 0; n < 2; ++n) { const f32x4 x = acc[ai][bj][m][n]; q += (x[0] * x[0] + x[1] * x[1]) + (x[2] * x[2] + x[3] * x[3]); }
                    q += __shfl_xor(q, 16); q += __shfl_xor(q, 32);
                    if (fq == 0) P[(ai * 128 + wr * 64 + m * 16 + fr) * 4 + wc] = q; }
            __syncthreads();
            if (tid < 256) slots[(size_t)(u.pm * 256 + tid) * 4 + u.pn] = __float_as_uint((P[tid * 4 + 0] + P[tid * 4 + 1]) + (P[tid * 4 + 2] + P[tid * 4 + 3]));
        }
    }
};

__device__ __forceinline__ float small_rms_exchange(const Ctx& c, int set, int mt, int ng, int lane, const f32x4& s0, const f32x4& s1) {
    const int fr = lane & 15, fq = lane >> 4;
    unsigned* slots = (unsigned*)(c.ws + WS_XCHS) + (size_t)((set * 8 + mt) * 16) * 32;
    unsigned* cnt = (unsigned*)(c.ws + WS_CTL + CTL_XCNTS) + (size_t)(set * 8 + mt) * 64;
    float q = ((s0[0] * s0[0] + s0[1] * s0[1]) + (s0[2] * s0[2] + s0[3] * s0[3])) + ((s1[0] * s1[0] + s1[1] * s1[1]) + (s1[2] * s1[2] + s1[3] * s1[3]));
    q += __shfl_xor(q, 16); q += __shfl_xor(q, 32);
    if (fq == 0) __hip_atomic_store(slots + fr * 32 + ng, __float_as_uint(q), __ATOMIC_RELAXED, __HIP_MEMORY_SCOPE_AGENT);
    asm volatile("s_waitcnt vmcnt(0)" ::: "memory");
    if (lane == 0) {
        __hip_atomic_fetch_add(cnt, 1u, __ATOMIC_RELAXED, __HIP_MEMORY_SCOPE_AGENT);
        unsigned sp = 0;
        while (__hip_atomic_load(cnt, __ATOMIC_RELAXED, __HIP_MEMORY_SCOPE_AGENT) < 32u) { __builtin_amdgcn_s_sleep(1); if (++sp > (1u << 22)) break; }
    }
    __builtin_amdgcn_fence(__ATOMIC_ACQUIRE, "agent");
    asm volatile("s_waitcnt vmcnt(0)" ::: "memory");
    float t = 0.f;
#pragma unroll
    for (int k = 0; k < 8; ++k) t += __uint_as_float(__hip_atomic_load(slots + fr * 32 + fq * 8 + k, __ATOMIC_RELAXED, __HIP_MEMORY_SCOPE_AGENT));
    t += __shfl_xor(t, 16); t += __shfl_xor(t, 32);
    return 1.0f / sqrtf(t * (1.0f / DM) + EPS);
}
template <int KIND>
__device__ __forceinline__ void small_fused(const Ctx& c, int mt, int ng, int lane, f32x4 s0, f32x4 s1) {
    const int fr = lane & 15, fq = lane >> 4, col = ng * 32 + 8 * fq;
    const size_t ro = (size_t)(MP + mt * 16 + fr) * DM + col;
    bf16_t* MB = (bf16_t*)(c.ws + WS_ACT + A_M2);
    if constexpr (KIND == EK_WO) {
        const float rs = small_rms_exchange(c, 0, mt, ng, lane, s0, s1);
        const float* xr = c.xs + (size_t)(mt * 16 + fr) * DM + col;
        const f32x4 g0 = *(const f32x4*)(c.n_mix_post + col), g1 = *(const f32x4*)(c.n_mix_post + col + 4);
        const f32x4 h0 = *(const f32x4*)xr + s0 * rs * g0, h1 = *(const f32x4*)(xr + 4) + s1 * rs * g1;
        u32x4 w; w.x = pk2(h0[0], h0[1]); w.y = pk2(h0[2], h0[3]); w.z = pk2(h1[0], h1[1]); w.w = pk2(h1[2], h1[3]);
        *(u32x4*)(MB + ro) = w;
        const float rs2 = small_rms_exchange(c, 1, mt, ng, lane, h0, h1);
        if (ng == 0 && fq == 0) ((float*)(c.ws + WS_RS2S))[mt * 16 + fr] = rs2;
    } else {
        const float rs = small_rms_exchange(c, 2, mt, ng, lane, s0, s1);
        const u32x4 hw = *(const u32x4*)(MB + ro);
        const f32x4 h0 = {bflo(hw.x), bfhi(hw.x), bflo(hw.y), bfhi(hw.y)}, h1 = {bflo(hw.z), bfhi(hw.z), bflo(hw.w), bfhi(hw.w)};
        const f32x4 g0 = *(const f32x4*)(c.n_ffn_post + col), g1 = *(const f32x4*)(c.n_ffn_post + col + 4);
        float* p = c.out + ro;
        *(f32x4*)p = h0 + s0 * rs * g0; *(f32x4*)(p + 4) = h1 + s1 * rs * g1;
    }
}

struct EpiDnFused {
    static constexpr bool AFTER_DRAIN = true;
    Ctx c;
    __device__ __forceinline__ void fused(const f32x4 (&acc)[2][2][4][2], const pg8::Unit& u, int wr, int wc, int fr, int fq, LAS unsigned char* lds, int tid) const {
        row_rms_exchange(c, 0, acc, u, wr, wc, fr, fq, lds, tid);
        const LAS float* S = (const LAS float*)(lds + 8192);
#pragma unroll
        for (int bj = 0; bj < 2; ++bj) {
            const int col = u.pn * 256 + bj * 128 + wc * 32 + 8 * fq;
            const f32x4 g0 = *(const f32x4*)(c.n_ffn_post + col), g1 = *(const f32x4*)(c.n_ffn_post + col + 4);
#pragma unroll
            for (int ai = 0; ai < 2; ++ai)
#pragma unroll
                for (int m = 0; m < 4; ++m) { const int rl = ai * 128 + wr * 64 + m * 16 + fr; const float rs = S[rl];
                    float* p = c.out + (size_t)(u.pm * 256 + rl) * DM + col;
                    const u32x4 hw = __builtin_nontemporal_load((const u32x4*)((const bf16_t*)(c.ws + WS_ACT + A_M2) + (size_t)(u.pm * 256 + rl) * DM + col));
                    const f32x4 h0 = {bflo(hw.x), bfhi(hw.x), bflo(hw.y), bfhi(hw.y)}, h1 = {bflo(hw.z), bfhi(hw.z), bflo(hw.w), bfhi(hw.w)};
                    __builtin_nontemporal_store(h0 + acc[ai][bj][m][0] * rs * g0, (f32x4*)p); __builtin_nontemporal_store(h1 + acc[ai][bj][m][1] * rs * g1, (f32x4*)(p + 4)); }
        }
    }
};

template <int KIND, int N, int K, int NI, class BigEpi = Epi<KIND>, bool ALIGN = false, bool HNORM = false, bool RS2TAB = false>
__device__ __forceinline__ void gemm_all(const Ctx& c, LAS unsigned char* lds, const bf16_t* A, const bf16_t* Bt) {
    {
    {
    pg8::StaticOrder S; S.init(MP, N, gridDim.x, blockIdx.x);
    BigEpi E{c};
    if constexpr (RS2TAB) E.tab = (const LAS float*)(lds + pg8::STAGE_BYTES);
    pg8::Gemm g{A, Bt, MP, N, K, RS2TAB ? (const float*)(c.ws + WS_XCH) + (size_t)2 * 64 * 256 * 4 : (const float*)(c.ws + WS_SSQ)};
    pg8::gemm_phase<BigEpi, ALIGN, true, HNORM, RS2TAB>(lds, g, S, E);
    __syncthreads();
    }
    {
    const int tid = otid(), wid = __builtin_amdgcn_readfirstlane(tid >> 6), lane = tid & 63, fr = lane & 15, fq = lane >> 4;
    LAS f32x4* red = (LAS f32x4*)lds;
    constexpr int nitems = 8 * (N / 32), kw = K / 8, KS = kw / 32, KB = KS > 4 ? 4 : KS;
    const unsigned toff = (unsigned)((fr * K + wid * kw + 8 * fq) * 2);
    const unsigned tb0 = (unsigned)((pg8::perm32(fr) * K + wid * kw + 8 * fq) * 2), tb1 = (unsigned)((pg8::perm32(16 + fr) * K + wid * kw + 8 * fq) * 2);
    for (int base = blockIdx.x * NI; base < nitems; base += gridDim.x * NI) {
        f32x4 a0[NI], a1[NI];
#pragma unroll
        for (int q = 0; q < NI; ++q) { a0[q] = (f32x4){0.f, 0.f, 0.f, 0.f}; a1[q] = (f32x4){0.f, 0.f, 0.f, 0.f}; }
#pragma unroll 1
        for (int k0 = 0; k0 < KS; k0 += KB) {
            bf16x8 af[NI][KB], b0[NI][KB], b1[NI][KB];
#pragma unroll
            for (int q = 0; q < NI; ++q) { const int item = base + q, mt = item & 7, ng = item >> 3;
                const char* ap = (const char*)(A + (size_t)(MP + mt * 16) * K) + (size_t)k0 * 64; const char* bp = (const char*)(Bt + (size_t)(ng * 32) * K) + (size_t)k0 * 64;
#pragma unroll
                for (int ks = 0; ks < KB; ++ks) { af[q][ks] = *(const bf16x8*)(ap + ks * 64 + toff); b0[q][ks] = *(const bf16x8*)(bp + ks * 64 + tb0); b1[q][ks] = *(const bf16x8*)(bp + ks * 64 + tb1); } }
#pragma unroll
            for (int q = 0; q < NI; ++q)
#pragma unroll
                for (int ks = 0; ks < KB; ++ks) { a0[q] = __builtin_amdgcn_mfma_f32_16x16x32_bf16(b0[q][ks], af[q][ks], a0[q], 0, 0, 0); a1[q] = __builtin_amdgcn_mfma_f32_16x16x32_bf16(b1[q][ks], af[q][ks], a1[q], 0, 0, 0); }
        }
#pragma unroll
        for (int q = 0; q < NI; ++q) { red[((q * 8 + wid) * 2 + 0) * 64 + lane] = a0[q]; red[((q * 8 + wid) * 2 + 1) * 64 + lane] = a1[q]; }
        __syncthreads();
        if (wid < NI && base + wid < nitems) {
            f32x4 s0 = red[((wid * 8) * 2 + 0) * 64 + lane], s1 = red[((wid * 8) * 2 + 1) * 64 + lane];
#pragma unroll
            for (int w = 1; w < 8; ++w) { s0 += red[((wid * 8 + w) * 2 + 0) * 64 + lane]; s1 += red[((wid * 8 + w) * 2 + 1) * 64 + lane]; }
            const int item = base + wid, mt = item & 7, ng = item >> 3;
            if constexpr (KIND == EK_WO || KIND == EK_DN) small_fused<KIND>(c, mt, ng, lane, s0, s1);
            else { if constexpr (KIND == EK_UP) { const float f = ((const float*)(c.ws + WS_RS2S))[mt * 16 + fr]; s0 *= f; s1 *= f; }
                epi8<KIND>(c, MP + mt * 16 + fr, ng * 32 + 8 * fq, s0, s1); }
        }
        __syncthreads();
    }
    }
    }
}

__device__ __forceinline__ int map_in(int n) {
    if (n < 512) return 2 * n;
    if (n < 1024) return 2 * (n - 512) + 1;
    if (n < 2048) { const int base = n < 1536 ? 1024 : 1536, cc = n - base, h = cc >> 7, d = cc & 127; return base + h * 128 + 2 * (d & 63) + (d >> 6); }
    return n;
}
struct WItem { const float* W; bf16_t* WT; int K, N, r; bool mapin; const float* kscale; };
__device__ __forceinline__ void wt_load(const WItem& w, int lane, f32x4 (&v)[8]) {
    const int nblk = w.N / 32, kb = w.r / nblk, nb = w.r % nblk, k0 = 64 * kb, n0 = 32 * nb, kr = lane >> 3, seg = lane & 7;
    const float* wp = w.W + (size_t)(k0 + kr) * w.N + n0 + seg * 4;
#pragma unroll
    for (int i = 0; i < 8; ++i) v[i] = __builtin_nontemporal_load((const f32x4*)(wp + (size_t)(8 * i) * w.N));
}
__device__ __forceinline__ void wt_finish(const WItem& w, int lane, const f32x4 (&v)[8], LAS float* scr) {
    const int nblk = w.N / 32, kb = w.r / nblk, nb = w.r % nblk, k0 = 64 * kb, n0 = 32 * nb, kr = lane >> 3, seg = lane & 7;
#pragma unroll
    for (int i = 0; i < 8; ++i) { LAS float* d = scr + (8 * i + kr) * 33 + seg * 4; d[0] = v[i][0]; d[1] = v[i][1]; d[2] = v[i][2]; d[3] = v[i][3]; }
    LDS_WAIT();
    const int ch = lane & 7;
#pragma unroll
    for (int j = 0; j < 4; ++j) { const int n = (lane >> 3) + 8 * j; const LAS float* s = scr + (8 * ch) * 33 + n;
        f32x4 ga = {1.f, 1.f, 1.f, 1.f}, gb = {1.f, 1.f, 1.f, 1.f};
        if (w.kscale) { ga = *(const f32x4*)(w.kscale + k0 + 8 * ch); gb = *(const f32x4*)(w.kscale + k0 + 8 * ch + 4); }
        u32x4 o; o.x = pk2(s[0 * 33] * ga[0], s[1 * 33] * ga[1]); o.y = pk2(s[2 * 33] * ga[2], s[3 * 33] * ga[3]); o.z = pk2(s[4 * 33] * gb[0], s[5 * 33] * gb[1]); o.w = pk2(s[6 * 33] * gb[2], s[7 * 33] * gb[3]);
        const int dn = w.mapin ? map_in(n0 + n) : (n0 + n);
        *(u32x4*)(w.WT + (size_t)dn * w.K + k0 + 8 * ch) = o; }
    LDS_WAIT();
}
constexpr int WI_IN = (DM / 64) * (NIN / 32);
constexpr int WI_CO = (CD / 64) * (DM / 32), WI_RO = (DM / 64) * (DM / 32), WI_O = WI_RO, WI_UP = (DM / 64) * (FF / 32), WI_DN = (FF / 64) * (DM / 32);
constexpr int WI_TOTAL = WI_IN + WI_CO + WI_RO + WI_O + WI_UP + WI_DN;

__device__ __forceinline__ void wt_pair(const Ctx& c, int p, int lane, LAS float* scr) {
    int r = 2 * p; WItem w;
    if (r < WI_IN) { w.W = c.w_in; w.WT = (bf16_t*)(c.ws + WS_WIN); w.K = DM; w.N = NIN; w.mapin = true; w.kscale = nullptr; }
    else if ((r -= WI_IN) < WI_CO) { w.W = c.w_co; w.WT = (bf16_t*)(c.ws + WS_WCO); w.K = CD; w.N = DM; w.mapin = false; w.kscale = nullptr; }
    else if ((r -= WI_CO) < WI_RO) { w.W = c.w_ro; w.WT = (bf16_t*)(c.ws + WS_WRO); w.K = DM; w.N = DM; w.mapin = false; w.kscale = nullptr; }
    else if ((r -= WI_RO) < WI_O) { w.W = c.w_o; w.WT = (bf16_t*)(c.ws + WS_WO); w.K = DM; w.N = DM; w.mapin = false; w.kscale = nullptr; }
    else if ((r -= WI_O) < WI_UP) { w.W = c.w_up; w.WT = (bf16_t*)(c.ws + WS_WUP); w.K = DM; w.N = FF; w.mapin = false; w.kscale = c.n_ffn_pre; }
    else { r -= WI_UP; w.W = c.w_dn; w.WT = (bf16_t*)(c.ws + WS_WDN); w.K = FF; w.N = DM; w.mapin = false; w.kscale = nullptr; }
    WItem w1 = w; w.r = r; w1.r = r + 1;
    f32x4 va[8], vb[8];
    wt_load(w, lane, va); wt_load(w1, lane, vb);
    wt_finish(w, lane, va, scr); wt_finish(w1, lane, vb, scr);
}
__device__ __forceinline__ void rms_rows4_to_bf16(const Ctx& c, int row0, int stride, const float* w, bf16_t* XN, int lane) {
    f32x4 v[4][4];
#pragma unroll
    for (int r = 0; r < 4; ++r) { const int row = row0 + r * stride;
        if (row < RT) { const float* x = xrow(c, row);
#pragma unroll
            for (int j = 0; j < 4; ++j) v[r][j] = __builtin_nontemporal_load((const f32x4*)x + 64 * j + lane); } }
#pragma unroll
    for (int r = 0; r < 4; ++r) { const int row = row0 + r * stride;
        if (row < RT) { float s = 0.f;
#pragma unroll
            for (int j = 0; j < 4; ++j) s += (v[r][j].x * v[r][j].x + v[r][j].y * v[r][j].y) + (v[r][j].z * v[r][j].z + v[r][j].w * v[r][j].w);
            const float rs = 1.0f / sqrtf(wave_sum(s) * (1.0f / DM) + EPS);
#pragma unroll
            for (int j = 0; j < 4; ++j) { const f32x4 g = *((const f32x4*)w + 64 * j + lane);
                u32x2 p; p.x = pk2(v[r][j].x * rs * g.x, v[r][j].y * rs * g.y); p.y = pk2(v[r][j].z * rs * g.z, v[r][j].w * rs * g.w);
                *((u32x2*)(XN + (size_t)row * DM) + 64 * j + lane) = p; } } }
}
__device__ __forceinline__ void phase0(const Ctx& c, LAS unsigned char* lds) {
    const int tid = otid(), wid = __builtin_amdgcn_readfirstlane(tid >> 6), lane = tid & 63;
    if (blockIdx.x == 0 && tid < 64) {
        const float xi = (float)tid / 63.0f;
        const float p = (float)exp((double)xi * 9.210340371976184);
        ((float*)(c.ws + WS_CTL + 256))[tid] = 1.0f / p;
    }
    LAS float* scr = (LAS float*)(lds + wid * 16384);
    const int gw = blockIdx.x * 8 + wid, NGW = gridDim.x * 8;
    bf16_t* XN = (bf16_t*)c.out;
    for (int row = gw; row < RT; row += 4 * NGW) rms_rows4_to_bf16(c, row, NGW, c.n_mix_pre, XN, lane);
    for (int p = gw; p < WI_IN / 2; p += NGW) wt_pair(c, p, lane, scr);
}

__device__ __forceinline__ void ret_prompt_item(const Ctx& c, LAS unsigned char* lds, int item) {
    const int tid = otid(), wid = __builtin_amdgcn_readfirstlane(tid >> 6), lane = tid & 63, fr = lane & 15, fq = lane >> 4;
    const int s = item & 3, h = (item >> 2) & 3, b = item >> 4;
    const float l2g = log2f(1.0f - exp2f(-5.0f - (float)h));
    unsigned char* act = c.ws + WS_ACT;
    const bf16_t* Q = (const bf16_t*)(act + A_Q); const bf16_t* Kg = (const bf16_t*)(act + A_K); const bf16_t* V = (const bf16_t*)(act + A_V); bf16_t* OB = (bf16_t*)c.out;
    float* SSQ = (float*)(c.ws + WS_SSQ);
    constexpr int LD = 136;
    LAS bf16_t* sQ = (LAS bf16_t*)lds; LAS bf16_t* sK = sQ + 128 * LD; LAS bf16_t* sKT = sK + 128 * LD; LAS bf16_t* sVT = sKT + 128 * LD; LAS bf16_t* sST = sVT + 64 * LD;
    for (int i = tid; i < 64 * LD / 2; i += 512) ((LAS unsigned*)sST)[i] = 0u;
    f32x4 Sacc[4];
#pragma unroll
    for (int e = 0; e < 4; ++e) Sacc[e] = (f32x4){0.f, 0.f, 0.f, 0.f};
    const float gC = exp2f(128.0f * l2g);
    const int il = 16 * wid + fr;
    u32x4 rq[4], rk[4]; unsigned kv[16], vv[8]; u32x2 sgv[4], sgc[4];
    const bf16_t* SGp = (const bf16_t*)(act + A_SG);
    const int dp = tid & 63, ep = tid & 31, jgv = tid >> 5;
    const int jgk = wid;
    const unsigned toq = (unsigned)(((tid >> 4) * 512 + (tid & 15) * 8) * 2);
    const unsigned tok = (unsigned)(2 * dp * 2);
    const unsigned tov = (unsigned)(((jgv * 8) * 1024 + 2 * ep) * 2);
    const unsigned tosg = (unsigned)((il * 1024 + 4 * fq) * 2);
#define RET_LOAD(CH) do { const size_t r0_ = (size_t)b * SEQ + (size_t)(CH) * 128; \
        const char* qb_ = (const char*)(Q + r0_ * 512 + h * 128); const char* kb_ = (const char*)(Kg + r0_ * 512 + h * 128); \
        const char* kt_ = (const char*)(Kg + (r0_ + jgk * 16) * 512 + h * 128); const char* vb_ = (const char*)(V + r0_ * 1024 + h * 256 + s * 64); \
        _Pragma("unroll") for (int i = 0; i < 4; ++i) { rq[i] = *(const u32x4*)(qb_ + (size_t)i * 32768 + toq); rk[i] = *(const u32x4*)(kb_ + (size_t)i * 32768 + toq); } \
        _Pragma("unroll") for (int jj = 0; jj < 16; ++jj) kv[jj] = *(const unsigned*)(kt_ + (size_t)jj * 1024 + tok); \
        _Pragma("unroll") for (int jj = 0; jj < 8; ++jj) vv[jj] = *(const unsigned*)(vb_ + (size_t)jj * 2048 + tov); \
        const char* sg_ = (const char*)(SGp + r0_ * 1024 + h * 256 + s * 64); \
        _Pragma("unroll") for (int et = 0; et < 4; ++et) sgv[et] = *(const u32x2*)(sg_ + (size_t)et * 32 + tosg); } while (0)
    RET_LOAD(0);
    for (int ch = 0; ch < SEQ / 128; ++ch) {
        const size_t r0 = (size_t)b * SEQ + (size_t)ch * 128;
#pragma unroll
        for (int i = 0; i < 4; ++i) { const int id = tid + 512 * i, row = id >> 4, cq = id & 15;
            *(LAS u32x4*)(sQ + row * LD + cq * 8) = rq[i]; *(LAS u32x4*)(sK + row * LD + cq * 8) = rk[i]; }
        {
            unsigned lo[8], hi[8];
#pragma unroll
            for (int jj = 0; jj < 16; jj += 2) {
                const float d0 = exp2f((float)(127 - (jgk * 16 + jj)) * l2g), d1 = exp2f((float)(127 - (jgk * 16 + jj + 1)) * l2g);
                lo[jj >> 1] = pk2(bflo(kv[jj]) * d0, bflo(kv[jj + 1]) * d1); hi[jj >> 1] = pk2(bfhi(kv[jj]) * d0, bfhi(kv[jj + 1]) * d1);
            }
            LAS u32x4* p0 = (LAS u32x4*)(sKT + (2 * dp) * LD + jgk * 16); LAS u32x4* p1 = (LAS u32x4*)(sKT + (2 * dp + 1) * LD + jgk * 16);
            p0[0] = (u32x4){lo[0], lo[1], lo[2], lo[3]}; p0[1] = (u32x4){lo[4], lo[5], lo[6], lo[7]};
            p1[0] = (u32x4){hi[0], hi[1], hi[2], hi[3]}; p1[1] = (u32x4){hi[4], hi[5], hi[6], hi[7]};
        }
        {
            u32x4 lo, hi;
            lo.x = (vv[0] & 0xffffu) | (vv[1] << 16); lo.y = (vv[2] & 0xffffu) | (vv[3] << 16); lo.z = (vv[4] & 0xffffu) | (vv[5] << 16); lo.w = (vv[6] & 0xffffu) | (vv[7] << 16);
            hi.x = (vv[0] >> 16) | (vv[1] & 0xffff0000u); hi.y = (vv[2] >> 16) | (vv[3] & 0xffff0000u); hi.z = (vv[4] >> 16) | (vv[5] & 0xffff0000u); hi.w = (vv[6] >> 16) | (vv[7] & 0xffff0000u);
            *(LAS u32x4*)(sVT + (2 * ep) * LD + jgv * 8) = lo; *(LAS u32x4*)(sVT + (2 * ep + 1) * LD + jgv * 8) = hi;
        }
#pragma unroll
        for (int et = 0; et < 4; ++et) sgc[et] = sgv[et];
        if (ch + 1 < SEQ / 128) RET_LOAD(ch + 1);
        __syncthreads();
        bf16x8 qf[4];
#pragma unroll
        for (int ks = 0; ks < 4; ++ks) qf[ks] = *(const LAS bf16x8*)(sQ + il * LD + ks * 32 + fq * 8);
        f32x4 sc[8];
#pragma unroll
        for (int jp = 0; jp < 8; jp += 2) {
            bf16x8 kf[2][4];
#pragma unroll
            for (int t = 0; t < 2; ++t)
#pragma unroll
                for (int ks = 0; ks < 4; ++ks) kf[t][ks] = *(const LAS bf16x8*)(sK + ((jp + t) * 16 + fr) * LD + ks * 32 + fq * 8);
#pragma unroll
            for (int t = 0; t < 2; ++t) { sc[jp + t] = (f32x4){0.f, 0.f, 0.f, 0.f};
#pragma unroll
                for (int ks = 0; ks < 4; ++ks) sc[jp + t] = __builtin_amdgcn_mfma_f32_16x16x32_bf16(kf[t][ks], qf[ks], sc[jp + t], 0, 0, 0); }
        }
        __syncthreads();
#pragma unroll
        for (int jt = 0; jt < 8; ++jt) { float pv[4];
#pragma unroll
            for (int jj = 0; jj < 4; ++jj) { const int df = il - (jt * 16 + 4 * fq + jj); pv[jj] = df >= 0 ? sc[jt][jj] * exp2f((float)df * l2g) : 0.f; }
            u32x2 w; w.x = pk2(pv[0], pv[1]); w.y = pk2(pv[2], pv[3]);
            *(LAS u32x2*)(sK + il * LD + jt * 16 + 4 * fq) = w; }
        LDS_WAIT(); __builtin_amdgcn_wave_barrier();
        f32x4 o[4];
#pragma unroll
        for (int ep2 = 0; ep2 < 4; ep2 += 2) {
            bf16x8 sf[2][4];
#pragma unroll
            for (int t = 0; t < 2; ++t)
#pragma unroll
                for (int ks = 0; ks < 4; ++ks) sf[t][ks] = *(const LAS bf16x8*)(sST + ((ep2 + t) * 16 + fr) * LD + ks * 32 + fq * 8);
#pragma unroll
            for (int t = 0; t < 2; ++t) { o[ep2 + t] = (f32x4){0.f, 0.f, 0.f, 0.f};
#pragma unroll
                for (int ks = 0; ks < 4; ++ks) o[ep2 + t] = __builtin_amdgcn_mfma_f32_16x16x32_bf16(sf[t][ks], qf[ks], o[ep2 + t], 0, 0, 0); }
        }
        const float qd = exp2f((float)(il + 1) * l2g);
#pragma unroll
        for (int et = 0; et < 4; ++et) { o[et] *= qd; Sacc[et] *= gC; }
#pragma unroll
        for (int k2 = 0; k2 < 4; k2 += 2) {
            bf16x8 pf[2], kf[2], vf[2][4];
#pragma unroll
            for (int t = 0; t < 2; ++t) { const int ks = k2 + t;
                pf[t] = *(const LAS bf16x8*)(sK + il * LD + ks * 32 + fq * 8); kf[t] = *(const LAS bf16x8*)(sKT + il * LD + ks * 32 + fq * 8);
#pragma unroll
                for (int et = 0; et < 4; ++et) vf[t][et] = *(const LAS bf16x8*)(sVT + (et * 16 + fr) * LD + ks * 32 + fq * 8); }
#pragma unroll
            for (int t = 0; t < 2; ++t)
#pragma unroll
                for (int et = 0; et < 4; ++et) { o[et] = __builtin_amdgcn_mfma_f32_16x16x32_bf16(vf[t][et], pf[t], o[et], 0, 0, 0);
                    Sacc[et] = __builtin_amdgcn_mfma_f32_16x16x32_bf16(kf[t], vf[t][et], Sacc[et], 0, 0, 0); }
        }
        float ss = 0.f;
#pragma unroll
        for (int et = 0; et < 4; ++et) { ss += (o[et][0] * o[et][0] + o[et][1] * o[et][1]) + (o[et][2] * o[et][2] + o[et][3] * o[et][3]);
            u32x2 w; w.x = pk2(o[et][0] * bflo(sgc[et].x), o[et][1] * bfhi(sgc[et].x)); w.y = pk2(o[et][2] * bflo(sgc[et].y), o[et][3] * bfhi(sgc[et].y));
            *(u32x2*)(OB + (r0 + il) * 1024 + h * 256 + s * 64 + et * 16 + 4 * fq) = w; }
        ss += __shfl_xor(ss, 16); ss += __shfl_xor(ss, 32);
        if (fq == 0) SSQ[(r0 + il) * 16 + h * 4 + s] = ss;
        __syncthreads();
#pragma unroll
        for (int et = 0; et < 4; ++et) { u32x2 w; w.x = pk2(Sacc[et][0], Sacc[et][1]); w.y = pk2(Sacc[et][2], Sacc[et][3]);
            *(LAS u32x2*)(sST + (et * 16 + fr) * LD + 16 * wid + 4 * fq) = w; }
    }
    float* nrp = c.out + O_NRP + ((size_t)(b * NH + h) * DK) * DV + s * 64;
#pragma unroll
    for (int et = 0; et < 4; ++et)
#pragma unroll
        for (int jj = 0; jj < 4; ++jj) nrp[(size_t)(16 * wid + 4 * fq + jj) * DV + et * 16 + fr] = Sacc[et][jj];
    __syncthreads();
#undef RET_LOAD
}

__device__ __forceinline__ float block_sum(float v, LAS float* red, int tid) {
    v = wave_sum(v);
    __syncthreads();
    if ((tid & 63) == 0) red[tid >> 6] = v;
    __syncthreads();
    float t = 0.f;
#pragma unroll
    for (int w = 0; w < 8; ++w) t += red[w];
    return t;
}

__device__ __forceinline__ void ret_sample_item(const Ctx& c, LAS unsigned char* lds, int item) {
    const int tid = otid(), b = item >> 2, h = item & 3, row = MP + b;
    unsigned char* act = c.ws + WS_ACT;
    const bf16_t* Q = (const bf16_t*)(act + A_Q) + (size_t)row * 512 + h * 128; const bf16_t* Kg = (const bf16_t*)(act + A_K) + (size_t)row * 512 + h * 128;
    const bf16_t* V = (const bf16_t*)(act + A_V) + (size_t)row * 1024 + h * 256; bf16_t* OB = (bf16_t*)c.out + (size_t)row * 1024 + h * 256;
    LAS float* sq = (LAS float*)lds; LAS float* sk = sq + 128; LAS float* red = sk + 128; LAS float* part = red + 16;
    if (tid < 128) sq[tid] = bf2f(Q[tid]); else if (tid < 256) sk[tid - 128] = bf2f(Kg[tid - 128]);
    __syncthreads();
    const float g = 1.0f - exp2f(-5.0f - (float)h);
    const int e4 = (tid & 63) * 4, dg = tid >> 6;
    const u32x2 vw = *(const u32x2*)(V + e4);
    const f32x4 vv = {bflo(vw.x), bfhi(vw.x), bflo(vw.y), bfhi(vw.y)};
    const float* Sin = c.state_ret + ((size_t)(b * NH + h) * DK + dg * 16) * DV + e4;
    float* Sout = c.out + O_NRS + ((size_t)(b * NH + h) * DK + dg * 16) * DV + e4;
    f32x4 oa = {0.f, 0.f, 0.f, 0.f};
    f32x4 sv[16];
#pragma unroll
    for (int dd = 0; dd < 16; ++dd) sv[dd] = __builtin_nontemporal_load((const f32x4*)(Sin + (size_t)dd * DV));
#pragma unroll
    for (int dd = 0; dd < 16; ++dd) { const float kd = sk[dg * 16 + dd], qd = sq[dg * 16 + dd];
        const f32x4 sn = sv[dd] * g + vv * kd; __builtin_nontemporal_store(sn, (f32x4*)(Sout + (size_t)dd * DV)); oa += sn * qd; }
    *(LAS f32x4*)(part + dg * 256 + e4) = oa;
    __syncthreads();
    float ov = 0.f;
    if (tid < 256) {
#pragma unroll
        for (int w = 0; w < 8; ++w) ov += part[w * 256 + tid];
    }
    const float tot = block_sum(ov * ov, red, tid);
    const float rs = 1.0f / sqrtf(tot * (1.0f / DV) + EPS);
    if (tid < 256) OB[tid] = (bf16_t)(pk2(bf2f(((const bf16_t*)(act + A_SG))[(size_t)row * 1024 + h * 256 + tid]) * ov * rs, 0.f) & 0xffffu);
    __syncthreads();
}

__device__ __forceinline__ void conv_prompt_item(const Ctx& c, LAS unsigned char* lds, int item) {
    const int tid = otid(), wid = tid >> 6, lane = tid & 63, b = item >> 6, t0 = (item & 63) * 32;
    unsigned char* act = c.ws + WS_ACT;
    const bf16_t* U = (const bf16_t*)(act + A_U) + (size_t)b * SEQ * 512; bf16_t* AA = (bf16_t*)(act + A_AACT) + (size_t)b * SEQ * 512;
    LAS bf16_t* sU = (LAS bf16_t*)lds; LAS float* sC = (LAS float*)(lds + 63488);
    {
        u32x4 uv[8];
#pragma unroll
        for (int i = 0; i < 8; ++i) { const int id = tid + 512 * i, lr = id >> 6, cq = id & 63, t = t0 - 30 + lr;
            uv[i] = (u32x4){0u, 0u, 0u, 0u}; if (t >= 0 && lr < 62) uv[i] = __builtin_nontemporal_load((const u32x4*)(U + (size_t)t * 512 + cq * 8)); }
#pragma unroll
        for (int i = 0; i < 8; ++i) { const int id = tid + 512 * i, lr = id >> 6, cq = id & 63;
            if (lr < 62) *(LAS u32x4*)(sU + lr * 512 + cq * 8) = uv[i]; }
    }
    float wreg[CW];
#pragma unroll
    for (int w = 0; w < CW; ++w) wreg[w] = c.w_dw[w * CD + tid];
    const float bias = c.b_dw[tid];
    __syncthreads();
#pragma unroll 1
    for (int tb = 0; tb < 4; ++tb) {
        float a[8];
#pragma unroll
        for (int o = 0; o < 8; ++o) a[o] = bias;
#pragma unroll
        for (int k = 0; k < 38; ++k) { const float u = bf2f(sU[(tb * 8 + k) * 512 + tid]);
#pragma unroll
            for (int o = 0; o < 8; ++o) { const int w = k - o; if (w >= 0 && w < CW) a[o] += u * wreg[w]; } }
#pragma unroll
        for (int o = 0; o < 8; ++o) sC[(tb * 8 + o) * 512 + tid] = a[o];
    }
    __syncthreads();
    const f32x4 g0 = *(const f32x4*)(c.ln_w + lane * 4), g1 = *(const f32x4*)(c.ln_w + 256 + lane * 4), b0 = *(const f32x4*)(c.ln_b + lane * 4), b1 = *(const f32x4*)(c.ln_b + 256 + lane * 4);
    for (int rr = wid; rr < 32; rr += 8) {
        f32x4 x0 = *(const LAS f32x4*)(sC + rr * 512 + lane * 4), x1 = *(const LAS f32x4*)(sC + rr * 512 + 256 + lane * 4);
        const float mean = wave_sum((x0.x + x0.y) + (x0.z + x0.w) + (x1.x + x1.y) + (x1.z + x1.w)) * (1.0f / CD);
        x0 -= mean; x1 -= mean;
        const float var = wave_sum((x0.x * x0.x + x0.y * x0.y) + (x0.z * x0.z + x0.w * x0.w) + (x1.x * x1.x + x1.y * x1.y) + (x1.z * x1.z + x1.w * x1.w)) * (1.0f / CD);
        const float rstd = 1.0f / sqrtf(var + EPS);
        f32x4 y0 = x0 * rstd * g0 + b0, y1 = x1 * rstd * g1 + b1;
#pragma unroll
        for (int j = 0; j < 4; ++j) { y0[j] = y0[j] * sigm(y0[j]); y1[j] = y1[j] * sigm(y1[j]); }
        u32x2 w0, w1; w0.x = pk2(y0.x, y0.y); w0.y = pk2(y0.z, y0.w); w1.x = pk2(y1.x, y1.y); w1.y = pk2(y1.z, y1.w);
        bf16_t* dst = AA + (size_t)(t0 + rr) * 512;
        *(u32x2*)(dst + lane * 4) = w0; *(u32x2*)(dst + 256 + lane * 4) = w1;
    }
    if (t0 == SEQ - 32) {
        float* ncp = c.out + O_NCP + (size_t)b * 30 * CD;
        for (int id = tid; id < 30 * CD; id += 512) ncp[id] = bf2f(sU[(32 + (id >> 9)) * 512 + (id & 511)]);
    }
    __syncthreads();
}

__device__ __forceinline__ void conv_sample_item(const Ctx& c, LAS unsigned char* lds, int b) {
    const int tid = otid();
    unsigned char* act = c.ws + WS_ACT;
    LAS float* red = (LAS float*)lds;
    const float* cache = c.cache_conv + (size_t)b * 30 * CD; float* ncs = c.out + O_NCS + (size_t)b * 30 * CD;
    float acc = c.b_dw[tid];
#pragma unroll 1
    for (int w0 = 0; w0 < 30; w0 += 10) {
        float cv[10], wv[10];
#pragma unroll
        for (int w = 0; w < 10; ++w) { cv[w] = __builtin_nontemporal_load(cache + (w0 + w) * CD + tid); wv[w] = c.w_dw[(w0 + w) * CD + tid]; }
#pragma unroll
        for (int w = 0; w < 10; ++w) { acc += cv[w] * wv[w]; if (w0 + w >= 1) __builtin_nontemporal_store(cv[w], ncs + (w0 + w - 1) * CD + tid); }
    }
    const float u = bf2f(((const bf16_t*)(act + A_U))[(size_t)(MP + b) * 512 + tid]);
    acc += u * c.w_dw[30 * CD + tid]; ncs[29 * CD + tid] = u;
    const float mean = block_sum(acc, red, tid) * (1.0f / CD);
    const float d = acc - mean;
    const float var = block_sum(d * d, red, tid) * (1.0f / CD);
    float y = d * (1.0f / sqrtf(var + EPS)) * c.ln_w[tid] + c.ln_b[tid];
    y = y * sigm(y);
    ((bf16_t*)(act + A_AACT))[(size_t)(MP + b) * 512 + tid] = (bf16_t)(pk2(y, 0.f) & 0xffffu);
    __syncthreads();
}

__device__ __forceinline__ void phase2(const Ctx& c, LAS unsigned char* lds, int rep) {
    for (int it = blockIdx.x; it < NB * NH * 4; it += gridDim.x) { const int x = it & 7, j = it >> 3; ret_prompt_item(c, lds, (x * 4 + (j >> 2)) * 4 + (j & 3)); }
    unsigned* counter = (unsigned*)(c.ws + WS_CTL) + rep;
    LAS int* sItem = (LAS int*)(lds + LDS_BYTES - 16);
    constexpr int N_CONV = MP / 32, N_RS = MS * NH, N_CS = MS, N_WQ = (WI_TOTAL - WI_IN) / 16, NTOT = N_CONV + N_RS + N_CS + N_WQ;
    static_assert((WI_TOTAL - WI_IN) % 16 == 0, "weight queue items");
    unsigned nxt = 0u;
    if (threadIdx.x == 0) nxt = atomicAdd(counter, 1u);
    for (;;) {
        if (threadIdx.x == 0) { *sItem = (int)nxt; nxt = atomicAdd(counter, 1u); }
        __syncthreads();
        const int it = __builtin_amdgcn_readfirstlane(*sItem);
        __syncthreads();
        if (it >= NTOT) break;
        if (it < N_CS) conv_sample_item(c, lds, it);
        else if (it < N_CS + N_CONV) conv_prompt_item(c, lds, it - N_CS);
        else if (it < N_CS + N_CONV + N_RS) ret_sample_item(c, lds, it - N_CS - N_CONV);
        else { const int t_ = otid(); const int wv = __builtin_amdgcn_readfirstlane(t_ >> 6);
            wt_pair(c, WI_IN / 2 + (it - N_CS - N_CONV - N_RS) * 8 + wv, t_ & 63, (LAS float*)(lds + wv * 16384)); __syncthreads(); }
    }
}

__device__ __forceinline__ void phase2b(const Ctx& c) {
    const int t_ = otid(); const int lane = t_ & 63, gw = blockIdx.x * 8 + (t_ >> 6), NGW = gridDim.x * 8;
    unsigned char* act = c.ws + WS_ACT;
    const float* SSQ = (const float*)(c.ws + WS_SSQ);
    for (int row0 = gw; row0 < RT; row0 += 4 * NGW) {
        u32x4 a[4][2], o[4][2]; float rs[4];
#pragma unroll
        for (int r = 0; r < 4; ++r) { const int row = row0 + r * NGW; rs[r] = 1.0f;
            if (row < RT) {
                const u32x4* sg = (const u32x4*)((bf16_t*)(act + A_SG) + (size_t)row * 1024 + lane * 16);
                const u32x4* ov = (const u32x4*)((const bf16_t*)c.out + (size_t)row * 1024 + lane * 16);
#pragma unroll
                for (int j = 0; j < 2; ++j) { a[r][j] = __builtin_nontemporal_load(sg + j); o[r][j] = __builtin_nontemporal_load(ov + j); }
                if (row < MP) { const f32x4 q = *(const f32x4*)(SSQ + (size_t)row * 16 + (lane >> 4) * 4); rs[r] = 1.0f / sqrtf(((q.x + q.y) + (q.z + q.w)) * (1.0f / DV) + EPS); }
            } }
#pragma unroll
        for (int r = 0; r < 4; ++r) { const int row = row0 + r * NGW;
            if (row < RT) { u32x4* dg = (u32x4*)((bf16_t*)(act + A_SG) + (size_t)row * 1024 + lane * 16); const float k = rs[r];
#pragma unroll
                for (int j = 0; j < 2; ++j) { const u32x4 x = a[r][j], y = o[r][j]; u32x4 w;
                    w.x = pk2(bflo(x.x) * bflo(y.x) * k, bfhi(x.x) * bfhi(y.x) * k); w.y = pk2(bflo(x.y) * bflo(y.y) * k, bfhi(x.y) * bfhi(y.y) * k);
                    w.z = pk2(bflo(x.z) * bflo(y.z) * k, bfhi(x.z) * bfhi(y.z) * k); w.w = pk2(bflo(x.w) * bflo(y.w) * k, bfhi(x.w) * bfhi(y.w) * k);
                    dg[j] = w; } } }
    }
}


#define XB_TMO      128
#define XB_XCNT(j)  (256  + 64 * (j))
#define XB_XSUB(j)  (1280 + 64 * (j))
#define XB_XGEN(j)  (2304 + 64 * (j))
#define XB_TOP      3328
#define XB_TOPGEN   3392
#define XCD_BAR_WORDS 3456
#define XB_SPIN_CAP (1u << 22)
__device__ __forceinline__ unsigned xb_ld(unsigned* p)              { return __hip_atomic_load(p, __ATOMIC_RELAXED, __HIP_MEMORY_SCOPE_AGENT); }
__device__ __forceinline__ unsigned xb_add(unsigned* p, unsigned v) { return __hip_atomic_fetch_add(p, v, __ATOMIC_RELAXED, __HIP_MEMORY_SCOPE_AGENT); }
__device__ __forceinline__ unsigned xb_xcc_id() { return (unsigned)__builtin_amdgcn_s_getreg((3 << 11) | 20) & 0xFu; }
#define XB_SPIN(cond, bar) do { unsigned _sp = 0; while (cond) { __builtin_amdgcn_s_sleep(1); \
    if ((++_sp & 255u) == 0u) { if (xb_ld(&(bar)[XB_TMO])) break; if (_sp > XB_SPIN_CAP) { atomicAdd(&(bar)[XB_TMO], 1u); break; } } } } while (0)
struct XcdBarrier { unsigned* bar; unsigned x; volatile LAS unsigned* st; };
__device__ __forceinline__ XcdBarrier xcd_barrier_post(unsigned* bar, volatile LAS unsigned* st) {
    XcdBarrier b; b.bar = bar; b.x = xb_xcc_id(); b.st = st;
    if (threadIdx.x == 0) (void)xb_add(&bar[XB_XCNT(b.x)], 1u);
    return b;
}
__device__ __forceinline__ void xcd_barrier_complete(unsigned* bar, unsigned x, unsigned& nloc, unsigned& nx) {
    const unsigned G = gridDim.x * gridDim.y * gridDim.z;
    unsigned sum, cnt, mine, sp = 0u;
    for (;;) {
        sum = 0u; cnt = 0u; mine = 0u;
#pragma unroll
        for (unsigned j = 0; j < 16; ++j) { const unsigned c = xb_ld(&bar[XB_XCNT(j)]); sum += c; cnt += (c > 0u) ? 1u : 0u; mine = (j == x) ? c : mine; }
        if (sum == G) break;
        __builtin_amdgcn_s_sleep(1);
        if ((++sp & 255u) == 0u) { if (xb_ld(&bar[XB_TMO])) break; if (sp > XB_SPIN_CAP) { atomicAdd(&bar[XB_TMO], 1u); break; } }
    }
    nloc = mine > 0u ? mine : 1u; nx = cnt > 0u ? cnt : 1u;
}
__device__ __forceinline__ void xcd_barrier(const XcdBarrier& b) {
    asm volatile("s_waitcnt vmcnt(0)" ::: "memory");
    __syncthreads();
    if (threadIdx.x == 0) {
        unsigned* bar = b.bar;
        __builtin_amdgcn_s_waitcnt(0);
        unsigned nloc = b.st[0], nx = b.st[1];
        if (nloc == 0u) { xcd_barrier_complete(bar, b.x, nloc, nx); b.st[0] = nloc; b.st[1] = nx; }
        const unsigned old = xb_add(&bar[XB_XSUB(b.x)], 1u);
        const unsigned gen = old / nloc;
        if (old + 1u == (gen + 1u) * nloc) {
            __builtin_amdgcn_fence(__ATOMIC_RELEASE, "agent");
            asm volatile("s_waitcnt vmcnt(0)" ::: "memory");
            const unsigned og = xb_add(&bar[XB_TOP], 1u);
            const unsigned tg = og / nx;
            if (og + 1u == (tg + 1u) * nx) xb_add(&bar[XB_TOPGEN], 1u);
            else XB_SPIN(xb_ld(&bar[XB_TOPGEN]) == tg, bar);
            __builtin_amdgcn_fence(__ATOMIC_ACQUIRE, "agent");
            xb_add(&bar[XB_XGEN(b.x)], 1u);
            asm volatile("s_waitcnt vmcnt(0)" ::: "memory");
        } else {
            XB_SPIN(xb_ld(&bar[XB_XGEN(b.x)]) == gen, bar);
            __builtin_amdgcn_fence(__ATOMIC_ACQUIRE, "agent");
            asm volatile("s_waitcnt vmcnt(0)" ::: "memory");
        }
    }
    __syncthreads();
}

__global__ void __launch_bounds__(512) fwd_megakernel(Ctx c) {
    extern __shared__ __attribute__((aligned(16))) unsigned char smem[];
    LAS unsigned char* lds = (LAS unsigned char*)smem;
    cg::grid_group grid = cg::this_grid();
    unsigned char* act = c.ws + WS_ACT;
    volatile LAS unsigned* xst = (volatile LAS unsigned*)(lds + LDS_BYTES - 32);
    if (threadIdx.x == 0) { xst[0] = 0u; xst[1] = 0u; }
    __syncthreads();
    const XcdBarrier xb = xcd_barrier_post((unsigned*)(c.ws + WS_BAR), xst);
    phase0(c, lds);
    if (c.ws == nullptr) grid.sync();
    xcd_barrier(xb);
    gemm_all<EK_IN, NIN, DM, 3, Epi<EK_IN>, true>(c, lds, (const bf16_t*)c.out, (const bf16_t*)(c.ws + WS_WIN));
    xcd_barrier(xb);
    phase2(c, lds, 0);
    xcd_barrier(xb);
    gemm_all<EK_CO, DM, CD, 1, Epi<EK_CO>, true>(c, lds, (const bf16_t*)(act + A_AACT), (const bf16_t*)(c.ws + WS_WCO));
    gemm_all<EK_RO, DM, DM, 1, Epi<EK_RO>, true, true>(c, lds, (const bf16_t*)c.out, (const bf16_t*)(c.ws + WS_WRO));
    xcd_barrier(xb);
    gemm_all<EK_WO, DM, DM, 1, EpiWoFused>(c, lds, (const bf16_t*)(act + A_SB), (const bf16_t*)(c.ws + WS_WO));
    xcd_barrier(xb);
    gemm_all<EK_UP, FF, DM, 4, Epi<EK_UP>, true, false, true>(c, lds, (const bf16_t*)(act + A_M2), (const bf16_t*)(c.ws + WS_WUP));
    xcd_barrier(xb);
    gemm_all<EK_DN, DM, FF, 1, EpiDnFused>(c, lds, (const bf16_t*)(act + A_UP), (const bf16_t*)(c.ws + WS_WDN));
}

extern "C" void kernel_launch(void* const* d_in, const int* in_sizes, int n_in, void* d_out, int out_size, void* d_ws, size_t ws_size, hipStream_t stream) {
    static int grid_blocks = 0;
    if (!grid_blocks) {
        if (n_in != 18 || ws_size < WS_END3) { fprintf(stderr, "kernel_launch: unexpected n_in %d / ws_size %zu (need %zu)\n", n_in, ws_size, (size_t)WS_END3); grid_blocks = -1; return; }
        int dev = 0, cus = 0, per_cu = 0;
        hipGetDevice(&dev);
        hipDeviceGetAttribute(&cus, hipDeviceAttributeMultiprocessorCount, dev);
        if (hipFuncSetAttribute((const void*)fwd_megakernel, hipFuncAttributeMaxDynamicSharedMemorySize, LDS_BYTES) != hipSuccess) fprintf(stderr, "kernel_launch: hipFuncSetAttribute failed\n");
        hipOccupancyMaxActiveBlocksPerMultiprocessor(&per_cu, (const void*)fwd_megakernel, 512, LDS_BYTES);
        (void)hipGetLastError();
        if (per_cu < 1) { fprintf(stderr, "kernel_launch: occupancy query says %d blocks per CU\n", per_cu); per_cu = 1; }
        grid_blocks = cus * per_cu; if (grid_blocks > 256) grid_blocks = 256;
    }
    if (grid_blocks < 0) return;
    (void)hipMemsetAsync((char*)d_ws + WS_CTL, 0, CTL_ZERO, stream);
    Ctx c{};
    const float** f = (const float**)&c;
    for (int i = 0; i < 18; ++i) f[i] = (const float*)d_in[i];
    c.out = (float*)d_out; c.ws = (unsigned char*)d_ws;
    void* args[] = {&c};
    hipError_t e = hipLaunchCooperativeKernel((const void*)fwd_megakernel, dim3(grid_blocks), dim3(512), args, LDS_BYTES, stream);
    if (e != hipSuccess) fprintf(stderr, "cooperative launch failed: %s (grid %d)\n", hipGetErrorString(e), grid_blocks);
}
```

```cpp
#include <hip/hip_runtime.h>
#include <hip/hip_cooperative_groups.h>
#include <cstdio>
#include <cstdint>
namespace cg = cooperative_groups;

#define LAS __attribute__((address_space(3)))
typedef unsigned short bf16_t;
typedef short bf16x8 __attribute__((ext_vector_type(8)));
typedef float f32x4 __attribute__((ext_vector_type(4)));
typedef unsigned u32x4 __attribute__((ext_vector_type(4)));
typedef unsigned u32x2 __attribute__((ext_vector_type(2)));

constexpr int DM = 1024, NB = 8, SEQ = 2048, MP = NB * SEQ  , MS = 128, RT = MP + MS  ;
constexpr int CD = 512, CW = 31, NH = 4, DK = 128, DV = 256, FF = 4096, NIN = 6144;
constexpr float EPS = 1e-6f;
constexpr size_t O_NCP = (size_t)RT * DM;
constexpr size_t O_NRP = O_NCP + (size_t)NB * 30 * CD;
constexpr size_t O_NCS = O_NRP + (size_t)NB * NH * DK * DV;
constexpr size_t O_NRS = O_NCS + (size_t)MS * 30 * CD;
constexpr size_t WS_CTL = 0, WS_BAR = 4096, WS_WIN = 131072, WS_WCO = WS_WIN + (size_t)NIN * DM * 2, WS_WRO = WS_WCO + (size_t)DM * CD * 2,
                 WS_WO = WS_WRO + (size_t)DM * DM * 2, WS_WUP = WS_WO + (size_t)DM * DM * 2, WS_WDN = WS_WUP + (size_t)FF * DM * 2,
                 WS_ACT = WS_WDN + (size_t)FF * DM * 2;
constexpr size_t A_U = 0, A_Q = A_U + (size_t)RT * 512 * 2, A_K = A_Q + (size_t)RT * 512 * 2, A_V = A_K + (size_t)RT * 512 * 2,
                 A_SG = A_V + (size_t)RT * 1024 * 2, A_SA = A_SG + (size_t)RT * 1024 * 2, A_SB = A_SA + (size_t)RT * 1024 * 2,
                 A_AACT = A_SB + (size_t)RT * 1024 * 2, A_END = A_AACT + (size_t)RT * 512 * 2;
constexpr size_t A_M2 = (size_t)RT * 1024 * 2  , A_HN = 0  , A_F = 0  , A_UP = (size_t)RT * 1024 * 4;
static_assert(A_UP + (size_t)RT * FF * 2 <= A_END, "act region");
constexpr size_t WS_SSQ = WS_ACT + A_END, WS_END = WS_SSQ + (size_t)MP * 16 * 4;
constexpr size_t WS_XCH = WS_END;
constexpr size_t WS_XCHS = WS_XCH + 3 * 64 * 256 * 4 * 4;
constexpr size_t WS_END2 = WS_XCHS + 3 * 8 * 16 * 32 * 4;
constexpr size_t CTL_XCNT = 20480;
constexpr size_t CTL_XCNTS = CTL_XCNT + 3 * 64 * 256;
constexpr size_t CTL_ZERO = CTL_XCNTS + 3 * 8 * 256;
static_assert(CTL_ZERO <= WS_WIN, "control words");
constexpr size_t WS_RS2S = WS_END2;
constexpr size_t WS_END3 = WS_RS2S + 128 * 4;
constexpr int LDS_BYTES = 147456;

struct Ctx {
    const float *xp, *xs, *cache_conv, *state_ret, *n_mix_pre, *n_mix_post, *w_in, *w_dw, *b_dw, *ln_w, *ln_b, *w_co, *w_ro, *w_o,
        *n_ffn_pre, *n_ffn_post, *w_up, *w_dn;
    float* out; unsigned char* ws;
};

__device__ __forceinline__ unsigned pk2(float lo, float hi) { unsigned r; asm volatile("v_cvt_pk_bf16_f32 %0, %1, %2" : "=v"(r) : "v"(lo), "v"(hi)); return r; }
__device__ __forceinline__ float bflo(unsigned w) { return __uint_as_float(w << 16); }
__device__ __forceinline__ float bfhi(unsigned w) { return __uint_as_float(w & 0xffff0000u); }
__device__ __forceinline__ float bf2f(bf16_t b) { return __uint_as_float(((unsigned)b) << 16); }
__device__ __forceinline__ float sigm(float x) { return __builtin_amdgcn_rcpf(1.0f + __expf(-x)); }
__device__ __forceinline__ float wave_sum(float v) {
#pragma unroll
    for (int o = 1; o < 64; o <<= 1) v += __shfl_xor(v, o);
    return v;
}
#define LDS_WAIT() asm volatile("s_waitcnt lgkmcnt(0)" ::: "memory")
__device__ __forceinline__ int otid() { int t = threadIdx.x; asm volatile("" : "+v"(t)); return t; }
__device__ __forceinline__ const float* xrow(const Ctx& c, int row) { return row < MP ? c.xp + (size_t)row * DM : c.xs + (size_t)(row - MP) * DM; }

namespace pg8 {
constexpr int BM = 256, BK = 64, HALF = 128, HTB = HALF * BK * 2, STAGE_BYTES = 8 * HTB, NXCD = 8, WGM = 8;
__host__ __device__ __forceinline__ int lds_byte(int r, int c) { const int st = (r >> 4) * 2 + (c >> 5), rr = r & 15, cc = c & 31, ob = rr * 64 + cc * 2; return st * 1024 + (ob ^ (((ob >> 9) & 1) << 5)); }
__host__ __device__ __forceinline__ void stage_rc(int b, int& R, int& C) { const int st = b / 1024, sb = b % 1024, swz = sb ^ (((sb >> 9) & 1) << 5); R = (st >> 1) * 16 + swz / 64; C = (st & 1) * 32 + (swz % 64) / 2; }
__host__ __device__ __forceinline__ int perm32(int rho) { const int n = rho >> 4, i = rho & 15; return 8 * (i >> 2) + 4 * n + (i & 3); }
struct Unit { int pm, pn; };
struct Gemm { const bf16_t* A; const bf16_t* Bt; int M, N, K; const float* ssq = nullptr; };
struct StaticOrder {
    int nM, nN, nwg, G, c;
    __device__ void init(int M, int N, int G_, int c_) { nM = M / BM; nN = N / BM; nwg = nM * nN; G = G_; c = c_; }
    __device__ bool next(int i, Unit& u) const {
        const long L = (long)i * G + c; if (L >= nwg) return false;
        int wgid = (int)L; { const int q = nwg / NXCD, r = nwg % NXCD, xcd = wgid % NXCD, off = wgid / NXCD; wgid = (xcd < r ? xcd * (q + 1) : r * (q + 1) + (xcd - r) * q) + off; }
        const int nig = WGM * nN, gid = wgid / nig, fm = gid * WGM, gsz = (nM - fm) < WGM ? (nM - fm) : WGM;
        u.pm = fm + ((wgid % nig) % gsz); u.pn = (wgid % nig) / gsz; return true;
    }
};
template <class Epi, bool ALIGN_EPI = false, bool SP2 = true, bool HNORM = false, bool RS2TAB = false>
__device__ __forceinline__ void gemm_phase(LAS unsigned char* lds, const Gemm g, const StaticOrder& S, const Epi& E) {
    int tid_ = threadIdx.x; asm volatile("" : "+v"(tid_));
    const int tid = tid_, wid = __builtin_amdgcn_readfirstlane(tid >> 6), lane = tid & 63, wr = wid >> 2, wc = wid & 3, fr = lane & 15, fq = lane >> 4;
    const int K = g.K, nt = K / BK;
    unsigned voffA[2], voffB[2];
#pragma unroll
    for (int i = 0; i < 2; ++i) { int R, C; stage_rc(tid * 16 + i * 8192, R, C); const int Rb = (R & ~31) + perm32(R & 31);
        voffA[i] = (unsigned)(R * K + C) * 2u; voffB[i] = (unsigned)(Rb * K + C) * 2u; }
    const size_t kstep = (size_t)(BK * 2);
    const size_t hstep = (size_t)HALF * K * 2;
    const size_t tstep = 2 * hstep;
    const unsigned ldsw = (unsigned)wid * 1024u;
    const int aoff = lds_byte(wr * 64 + fr, fq * 8), boff = lds_byte(wc * 32 + fr, fq * 8);
#define PG8_SA(b, h) (((b) * 2 + (h)) * HTB)
#define PG8_SB(b, h) ((4 + (b) * 2 + (h)) * HTB)
#define PG8_STAGE(bufoff, gbase, voff) do { _Pragma("unroll") for (int _i = 0; _i < 2; ++_i) \
        __builtin_amdgcn_global_load_lds((const unsigned*)((const char*)(gbase) + (voff)[_i]), (LAS unsigned*)(lds + (bufoff) + ldsw + _i * 8192), 16, 0, 0); } while (0)
#define PG8_LDA(dst, b, h) do { _Pragma("unroll") for (int m = 0; m < 4; ++m) _Pragma("unroll") for (int k = 0; k < 2; ++k) dst[m][k] = *(const LAS bf16x8*)(lds + PG8_SA(b, h) + aoff + m * 2048 + k * 1024); } while (0)
#define PG8_LDB(dst, b, h) do { _Pragma("unroll") for (int n = 0; n < 2; ++n) _Pragma("unroll") for (int k = 0; k < 2; ++k) dst[n][k] = *(const LAS bf16x8*)(lds + PG8_SB(b, h) + boff + n * 2048 + k * 1024); } while (0)
#define PG8_MMA(ai, bj, At, Bt) do { __builtin_amdgcn_s_setprio(1); _Pragma("unroll") for (int m = 0; m < 4; ++m) _Pragma("unroll") for (int n = 0; n < 2; ++n) _Pragma("unroll") for (int k = 0; k < 2; ++k) \
        acc[ai][bj][m][n] = __builtin_amdgcn_mfma_f32_16x16x32_bf16(Bt[n][k], At[m][k], acc[ai][bj][m][n], 0, 0, 0); __builtin_amdgcn_s_setprio(0); } while (0)
#define PG8_WAIT_V(n) asm volatile("s_waitcnt vmcnt(" #n ")" ::: "memory")
#define PG8_WAIT_L(n) asm volatile("s_waitcnt lgkmcnt(" #n ")" ::: "memory")
#define PG8_BAR __builtin_amdgcn_s_barrier()
#define PG8_SCHED __builtin_amdgcn_sched_barrier(0)
    Unit cur, nxt; int ui = 0;
    if (!S.next(0, cur)) return;
    f32x4 acc[2][2][4][2];
#pragma unroll
    for (int a = 0; a < 2; ++a)
#pragma unroll
        for (int b = 0; b < 2; ++b)
#pragma unroll
            for (int m = 0; m < 4; ++m)
#pragma unroll
                for (int n = 0; n < 2; ++n) acc[a][b][m][n] = (f32x4){0.f, 0.f, 0.f, 0.f};
    bf16x8 At[4][2], B0[2][2], B1[2][2];
    const char* cA = (const char*)g.A + (size_t)cur.pm * tstep; const char* cB = (const char*)g.Bt + (size_t)cur.pn * tstep;
    LAS float* hrt = (LAS float*)(lds + STAGE_BYTES);
    if constexpr (RS2TAB) {
        if (tid < 256) { const f32x4 q = *(const f32x4*)(g.ssq + (size_t)(cur.pm * 256 + tid) * 4); hrt[tid] = 1.0f / sqrtf(((q.x + q.y) + (q.z + q.w)) * (1.0f / 1024.0f) + 1e-6f); }
        asm volatile("s_waitcnt vmcnt(0) lgkmcnt(0)" ::: "memory"); PG8_BAR;
    }
    if constexpr (HNORM) {
        if (tid < 256) { const float* q = g.ssq + (size_t)(cur.pm * 256 + tid) * 16; float r[4];
#pragma unroll
            for (int hh = 0; hh < 4; ++hh) { const f32x4 v = *(const f32x4*)(q + 4 * hh); r[hh] = 1.0f / sqrtf(((v.x + v.y) + (v.z + v.w)) * (1.0f / 256.0f) + 1e-6f); }
            *(LAS f32x4*)(hrt + tid * 4) = (f32x4){r[0] / r[1], r[1] / r[2], r[2] / r[3], r[3]}; }
        asm volatile("s_waitcnt vmcnt(0) lgkmcnt(0)" ::: "memory"); PG8_BAR;
    }
    if constexpr (SP2) {
        PG8_STAGE(PG8_SB(0, 0), cB, voffB); PG8_STAGE(PG8_SB(0, 1), cB + hstep, voffB); PG8_STAGE(PG8_SA(0, 0), cA, voffA); PG8_STAGE(PG8_SA(0, 1), cA + hstep, voffA);
        if (wr == 1) PG8_BAR;
        PG8_WAIT_V(2); PG8_BAR;
        PG8_STAGE(PG8_SB(1, 0), cB + kstep, voffB); PG8_STAGE(PG8_SA(1, 0), cA + kstep, voffA); PG8_STAGE(PG8_SB(1, 1), cB + hstep + kstep, voffB);
        PG8_WAIT_V(6); PG8_BAR;
    } else {
    PG8_STAGE(PG8_SB(0, 0), cB, voffB); PG8_STAGE(PG8_SA(0, 0), cA, voffA); PG8_STAGE(PG8_SB(0, 1), cB + hstep, voffB); PG8_STAGE(PG8_SA(0, 1), cA + hstep, voffA);
    if (wr == 1) PG8_BAR;
    PG8_WAIT_V(4); PG8_BAR;
    PG8_STAGE(PG8_SB(1, 0), cB + kstep, voffB); PG8_STAGE(PG8_SA(1, 0), cA + kstep, voffA); PG8_STAGE(PG8_SB(1, 1), cB + hstep + kstep, voffB);
    PG8_WAIT_V(6); PG8_BAR;
    }
    for (;;) {
        const bool has_next = S.next(ui + 1, nxt);
        const char* nA = has_next ? (const char*)g.A + (size_t)nxt.pm * tstep : cA; const char* nB = has_next ? (const char*)g.Bt + (size_t)nxt.pn * tstep : cB;
        for (int t = 0; t < nt; t += 2) {
            const bool last = (t == nt - 2);
            const char* a1 = cA + (size_t)(t + 1) * kstep;
            const char* a2 = last ? nA : cA + (size_t)(t + 2) * kstep; const char* b2 = last ? nB : cB + (size_t)(t + 2) * kstep;
            const char* a3 = a2 + kstep; const char* b3 = b2 + kstep;
            if constexpr (HNORM) { if (t == 4 || t == 8 || t == 12) { const int hi = (t >> 2) - 1;
#pragma unroll
                for (int ai = 0; ai < 2; ++ai)
#pragma unroll
                    for (int m = 0; m < 4; ++m) { const float f = hrt[(ai * 128 + wr * 64 + m * 16 + fr) * 4 + hi];
#pragma unroll
                        for (int bj = 0; bj < 2; ++bj)
#pragma unroll
                            for (int n = 0; n < 2; ++n) acc[ai][bj][m][n] *= f; } } }
            if constexpr (SP2) {
            PG8_LDB(B0, 0, 0); PG8_LDB(B1, 0, 1); PG8_SCHED; PG8_LDA(At, 0, 0); PG8_STAGE(PG8_SA(1, 1), a1 + hstep, voffA);
            PG8_WAIT_V(8); PG8_WAIT_L(0); PG8_BAR; PG8_MMA(0, 0, At, B0); PG8_MMA(0, 1, At, B1); PG8_BAR; PG8_SCHED;
            PG8_LDA(At, 0, 1); PG8_STAGE(PG8_SB(0, 0), b2, voffB); PG8_STAGE(PG8_SB(0, 1), b2 + hstep, voffB); PG8_STAGE(PG8_SA(0, 0), a2, voffA);
            PG8_WAIT_V(8); PG8_WAIT_L(0); PG8_BAR; PG8_MMA(1, 0, At, B0); PG8_MMA(1, 1, At, B1); PG8_BAR; PG8_SCHED;
            PG8_LDB(B0, 1, 0); PG8_LDB(B1, 1, 1); PG8_SCHED; PG8_LDA(At, 1, 0); PG8_STAGE(PG8_SA(0, 1), a2 + hstep, voffA);
            PG8_WAIT_V(8); PG8_WAIT_L(0); PG8_BAR; PG8_MMA(0, 0, At, B0); PG8_MMA(0, 1, At, B1); PG8_BAR; PG8_SCHED;
            PG8_LDA(At, 1, 1); PG8_STAGE(PG8_SB(1, 0), b3, voffB); PG8_STAGE(PG8_SB(1, 1), b3 + hstep, voffB); PG8_STAGE(PG8_SA(1, 0), a3, voffA);
            PG8_WAIT_V(8); PG8_WAIT_L(0); PG8_BAR; PG8_MMA(1, 0, At, B0); PG8_MMA(1, 1, At, B1); PG8_BAR; PG8_SCHED;
            } else {
            PG8_LDB(B0, 0, 0); PG8_SCHED; PG8_LDA(At, 0, 0); PG8_STAGE(PG8_SA(1, 1), a1 + hstep, voffA);
            PG8_WAIT_L(8); PG8_BAR; PG8_WAIT_L(0); PG8_MMA(0, 0, At, B0); PG8_BAR; PG8_SCHED;
            PG8_LDB(B1, 0, 1); PG8_STAGE(PG8_SB(0, 0), b2, voffB);
            PG8_BAR; PG8_WAIT_L(0); PG8_MMA(0, 1, At, B1); PG8_BAR;
            PG8_LDA(At, 0, 1); PG8_STAGE(PG8_SA(0, 0), a2, voffA);
            PG8_BAR; PG8_WAIT_L(0); PG8_MMA(1, 0, At, B0); PG8_BAR; PG8_SCHED;
            PG8_STAGE(PG8_SB(0, 1), b2 + hstep, voffB);
            PG8_WAIT_V(6); PG8_BAR; PG8_MMA(1, 1, At, B1); PG8_BAR;
            PG8_LDB(B0, 1, 0); PG8_SCHED; PG8_LDA(At, 1, 0); PG8_STAGE(PG8_SA(0, 1), a2 + hstep, voffA);
            PG8_WAIT_L(8); PG8_BAR; PG8_WAIT_L(0); PG8_MMA(0, 0, At, B0); PG8_BAR; PG8_SCHED;
            PG8_LDB(B1, 1, 1); PG8_STAGE(PG8_SB(1, 0), b3, voffB);
            PG8_BAR; PG8_WAIT_L(0); PG8_MMA(0, 1, At, B1); PG8_BAR;
            PG8_LDA(At, 1, 1); PG8_STAGE(PG8_SA(1, 0), a3, voffA);
            PG8_BAR; PG8_WAIT_L(0); PG8_MMA(1, 0, At, B0); PG8_BAR; PG8_SCHED;
            PG8_STAGE(PG8_SB(1, 1), b3 + hstep, voffB);
            PG8_WAIT_V(6); PG8_BAR; PG8_MMA(1, 1, At, B1); PG8_BAR;
            }
        }
        if constexpr (HNORM) {
#pragma unroll
            for (int ai = 0; ai < 2; ++ai)
#pragma unroll
                for (int m = 0; m < 4; ++m) { const float f = hrt[(ai * 128 + wr * 64 + m * 16 + fr) * 4 + 3];
#pragma unroll
                    for (int bj = 0; bj < 2; ++bj)
#pragma unroll
                        for (int n = 0; n < 2; ++n) acc[ai][bj][m][n] *= f; } }
        if constexpr (ALIGN_EPI) { if (wr == 0) PG8_BAR; }
        if constexpr (!Epi::AFTER_DRAIN) E(acc, cur, wr, wc, fr, fq);
        if (!has_next) break;
#pragma unroll
        for (int a = 0; a < 2; ++a)
#pragma unroll
            for (int b = 0; b < 2; ++b)
#pragma unroll
                for (int m = 0; m < 4; ++m)
#pragma unroll
                    for (int n = 0; n < 2; ++n) acc[a][b][m][n] = (f32x4){0.f, 0.f, 0.f, 0.f};
        cur = nxt; cA = nA; cB = nB; ++ui;
        if constexpr (ALIGN_EPI) { if (wr == 1) PG8_BAR; }
    }
    PG8_WAIT_V(0);
    if constexpr (!ALIGN_EPI) { if (wr == 0) PG8_BAR; }
    PG8_BAR;
    if constexpr (Epi::AFTER_DRAIN) E.fused(acc, cur, wr, wc, fr, fq, lds, tid);
#undef PG8_SA
#undef PG8_SB
#undef PG8_STAGE
#undef PG8_LDA
#undef PG8_LDB
#undef PG8_MMA
#undef PG8_WAIT_V
#undef PG8_WAIT_L
#undef PG8_BAR
#undef PG8_SCHED
}
}

enum { EK_IN = 0, EK_CO, EK_RO, EK_WO, EK_UP, EK_DN };

template <int KIND>
__device__ __forceinline__ void epi8(const Ctx& c, int row, int col, f32x4 v0, f32x4 v1) {
    unsigned char* act = c.ws + WS_ACT;
    if constexpr (KIND == EK_IN) {
        if (col < 1024) {
            u32x2 w; w.x = pk2(v0[0] * sigm(v0[1]), v0[2] * sigm(v0[3])); w.y = pk2(v1[0] * sigm(v1[1]), v1[2] * sigm(v1[3]));
            *(u32x2*)((bf16_t*)(act + A_U) + (size_t)row * 512 + (col >> 1)) = w;
        } else if (col < 2048) {
            const bool isk = col >= 1536; const int cc = col - (isk ? 1536 : 1024), h = cc >> 7, i0 = (cc & 127) >> 1;
            const float pos = row < MP ? (float)(row & (SEQ - 1)) : 16384.0f;
            const float sc = isk ? 0.08838834764831845f : 1.0f;
            const float* freq = (const float*)(c.ws + WS_CTL + 256);
            const f32x4 fv = *(const f32x4*)(freq + i0);
            float x1[4] = {v0[0], v0[2], v1[0], v1[2]}, x2[4] = {v0[1], v0[3], v1[1], v1[3]}, o1[4], o2[4];
#pragma unroll
            for (int p = 0; p < 4; ++p) {
                const float ang = pos * fv[p];
                const float n = rintf(ang * 0.15915494309189535f);
                const float r = fmaf(-n, -1.7484555e-7f, fmaf(-n, 6.2831854820251465f, ang));
                const float sn = __sinf(r) * sc, cs = __cosf(r) * sc;
                o1[p] = x1[p] * cs - x2[p] * sn; o2[p] = x2[p] * cs + x1[p] * sn;
            }
            bf16_t* dst = (bf16_t*)(act + (isk ? A_K : A_Q)) + (size_t)row * 512 + h * 128 + i0;
            u32x2 w1, w2; w1.x = pk2(o1[0], o1[1]); w1.y = pk2(o1[2], o1[3]); w2.x = pk2(o2[0], o2[1]); w2.y = pk2(o2[2], o2[3]);
            *(u32x2*)dst = w1; *(u32x2*)(dst + 64) = w2;
        } else {
            const int seg = (col - 2048) >> 10, cc = (col - 2048) & 1023;
            float f[8] = {v0[0], v0[1], v0[2], v0[3], v1[0], v1[1], v1[2], v1[3]};
            if (seg >= 2) {
#pragma unroll
                for (int j = 0; j < 8; ++j) f[j] = sigm(f[j]);
            }
            u32x4 w; w.x = pk2(f[0], f[1]); w.y = pk2(f[2], f[3]); w.z = pk2(f[4], f[5]); w.w = pk2(f[6], f[7]);
            *(u32x4*)((bf16_t*)(act + A_V + (size_t)seg * ((size_t)RT * 1024 * 2)) + (size_t)row * 1024 + cc) = w;
        }
    } else if constexpr (KIND == EK_CO) {
        u32x4* p = (u32x4*)((bf16_t*)(act + A_SA) + (size_t)row * 1024 + col); const u32x4 g = *p;
        u32x4 w; w.x = pk2(v0[0] * bflo(g.x), v0[1] * bfhi(g.x)); w.y = pk2(v0[2] * bflo(g.y), v0[3] * bfhi(g.y));
        w.z = pk2(v1[0] * bflo(g.z), v1[1] * bfhi(g.z)); w.w = pk2(v1[2] * bflo(g.w), v1[3] * bfhi(g.w));
        *p = w;
    } else if constexpr (KIND == EK_RO) {
        const u32x4 t = *(const u32x4*)((bf16_t*)(act + A_SA) + (size_t)row * 1024 + col);
        u32x4* p = (u32x4*)((bf16_t*)(act + A_SB) + (size_t)row * 1024 + col); const u32x4 g = *p;
        u32x4 w; w.x = pk2(bflo(t.x) + v0[0] * bflo(g.x), bfhi(t.x) + v0[1] * bfhi(g.x)); w.y = pk2(bflo(t.y) + v0[2] * bflo(g.y), bfhi(t.y) + v0[3] * bfhi(g.y));
        w.z = pk2(bflo(t.z) + v1[0] * bflo(g.z), bfhi(t.z) + v1[1] * bfhi(g.z)); w.w = pk2(bflo(t.w) + v1[2] * bflo(g.w), bfhi(t.w) + v1[3] * bfhi(g.w));
        *p = w;
    } else if constexpr (KIND == EK_WO) {
        u32x4 w; w.x = pk2(v0[0], v0[1]); w.y = pk2(v0[2], v0[3]); w.z = pk2(v1[0], v1[1]); w.w = pk2(v1[2], v1[3]);
        *(u32x4*)((bf16_t*)(act + A_M2) + (size_t)row * DM + col) = w;
    } else if constexpr (KIND == EK_UP) {
        float f[8] = {v0[0], v0[1], v0[2], v0[3], v1[0], v1[1], v1[2], v1[3]};
#pragma unroll
        for (int j = 0; j < 8; ++j) { const float r = fmaxf(f[j], 0.f); f[j] = r * r; }
        u32x4 w; w.x = pk2(f[0], f[1]); w.y = pk2(f[2], f[3]); w.z = pk2(f[4], f[5]); w.w = pk2(f[6], f[7]);
        *(u32x4*)((bf16_t*)(act + A_UP) + (size_t)row * FF + col) = w;
    } else {
        u32x4 w; w.x = pk2(v0[0], v0[1]); w.y = pk2(v0[2], v0[3]); w.z = pk2(v1[0], v1[1]); w.w = pk2(v1[2], v1[3]);
        *(u32x4*)((bf16_t*)(act + A_F) + (size_t)row * DM + col) = w;
    }
}

template <int KIND> struct Epi {
    static constexpr bool AFTER_DRAIN = false;
    Ctx c; const LAS float* tab = nullptr;
    __device__ __forceinline__ void operator()(const f32x4 (&acc)[2][2][4][2], const pg8::Unit& u, int wr, int wc, int fr, int fq) const {
#pragma unroll
        for (int ai = 0; ai < 2; ++ai)
#pragma unroll
            for (int m = 0; m < 4; ++m) {
                const int row = u.pm * 256 + ai * 128 + wr * 64 + m * 16 + fr;
                float f = 1.0f; if constexpr (KIND == EK_UP) f = tab[ai * 128 + wr * 64 + m * 16 + fr];
#pragma unroll
                for (int bj = 0; bj < 2; ++bj) {
                    if constexpr (KIND == EK_UP) epi8<KIND>(c, row, u.pn * 256 + bj * 128 + wc * 32 + 8 * fq, acc[ai][bj][m][0] * f, acc[ai][bj][m][1] * f);
                    else epi8<KIND>(c, row, u.pn * 256 + bj * 128 + wc * 32 + 8 * fq, acc[ai][bj][m][0], acc[ai][bj][m][1]);
                }
            }
    }
};

__device__ __forceinline__ void row_rms_exchange(const Ctx& c, int set, const f32x4 (&v)[2][2][4][2], const pg8::Unit& u, int wr, int wc, int fr, int fq, LAS unsigned char* lds, int tid) {
    LAS float* P = (LAS float*)lds;
    LAS float* S = (LAS float*)(lds + 8192);
    unsigned* slots = (unsigned*)(c.ws + WS_XCH) + (size_t)set * 64 * 256 * 4;
    unsigned* cnt = (unsigned*)(c.ws + WS_CTL + CTL_XCNT) + (size_t)(set * 64 + u.pm) * 64;
#pragma unroll
    for (int ai = 0; ai < 2; ++ai)
#pragma unroll
        for (int m = 0; m < 4; ++m) {
            float q = 0.f;
#pragma unroll
            for (int bj = 0; bj < 2; ++bj)
#pragma unroll
                for (int n = 0; n < 2; ++n) { const f32x4 x = v[ai][bj][m][n]; q += (x[0] * x[0] + x[1] * x[1]) + (x[2] * x[2] + x[3] * x[3]); }
            q += __shfl_xor(q, 16); q += __shfl_xor(q, 32);
            if (fq == 0) P[(ai * 128 + wr * 64 + m * 16 + fr) * 4 + wc] = q;
        }
    __syncthreads();
    if (tid < 256) {
        const float t = (P[tid * 4 + 0] + P[tid * 4 + 1]) + (P[tid * 4 + 2] + P[tid * 4 + 3]);
        __hip_atomic_store(slots + ((size_t)(u.pm * 256 + tid) * 4 + u.pn), __float_as_uint(t), __ATOMIC_RELAXED, __HIP_MEMORY_SCOPE_AGENT);
    }
    asm volatile("s_waitcnt vmcnt(0)" ::: "memory");
    __syncthreads();
    if (tid == 0) {
        __hip_atomic_fetch_add(cnt, 1u, __ATOMIC_RELAXED, __HIP_MEMORY_SCOPE_AGENT);
        unsigned sp = 0;
        while (__hip_atomic_load(cnt, __ATOMIC_RELAXED, __HIP_MEMORY_SCOPE_AGENT) < 4u) { __builtin_amdgcn_s_sleep(1); if (++sp > (1u << 22)) break; }
        __builtin_amdgcn_fence(__ATOMIC_ACQUIRE, "agent");
        asm volatile("s_waitcnt vmcnt(0)" ::: "memory");
    }
    __syncthreads();
    if (tid < 256) {
        const unsigned* sl = slots + (size_t)(u.pm * 256 + tid) * 4;
        float t = 0.f;
#pragma unroll
        for (int k = 0; k < 4; ++k) t += __uint_as_float(__hip_atomic_load(sl + k, __ATOMIC_RELAXED, __HIP_MEMORY_SCOPE_AGENT));
        S[tid] = 1.0f / sqrtf(t * (1.0f / DM) + EPS);
    }
    __syncthreads();
}
struct EpiWoFused {
    static constexpr bool AFTER_DRAIN = true;
    Ctx c;
    __device__ __forceinline__ void fused(f32x4 (&acc)[2][2][4][2], const pg8::Unit& u, int wr, int wc, int fr, int fq, LAS unsigned char* lds, int tid) const {
        row_rms_exchange(c, 1, acc, u, wr, wc, fr, fq, lds, tid);
        const LAS float* S = (const LAS float*)(lds + 8192);
        bf16_t* MB = (bf16_t*)(c.ws + WS_ACT + A_M2); bf16_t* HN = (bf16_t*)(c.ws + WS_ACT + A_HN);
#pragma unroll
        for (int bj = 0; bj < 2; ++bj) {
            const int col = u.pn * 256 + bj * 128 + wc * 32 + 8 * fq;
            const f32x4 g0 = *(const f32x4*)(c.n_mix_post + col), g1 = *(const f32x4*)(c.n_mix_post + col + 4);
#pragma unroll
            for (int ai = 0; ai < 2; ++ai)
#pragma unroll
                for (int m = 0; m < 4; ++m) { const int rl = ai * 128 + wr * 64 + m * 16 + fr; const float rs = S[rl]; const size_t ro = (size_t)(u.pm * 256 + rl) * DM + col;
                    const f32x4 x0 = __builtin_nontemporal_load((const f32x4*)(c.xp + ro)), x1 = __builtin_nontemporal_load((const f32x4*)(c.xp + ro + 4));
                    const f32x4 h0 = x0 + acc[ai][bj][m][0] * rs * g0, h1 = x1 + acc[ai][bj][m][1] * rs * g1;
                    acc[ai][bj][m][0] = h0; acc[ai][bj][m][1] = h1;
                    u32x4 w; w.x = pk2(h0[0], h0[1]); w.y = pk2(h0[2], h0[3]); w.z = pk2(h1[0], h1[1]); w.w = pk2(h1[2], h1[3]);
                    *(u32x4*)(MB + ro) = w; }
        }
        {
            LAS float* P = (LAS float*)lds;
            unsigned* slots = (unsigned*)(c.ws + WS_XCH) + (size_t)2 * 64 * 256 * 4;
#pragma unroll
            for (int ai = 0; ai < 2; ++ai)
#pragma unroll
                for (int m = 0; m < 4; ++m) { float q = 0.f;
#pragma unroll
                    for (int bj = 0; bj < 2; ++bj)
#pragma unroll
                        for (int n = 0; n < 2; ++n) { const f32x4 x = acc[ai][bj][m][n]; q += (x[0] * x[0] + x[1] * x[1]) + (x[2] * x[2] + x[3] * x[3]); }
                    q += __shfl_xor(q, 16); q += __shfl_xor(q, 32);
                    if (fq == 0) P[(ai * 128 + wr * 64 + m * 16 + fr) * 4 + wc] = q; }
            __syncthreads();
            if (tid < 256) slots[(size_t)(u.pm * 256 + tid) * 4 + u.pn] = __float_as_uint((P[tid * 4 + 0] + P[tid * 4 + 1]) + (P[tid * 4 + 2] + P[tid * 4 + 3]));
        }
    }
};

__device__ __forceinline__ float small_rms_exchange(const Ctx& c, int set, int mt, int ng, int lane, const f32x4& s0, const f32x4& s1) {
    const int fr = lane & 15, fq = lane >> 4;
    unsigned* slots = (unsigned*)(c.ws + WS_XCHS) + (size_t)((set * 8 + mt) * 16) * 32;
    unsigned* cnt = (unsigned*)(c.ws + WS_CTL + CTL_XCNTS) + (size_t)(set * 8 + mt) * 64;
    float q = ((s0[0] * s0[0] + s0[1] * s0[1]) + (s0[2] * s0[2] + s0[3] * s0[3])) + ((s1[0] * s1[0] + s1[1] * s1[1]) + (s1[2] * s1[2] + s1[3] * s1[3]));
    q += __shfl_xor(q, 16); q += __shfl_xor(q, 32);
    if (fq == 0) __hip_atomic_store(slots + fr * 32 + ng, __float_as_uint(q), __ATOMIC_RELAXED, __HIP_MEMORY_SCOPE_AGENT);
    asm volatile("s_waitcnt vmcnt(0)" ::: "memory");
    if (lane == 0) {
        __hip_atomic_fetch_add(cnt, 1u, __ATOMIC_RELAXED, __HIP_MEMORY_SCOPE_AGENT);
        unsigned sp = 0;
        while (__hip_atomic_load(cnt, __ATOMIC_RELAXED, __HIP_MEMORY_SCOPE_AGENT) < 32u) { __builtin_amdgcn_s_sleep(1); if (++sp > (1u << 22)) break; }
    }
    __builtin_amdgcn_fence(__ATOMIC_ACQUIRE, "agent");
    asm volatile("s_waitcnt vmcnt(0)" ::: "memory");
    float t = 0.f;
#pragma unroll
    for (int k = 0; k < 8; ++k) t += __uint_as_float(__hip_atomic_load(slots + fr * 32 + fq * 8 + k, __ATOMIC_RELAXED, __HIP_MEMORY_SCOPE_AGENT));
    t += __shfl_xor(t, 16); t += __shfl_xor(t, 32);
    return 1.0f / sqrtf(t * (1.0f / DM) + EPS);
}
template <int KIND>
__device__ __forceinline__ void small_fused(const Ctx& c, int mt, int ng, int lane, f32x4 s0, f32x4 s1) {
    const int fr = lane & 15, fq = lane >> 4, col = ng * 32 + 8 * fq;
    const size_t ro = (size_t)(MP + mt * 16 + fr) * DM + col;
    bf16_t* MB = (bf16_t*)(c.ws + WS_ACT + A_M2);
    if constexpr (KIND == EK_WO) {
        const float rs = small_rms_exchange(c, 0, mt, ng, lane, s0, s1);
        const float* xr = c.xs + (size_t)(mt * 16 + fr) * DM + col;
        const f32x4 g0 = *(const f32x4*)(c.n_mix_post + col), g1 = *(const f32x4*)(c.n_mix_post + col + 4);
        const f32x4 h0 = *(const f32x4*)xr + s0 * rs * g0, h1 = *(const f32x4*)(xr + 4) + s1 * rs * g1;
        u32x4 w; w.x = pk2(h0[0], h0[1]); w.y = pk2(h0[2], h0[3]); w.z = pk2(h1[0], h1[1]); w.w = pk2(h1[2], h1[3]);
        *(u32x4*)(MB + ro) = w;
        const float rs2 = small_rms_exchange(c, 1, mt, ng, lane, h0, h1);
        if (ng == 0 && fq == 0) ((float*)(c.ws + WS_RS2S))[mt * 16 + fr] = rs2;
    } else {
        const float rs = small_rms_exchange(c, 2, mt, ng, lane, s0, s1);
        const u32x4 hw = *(const u32x4*)(MB + ro);
        const f32x4 h0 = {bflo(hw.x), bfhi(hw.x), bflo(hw.y), bfhi(hw.y)}, h1 = {bflo(hw.z), bfhi(hw.z), bflo(hw.w), bfhi(hw.w)};
        const f32x4 g0 = *(const f32x4*)(c.n_ffn_post + col), g1 = *(const f32x4*)(c.n_ffn_post + col + 4);
        float* p = c.out + ro;
        *(f32x4*)p = h0 + s0 * rs * g0; *(f32x4*)(p + 4) = h1 + s1 * rs * g1;
    }
}

struct EpiDnFused {
    static constexpr bool AFTER_DRAIN = true;
    Ctx c;
    __device__ __forceinline__ void fused(const f32x4 (&acc)[2][2][4][2], const pg8::Unit& u, int wr, int wc, int fr, int fq, LAS unsigned char* lds, int tid) const {
        row_rms_exchange(c, 0, acc, u, wr, wc, fr, fq, lds, tid);
        const LAS float* S = (const LAS float*)(lds + 8192);
#pragma unroll
        for (int bj = 0; bj < 2; ++bj) {
            const int col = u.pn * 256 + bj * 128 + wc * 32 + 8 * fq;
            const f32x4 g0 = *(const f32x4*)(c.n_ffn_post + col), g1 = *(const f32x4*)(c.n_ffn_post + col + 4);
#pragma unroll
            for (int ai = 0; ai < 2; ++ai)
#pragma unroll
                for (int m = 0; m < 4; ++m) { const int rl = ai * 128 + wr * 64 + m * 16 + fr; const float rs = S[rl];
                    float* p = c.out + (size_t)(u.pm * 256 + rl) * DM + col;
                    const u32x4 hw = __builtin_nontemporal_load((const u32x4*)((const bf16_t*)(c.ws + WS_ACT + A_M2) + (size_t)(u.pm * 256 + rl) * DM + col));
                    const f32x4 h0 = {bflo(hw.x), bfhi(hw.x), bflo(hw.y), bfhi(hw.y)}, h1 = {bflo(hw.z), bfhi(hw.z), bflo(hw.w), bfhi(hw.w)};
                    __builtin_nontemporal_store(h0 + acc[ai][bj][m][0] * rs * g0, (f32x4*)p); __builtin_nontemporal_store(h1 + acc[ai][bj][m][1] * rs * g1, (f32x4*)(p + 4)); }
        }
    }
};

template <int KIND, int N, int K, int NI, class BigEpi = Epi<KIND>, bool ALIGN = false, bool HNORM = false, bool RS2TAB = false>
__device__ __forceinline__ void gemm_all(const Ctx& c, LAS unsigned char* lds, const bf16_t* A, const bf16_t* Bt) {
    {
    {
    pg8::StaticOrder S; S.init(MP, N, gridDim.x, blockIdx.x);
    BigEpi E{c};
    if constexpr (RS2TAB) E.tab = (const LAS float*)(lds + pg8::STAGE_BYTES);
    pg8::Gemm g{A, Bt, MP, N, K, RS2TAB ? (const float*)(c.ws + WS_XCH) + (size_t)2 * 64 * 256 * 4 : (const float*)(c.ws + WS_SSQ)};
    pg8::gemm_phase<BigEpi, ALIGN, true, HNORM, RS2TAB>(lds, g, S, E);
    __syncthreads();
    }
    {
    const int tid = otid(), wid = __builtin_amdgcn_readfirstlane(tid >> 6), lane = tid & 63, fr = lane & 15, fq = lane >> 4;
    LAS f32x4* red = (LAS f32x4*)lds;
    constexpr int nitems = 8 * (N / 32), kw = K / 8, KS = kw / 32, KB = KS > 4 ? 4 : KS;
    const unsigned toff = (unsigned)((fr * K + wid * kw + 8 * fq) * 2);
    const unsigned tb0 = (unsigned)((pg8::perm32(fr) * K + wid * kw + 8 * fq) * 2), tb1 = (unsigned)((pg8::perm32(16 + fr) * K + wid * kw + 8 * fq) * 2);
    for (int base = blockIdx.x * NI; base < nitems; base += gridDim.x * NI) {
        f32x4 a0[NI], a1[NI];
#pragma unroll
        for (int q = 0; q < NI; ++q) { a0[q] = (f32x4){0.f, 0.f, 0.f, 0.f}; a1[q] = (f32x4){0.f, 0.f, 0.f, 0.f}; }
#pragma unroll 1
        for (int k0 = 0; k0 < KS; k0 += KB) {
            bf16x8 af[NI][KB], b0[NI][KB], b1[NI][KB];
#pragma unroll
            for (int q = 0; q < NI; ++q) { const int item = base + q, mt = item & 7, ng = item >> 3;
                const char* ap = (const char*)(A + (size_t)(MP + mt * 16) * K) + (size_t)k0 * 64; const char* bp = (const char*)(Bt + (size_t)(ng * 32) * K) + (size_t)k0 * 64;
#pragma unroll
                for (int ks = 0; ks < KB; ++ks) { af[q][ks] = *(const bf16x8*)(ap + ks * 64 + toff); b0[q][ks] = *(const bf16x8*)(bp + ks * 64 + tb0); b1[q][ks] = *(const bf16x8*)(bp + ks * 64 + tb1); } }
#pragma unroll
            for (int q = 0; q < NI; ++q)
#pragma unroll
                for (int ks = 0; ks < KB; ++ks) { a0[q] = __builtin_amdgcn_mfma_f32_16x16x32_bf16(b0[q][ks], af[q][ks], a0[q], 0, 0, 0); a1[q] = __builtin_amdgcn_mfma_f32_16x16x32_bf16(b1[q][ks], af[q][ks], a1[q], 0, 0, 0); }
        }
#pragma unroll
        for (int q = 0; q < NI; ++q) { red[((q * 8 + wid) * 2 + 0) * 64 + lane] = a0[q]; red[((q * 8 + wid) * 2 + 1) * 64 + lane] = a1[q]; }
        __syncthreads();
        if (wid < NI && base + wid < nitems) {
            f32x4 s0 = red[((wid * 8) * 2 + 0) * 64 + lane], s1 = red[((wid * 8) * 2 + 1) * 64 + lane];
#pragma unroll
            for (int w = 1; w < 8; ++w) { s0 += red[((wid * 8 + w) * 2 + 0) * 64 + lane]; s1 += red[((wid * 8 + w) * 2 + 1) * 64 + lane]; }
            const int item = base + wid, mt = item & 7, ng = item >> 3;
            if constexpr (KIND == EK_WO || KIND == EK_DN) small_fused<KIND>(c, mt, ng, lane, s0, s1);
            else { if constexpr (KIND == EK_UP) { const float f = ((const float*)(c.ws + WS_RS2S))[mt * 16 + fr]; s0 *= f; s1 *= f; }
                epi8<KIND>(c, MP + mt * 16 + fr, ng * 32 + 8 * fq, s0, s1); }
        }
        __syncthreads();
    }
    }
    }
}

__device__ __forceinline__ int map_in(int n) {
    if (n < 512) return 2 * n;
    if (n < 1024) return 2 * (n - 512) + 1;
    if (n < 2048) { const int base = n < 1536 ? 1024 : 1536, cc = n - base, h = cc >> 7, d = cc & 127; return base + h * 128 + 2 * (d & 63) + (d >> 6); }
    return n;
}
struct WItem { const float* W; bf16_t* WT; int K, N, r; bool mapin; const float* kscale; };
__device__ __forceinline__ void wt_load(const WItem& w, int lane, f32x4 (&v)[8]) {
    const int nblk = w.N / 32, kb = w.r / nblk, nb = w.r % nblk, k0 = 64 * kb, n0 = 32 * nb, kr = lane >> 3, seg = lane & 7;
    const float* wp = w.W + (size_t)(k0 + kr) * w.N + n0 + seg * 4;
#pragma unroll
    for (int i = 0; i < 8; ++i) v[i] = __builtin_nontemporal_load((const f32x4*)(wp + (size_t)(8 * i) * w.N));
}
__device__ __forceinline__ void wt_finish(const WItem& w, int lane, const f32x4 (&v)[8], LAS float* scr) {
    const int nblk = w.N / 32, kb = w.r / nblk, nb = w.r % nblk, k0 = 64 * kb, n0 = 32 * nb, kr = lane >> 3, seg = lane & 7;
#pragma unroll
    for (int i = 0; i < 8; ++i) { LAS float* d = scr + (8 * i + kr) * 33 + seg * 4; d[0] = v[i][0]; d[1] = v[i][1]; d[2] = v[i][2]; d[3] = v[i][3]; }
    LDS_WAIT();
    const int ch = lane & 7;
#pragma unroll
    for (int j = 0; j < 4; ++j) { const int n = (lane >> 3) + 8 * j; const LAS float* s = scr + (8 * ch) * 33 + n;
        f32x4 ga = {1.f, 1.f, 1.f, 1.f}, gb = {1.f, 1.f, 1.f, 1.f};
        if (w.kscale) { ga = *(const f32x4*)(w.kscale + k0 + 8 * ch); gb = *(const f32x4*)(w.kscale + k0 + 8 * ch + 4); }
        u32x4 o; o.x = pk2(s[0 * 33] * ga[0], s[1 * 33] * ga[1]); o.y = pk2(s[2 * 33] * ga[2], s[3 * 33] * ga[3]); o.z = pk2(s[4 * 33] * gb[0], s[5 * 33] * gb[1]); o.w = pk2(s[6 * 33] * gb[2], s[7 * 33] * gb[3]);
        const int dn = w.mapin ? map_in(n0 + n) : (n0 + n);
        *(u32x4*)(w.WT + (size_t)dn * w.K + k0 + 8 * ch) = o; }
    LDS_WAIT();
}
constexpr int WI_IN = (DM / 64) * (NIN / 32);
constexpr int WI_CO = (CD / 64) * (DM / 32), WI_RO = (DM / 64) * (DM / 32), WI_O = WI_RO, WI_UP = (DM / 64) * (FF / 32), WI_DN = (FF / 64) * (DM / 32);
constexpr int WI_TOTAL = WI_IN + WI_CO + WI_RO + WI_O + WI_UP + WI_DN;

__device__ __forceinline__ void wt_pair(const Ctx& c, int p, int lane, LAS float* scr) {
    int r = 2 * p; WItem w;
    if (r < WI_IN) { w.W = c.w_in; w.WT = (bf16_t*)(c.ws + WS_WIN); w.K = DM; w.N = NIN; w.mapin = true; w.kscale = nullptr; }
    else if ((r -= WI_IN) < WI_CO) { w.W = c.w_co; w.WT = (bf16_t*)(c.ws + WS_WCO); w.K = CD; w.N = DM; w.mapin = false; w.kscale = nullptr; }
    else if ((r -= WI_CO) < WI_RO) { w.W = c.w_ro; w.WT = (bf16_t*)(c.ws + WS_WRO); w.K = DM; w.N = DM; w.mapin = false; w.kscale = nullptr; }
    else if ((r -= WI_RO) < WI_O) { w.W = c.w_o; w.WT = (bf16_t*)(c.ws + WS_WO); w.K = DM; w.N = DM; w.mapin = false; w.kscale = nullptr; }
    else if ((r -= WI_O) < WI_UP) { w.W = c.w_up; w.WT = (bf16_t*)(c.ws + WS_WUP); w.K = DM; w.N = FF; w.mapin = false; w.kscale = c.n_ffn_pre; }
    else { r -= WI_UP; w.W = c.w_dn; w.WT = (bf16_t*)(c.ws + WS_WDN); w.K = FF; w.N = DM; w.mapin = false; w.kscale = nullptr; }
    WItem w1 = w; w.r = r; w1.r = r + 1;
    f32x4 va[8], vb[8];
    wt_load(w, lane, va); wt_load(w1, lane, vb);
    wt_finish(w, lane, va, scr); wt_finish(w1, lane, vb, scr);
}
__device__ __forceinline__ void rms_rows4_to_bf16(const Ctx& c, int row0, int stride, const float* w, bf16_t* XN, int lane) {
    f32x4 v[4][4];
#pragma unroll
    for (int r = 0; r < 4; ++r) { const int row = row0 + r * stride;
        if (row < RT) { const float* x = xrow(c, row);
#pragma unroll
            for (int j = 0; j < 4; ++j) v[r][j] = __builtin_nontemporal_load((const f32x4*)x + 64 * j + lane); } }
#pragma unroll
    for (int r = 0; r < 4; ++r) { const int row = row0 + r * stride;
        if (row < RT) { float s = 0.f;
#pragma unroll
            for (int j = 0; j < 4; ++j) s += (v[r][j].x * v[r][j].x + v[r][j].y * v[r][j].y) + (v[r][j].z * v[r][j].z + v[r][j].w * v[r][j].w);
            const float rs = 1.0f / sqrtf(wave_sum(s) * (1.0f / DM) + EPS);
#pragma unroll
            for (int j = 0; j < 4; ++j) { const f32x4 g = *((const f32x4*)w + 64 * j + lane);
                u32x2 p; p.x = pk2(v[r][j].x * rs * g.x, v[r][j].y * rs * g.y); p.y = pk2(v[r][j].z * rs * g.z, v[r][j].w * rs * g.w);
                *((u32x2*)(XN + (size_t)row * DM) + 64 * j + lane) = p; } } }
}
__device__ __forceinline__ void phase0(const Ctx& c, LAS unsigned char* lds) {
    const int tid = otid(), wid = __builtin_amdgcn_readfirstlane(tid >> 6), lane = tid & 63;
    if (blockIdx.x == 0 && tid < 64) {
        const float xi = (float)tid / 63.0f;
        const float p = (float)exp((double)xi * 9.210340371976184);
        ((float*)(c.ws + WS_CTL + 256))[tid] = 1.0f / p;
    }
    LAS float* scr = (LAS float*)(lds + wid * 16384);
    const int gw = blockIdx.x * 8 + wid, NGW = gridDim.x * 8;
    bf16_t* XN = (bf16_t*)c.out;
    for (int row = gw; row < RT; row += 4 * NGW) rms_rows4_to_bf16(c, row, NGW, c.n_mix_pre, XN, lane);
    for (int p = gw; p < WI_IN / 2; p += NGW) wt_pair(c, p, lane, scr);
}

__device__ __forceinline__ void ret_prompt_item(const Ctx& c, LAS unsigned char* lds, int item) {
    const int tid = otid(), wid = __builtin_amdgcn_readfirstlane(tid >> 6), lane = tid & 63, fr = lane & 15, fq = lane >> 4;
    const int s = item & 3, h = (item >> 2) & 3, b = item >> 4;
    const float l2g = log2f(1.0f - exp2f(-5.0f - (float)h));
    unsigned char* act = c.ws + WS_ACT;
    const bf16_t* Q = (const bf16_t*)(act + A_Q); const bf16_t* Kg = (const bf16_t*)(act + A_K); const bf16_t* V = (const bf16_t*)(act + A_V); bf16_t* OB = (bf16_t*)c.out;
    float* SSQ = (float*)(c.ws + WS_SSQ);
    constexpr int LD = 136;
    LAS bf16_t* sQ = (LAS bf16_t*)lds; LAS bf16_t* sK = sQ + 128 * LD; LAS bf16_t* sKT = sK + 128 * LD; LAS bf16_t* sVT = sKT + 128 * LD; LAS bf16_t* sST = sVT + 64 * LD;
    for (int i = tid; i < 64 * LD / 2; i += 512) ((LAS unsigned*)sST)[i] = 0u;
    f32x4 Sacc[4];
#pragma unroll
    for (int e = 0; e < 4; ++e) Sacc[e] = (f32x4){0.f, 0.f, 0.f, 0.f};
    const float gC = exp2f(128.0f * l2g);
    const int il = 16 * wid + fr;
    u32x4 rq[4], rk[4]; unsigned kv[16], vv[8]; u32x2 sgv[4], sgc[4];
    const bf16_t* SGp = (const bf16_t*)(act + A_SG);
    const int dp = tid & 63, ep = tid & 31, jgv = tid >> 5;
    const int jgk = wid;
    const unsigned toq = (unsigned)(((tid >> 4) * 512 + (tid & 15) * 8) * 2);
    const unsigned tok = (unsigned)(2 * dp * 2);
    const unsigned tov = (unsigned)(((jgv * 8) * 1024 + 2 * ep) * 2);
    const unsigned tosg = (unsigned)((il * 1024 + 4 * fq) * 2);
#define RET_LOAD(CH) do { const size_t r0_ = (size_t)b * SEQ + (size_t)(CH) * 128; \
        const char* qb_ = (const char*)(Q + r0_ * 512 + h * 128); const char* kb_ = (const char*)(Kg + r0_ * 512 + h * 128); \
        const char* kt_ = (const char*)(Kg + (r0_ + jgk * 16) * 512 + h * 128); const char* vb_ = (const char*)(V + r0_ * 1024 + h * 256 + s * 64); \
        _Pragma("unroll") for (int i = 0; i < 4; ++i) { rq[i] = *(const u32x4*)(qb_ + (size_t)i * 32768 + toq); rk[i] = *(const u32x4*)(kb_ + (size_t)i * 32768 + toq); } \
        _Pragma("unroll") for (int jj = 0; jj < 16; ++jj) kv[jj] = *(const unsigned*)(kt_ + (size_t)jj * 1024 + tok); \
        _Pragma("unroll") for (int jj = 0; jj < 8; ++jj) vv[jj] = *(const unsigned*)(vb_ + (size_t)jj * 2048 + tov); \
        const char* sg_ = (const char*)(SGp + r0_ * 1024 + h * 256 + s * 64); \
        _Pragma("unroll") for (int et = 0; et < 4; ++et) sgv[et] = *(const u32x2*)(sg_ + (size_t)et * 32 + tosg); } while (0)
    RET_LOAD(0);
    for (int ch = 0; ch < SEQ / 128; ++ch) {
        const size_t r0 = (size_t)b * SEQ + (size_t)ch * 128;
#pragma unroll
        for (int i = 0; i < 4; ++i) { const int id = tid + 512 * i, row = id >> 4, cq = id & 15;
            *(LAS u32x4*)(sQ + row * LD + cq * 8) = rq[i]; *(LAS u32x4*)(sK + row * LD + cq * 8) = rk[i]; }
        {
            unsigned lo[8], hi[8];
#pragma unroll
            for (int jj = 0; jj < 16; jj += 2) {
                const float d0 = exp2f((float)(127 - (jgk * 16 + jj)) * l2g), d1 = exp2f((float)(127 - (jgk * 16 + jj + 1)) * l2g);
                lo[jj >> 1] = pk2(bflo(kv[jj]) * d0, bflo(kv[jj + 1]) * d1); hi[jj >> 1] = pk2(bfhi(kv[jj]) * d0, bfhi(kv[jj + 1]) * d1);
            }
            LAS u32x4* p0 = (LAS u32x4*)(sKT + (2 * dp) * LD + jgk * 16); LAS u32x4* p1 = (LAS u32x4*)(sKT + (2 * dp + 1) * LD + jgk * 16);
            p0[0] = (u32x4){lo[0], lo[1], lo[2], lo[3]}; p0[1] = (u32x4){lo[4], lo[5], lo[6], lo[7]};
            p1[0] = (u32x4){hi[0], hi[1], hi[2], hi[3]}; p1[1] = (u32x4){hi[4], hi[5], hi[6], hi[7]};
        }
        {
            u32x4 lo, hi;
            lo.x = (vv[0] & 0xffffu) | (vv[1] << 16); lo.y = (vv[2] & 0xffffu) | (vv[3] << 16); lo.z = (vv[4] & 0xffffu) | (vv[5] << 16); lo.w = (vv[6] & 0xffffu) | (vv[7] << 16);
            hi.x = (vv[0] >> 16) | (vv[1] & 0xffff0000u); hi.y = (vv[2] >> 16) | (vv[3] & 0xffff0000u); hi.z = (vv[4] >> 16) | (vv[5] & 0xffff0000u); hi.w = (vv[6] >> 16) | (vv[7] & 0xffff0000u);
            *(LAS u32x4*)(sVT + (2 * ep) * LD + jgv * 8) = lo; *(LAS u32x4*)(sVT + (2 * ep + 1) * LD + jgv * 8) = hi;
        }
#pragma unroll
        for (int et = 0; et < 4; ++et) sgc[et] = sgv[et];
        if (ch + 1 < SEQ / 128) RET_LOAD(ch + 1);
        __syncthreads();
        bf16x8 qf[4];
#pragma unroll
        for (int ks = 0; ks < 4; ++ks) qf[ks] = *(const LAS bf16x8*)(sQ + il * LD + ks * 32 + fq * 8);
        f32x4 sc[8];
#pragma unroll
        for (int jp = 0; jp < 8; jp += 2) {
            bf16x8 kf[2][4];
#pragma unroll
            for (int t = 0; t < 2; ++t)
#pragma unroll
                for (int ks = 0; ks < 4; ++ks) kf[t][ks] = *(const LAS bf16x8*)(sK + ((jp + t) * 16 + fr) * LD + ks * 32 + fq * 8);
#pragma unroll
            for (int t = 0; t < 2; ++t) { sc[jp + t] = (f32x4){0.f, 0.f, 0.f, 0.f};
#pragma unroll
                for (int ks = 0; ks < 4; ++ks) sc[jp + t] = __builtin_amdgcn_mfma_f32_16x16x32_bf16(kf[t][ks], qf[ks], sc[jp + t], 0, 0, 0); }
        }
        __syncthreads();
#pragma unroll
        for (int jt = 0; jt < 8; ++jt) { float pv[4];
#pragma unroll
            for (int jj = 0; jj < 4; ++jj) { const int df = il - (jt * 16 + 4 * fq + jj); pv[jj] = df >= 0 ? sc[jt][jj] * exp2f((float)df * l2g) : 0.f; }
            u32x2 w; w.x = pk2(pv[0], pv[1]); w.y = pk2(pv[2], pv[3]);
            *(LAS u32x2*)(sK + il * LD + jt * 16 + 4 * fq) = w; }
        LDS_WAIT(); __builtin_amdgcn_wave_barrier();
        f32x4 o[4];
#pragma unroll
        for (int ep2 = 0; ep2 < 4; ep2 += 2) {
            bf16x8 sf[2][4];
#pragma unroll
            for (int t = 0; t < 2; ++t)
#pragma unroll
                for (int ks = 0; ks < 4; ++ks) sf[t][ks] = *(const LAS bf16x8*)(sST + ((ep2 + t) * 16 + fr) * LD + ks * 32 + fq * 8);
#pragma unroll
            for (int t = 0; t < 2; ++t) { o[ep2 + t] = (f32x4){0.f, 0.f, 0.f, 0.f};
#pragma unroll
                for (int ks = 0; ks < 4; ++ks) o[ep2 + t] = __builtin_amdgcn_mfma_f32_16x16x32_bf16(sf[t][ks], qf[ks], o[ep2 + t], 0, 0, 0); }
        }
        const float qd = exp2f((float)(il + 1) * l2g);
#pragma unroll
        for (int et = 0; et < 4; ++et) { o[et] *= qd; Sacc[et] *= gC; }
#pragma unroll
        for (int k2 = 0; k2 < 4; k2 += 2) {
            bf16x8 pf[2], kf[2], vf[2][4];
#pragma unroll
            for (int t = 0; t < 2; ++t) { const int ks = k2 + t;
                pf[t] = *(const LAS bf16x8*)(sK + il * LD + ks * 32 + fq * 8); kf[t] = *(const LAS bf16x8*)(sKT + il * LD + ks * 32 + fq * 8);
#pragma unroll
                for (int et = 0; et < 4; ++et) vf[t][et] = *(const LAS bf16x8*)(sVT + (et * 16 + fr) * LD + ks * 32 + fq * 8); }
#pragma unroll
            for (int t = 0; t < 2; ++t)
#pragma unroll
                for (int et = 0; et < 4; ++et) { o[et] = __builtin_amdgcn_mfma_f32_16x16x32_bf16(vf[t][et], pf[t], o[et], 0, 0, 0);
                    Sacc[et] = __builtin_amdgcn_mfma_f32_16x16x32_bf16(kf[t], vf[t][et], Sacc[et], 0, 0, 0); }
        }
        float ss = 0.f;
#pragma unroll
        for (int et = 0; et < 4; ++et) { ss += (o[et][0] * o[et][0] + o[et][1] * o[et][1]) + (o[et][2] * o[et][2] + o[et][3] * o[et][3]);
            const float g0 = bflo(sgc[et].x), g1 = bfhi(sgc[et].x), g2 = bflo(sgc[et].y), g3 = bfhi(sgc[et].y);
            u32x2 w; w.x = pk2(o[et][0] * g0 * sigm(g0), o[et][1] * g1 * sigm(g1)); w.y = pk2(o[et][2] * g2 * sigm(g2), o[et][3] * g3 * sigm(g3));
            *(u32x2*)(OB + (r0 + il) * 1024 + h * 256 + s * 64 + et * 16 + 4 * fq) = w; }
        ss += __shfl_xor(ss, 16); ss += __shfl_xor(ss, 32);
        if (fq == 0) SSQ[(r0 + il) * 16 + h * 4 + s] = ss;
        __syncthreads();
#pragma unroll
        for (int et = 0; et < 4; ++et) { u32x2 w; w.x = pk2(Sacc[et][0], Sacc[et][1]); w.y = pk2(Sacc[et][2], Sacc[et][3]);
            *(LAS u32x2*)(sST + (et * 16 + fr) * LD + 16 * wid + 4 * fq) = w; }
    }
    float* nrp = c.out + O_NRP + ((size_t)(b * NH + h) * DK) * DV + s * 64;
#pragma unroll
    for (int et = 0; et < 4; ++et)
#pragma unroll
        for (int jj = 0; jj < 4; ++jj) nrp[(size_t)(16 * wid + 4 * fq + jj) * DV + et * 16 + fr] = Sacc[et][jj];
    __syncthreads();
#undef RET_LOAD
}

__device__ __forceinline__ float block_sum(float v, LAS float* red, int tid) {
    v = wave_sum(v);
    __syncthreads();
    if ((tid & 63) == 0) red[tid >> 6] = v;
    __syncthreads();
    float t = 0.f;
#pragma unroll
    for (int w = 0; w < 8; ++w) t += red[w];
    return t;
}

__device__ __forceinline__ void ret_sample_item(const Ctx& c, LAS unsigned char* lds, int item) {
    const int tid = otid(), b = item >> 2, h = item & 3, row = MP + b;
    unsigned char* act = c.ws + WS_ACT;
    const bf16_t* Q = (const bf16_t*)(act + A_Q) + (size_t)row * 512 + h * 128; const bf16_t* Kg = (const bf16_t*)(act + A_K) + (size_t)row * 512 + h * 128;
    const bf16_t* V = (const bf16_t*)(act + A_V) + (size_t)row * 1024 + h * 256; bf16_t* OB = (bf16_t*)c.out + (size_t)row * 1024 + h * 256;
    LAS float* sq = (LAS float*)lds; LAS float* sk = sq + 128; LAS float* red = sk + 128; LAS float* part = red + 16;
    if (tid < 128) sq[tid] = bf2f(Q[tid]); else if (tid < 256) sk[tid - 128] = bf2f(Kg[tid - 128]);
    __syncthreads();
    const float g = 1.0f - exp2f(-5.0f - (float)h);
    const int e4 = (tid & 63) * 4, dg = tid >> 6;
    const u32x2 vw = *(const u32x2*)(V + e4);
    const f32x4 vv = {bflo(vw.x), bfhi(vw.x), bflo(vw.y), bfhi(vw.y)};
    const float* Sin = c.state_ret + ((size_t)(b * NH + h) * DK + dg * 16) * DV + e4;
    float* Sout = c.out + O_NRS + ((size_t)(b * NH + h) * DK + dg * 16) * DV + e4;
    f32x4 oa = {0.f, 0.f, 0.f, 0.f};
    f32x4 sv[16];
#pragma unroll
    for (int dd = 0; dd < 16; ++dd) sv[dd] = __builtin_nontemporal_load((const f32x4*)(Sin + (size_t)dd * DV));
#pragma unroll
    for (int dd = 0; dd < 16; ++dd) { const float kd = sk[dg * 16 + dd], qd = sq[dg * 16 + dd];
        const f32x4 sn = sv[dd] * g + vv * kd; __builtin_nontemporal_store(sn, (f32x4*)(Sout + (size_t)dd * DV)); oa += sn * qd; }
    *(LAS f32x4*)(part + dg * 256 + e4) = oa;
    __syncthreads();
    float ov = 0.f;
    if (tid < 256) {
#pragma unroll
        for (int w = 0; w < 8; ++w) ov += part[w * 256 + tid];
    }
    const float tot = block_sum(ov * ov, red, tid);
    const float rs = 1.0f / sqrtf(tot * (1.0f / DV) + EPS);
    if (tid < 256) { const float g = bf2f(((const bf16_t*)(act + A_SG))[(size_t)row * 1024 + h * 256 + tid]); OB[tid] = (bf16_t)(pk2(g * sigm(g) * ov * rs, 0.f) & 0xffffu); }
    __syncthreads();
}

__device__ __forceinline__ void conv_prompt_item(const Ctx& c, LAS unsigned char* lds, int item) {
    const int tid = otid(), wid = tid >> 6, lane = tid & 63, b = item >> 6, t0 = (item & 63) * 32;
    unsigned char* act = c.ws + WS_ACT;
    const bf16_t* U = (const bf16_t*)(act + A_U) + (size_t)b * SEQ * 512; bf16_t* AA = (bf16_t*)(act + A_AACT) + (size_t)b * SEQ * 512;
    LAS bf16_t* sU = (LAS bf16_t*)lds; LAS float* sC = (LAS float*)(lds + 63488);
    {
        u32x4 uv[8];
#pragma unroll
        for (int i = 0; i < 8; ++i) { const int id = tid + 512 * i, lr = id >> 6, cq = id & 63, t = t0 - 30 + lr;
            uv[i] = (u32x4){0u, 0u, 0u, 0u}; if (t >= 0 && lr < 62) uv[i] = __builtin_nontemporal_load((const u32x4*)(U + (size_t)t * 512 + cq * 8)); }
#pragma unroll
        for (int i = 0; i < 8; ++i) { const int id = tid + 512 * i, lr = id >> 6, cq = id & 63;
            if (lr < 62) *(LAS u32x4*)(sU + lr * 512 + cq * 8) = uv[i]; }
    }
    float wreg[CW];
#pragma unroll
    for (int w = 0; w < CW; ++w) wreg[w] = c.w_dw[w * CD + tid];
    const float bias = c.b_dw[tid];
    __syncthreads();
#pragma unroll 1
    for (int tb = 0; tb < 4; ++tb) {
        float a[8];
#pragma unroll
        for (int o = 0; o < 8; ++o) a[o] = bias;
#pragma unroll
        for (int k = 0; k < 38; ++k) { const float u = bf2f(sU[(tb * 8 + k) * 512 + tid]);
#pragma unroll
            for (int o = 0; o < 8; ++o) { const int w = k - o; if (w >= 0 && w < CW) a[o] += u * wreg[w]; } }
#pragma unroll
        for (int o = 0; o < 8; ++o) sC[(tb * 8 + o) * 512 + tid] = a[o];
    }
    __syncthreads();
    const f32x4 g0 = *(const f32x4*)(c.ln_w + lane * 4), g1 = *(const f32x4*)(c.ln_w + 256 + lane * 4), b0 = *(const f32x4*)(c.ln_b + lane * 4), b1 = *(const f32x4*)(c.ln_b + 256 + lane * 4);
    for (int rr = wid; rr < 32; rr += 8) {
        f32x4 x0 = *(const LAS f32x4*)(sC + rr * 512 + lane * 4), x1 = *(const LAS f32x4*)(sC + rr * 512 + 256 + lane * 4);
        const float mean = wave_sum((x0.x + x0.y) + (x0.z + x0.w) + (x1.x + x1.y) + (x1.z + x1.w)) * (1.0f / CD);
        x0 -= mean; x1 -= mean;
        const float var = wave_sum((x0.x * x0.x + x0.y * x0.y) + (x0.z * x0.z + x0.w * x0.w) + (x1.x * x1.x + x1.y * x1.y) + (x1.z * x1.z + x1.w * x1.w)) * (1.0f / CD);
        const float rstd = 1.0f / sqrtf(var + EPS);
        f32x4 y0 = x0 * rstd * g0 + b0, y1 = x1 * rstd * g1 + b1;
#pragma unroll
        for (int j = 0; j < 4; ++j) { y0[j] = y0[j] * sigm(y0[j]); y1[j] = y1[j] * sigm(y1[j]); }
        u32x2 w0, w1; w0.x = pk2(y0.x, y0.y); w0.y = pk2(y0.z, y0.w); w1.x = pk2(y1.x, y1.y); w1.y = pk2(y1.z, y1.w);
        bf16_t* dst = AA + (size_t)(t0 + rr) * 512;
        *(u32x2*)(dst + lane * 4) = w0; *(u32x2*)(dst + 256 + lane * 4) = w1;
    }
    if (t0 == SEQ - 32) {
        float* ncp = c.out + O_NCP + (size_t)b * 30 * CD;
        for (int id = tid; id < 30 * CD; id += 512) ncp[id] = bf2f(sU[(32 + (id >> 9)) * 512 + (id & 511)]);
    }
    __syncthreads();
}

__device__ __forceinline__ void conv_sample_item(const Ctx& c, LAS unsigned char* lds, int b) {
    const int tid = otid();
    unsigned char* act = c.ws + WS_ACT;
    LAS float* red = (LAS float*)lds;
    const float* cache = c.cache_conv + (size_t)b * 30 * CD; float* ncs = c.out + O_NCS + (size_t)b * 30 * CD;
    float acc = c.b_dw[tid];
#pragma unroll 1
    for (int w0 = 0; w0 < 30; w0 += 10) {
        float cv[10], wv[10];
#pragma unroll
        for (int w = 0; w < 10; ++w) { cv[w] = __builtin_nontemporal_load(cache + (w0 + w) * CD + tid); wv[w] = c.w_dw[(w0 + w) * CD + tid]; }
#pragma unroll
        for (int w = 0; w < 10; ++w) { acc += cv[w] * wv[w]; if (w0 + w >= 1) __builtin_nontemporal_store(cv[w], ncs + (w0 + w - 1) * CD + tid); }
    }
    const float u = bf2f(((const bf16_t*)(act + A_U))[(size_t)(MP + b) * 512 + tid]);
    acc += u * c.w_dw[30 * CD + tid]; ncs[29 * CD + tid] = u;
    const float mean = block_sum(acc, red, tid) * (1.0f / CD);
    const float d = acc - mean;
    const float var = block_sum(d * d, red, tid) * (1.0f / CD);
    float y = d * (1.0f / sqrtf(var + EPS)) * c.ln_w[tid] + c.ln_b[tid];
    y = y * sigm(y);
    ((bf16_t*)(act + A_AACT))[(size_t)(MP + b) * 512 + tid] = (bf16_t)(pk2(y, 0.f) & 0xffffu);
    __syncthreads();
}

__device__ __forceinline__ void phase2(const Ctx& c, LAS unsigned char* lds, int rep) {
    for (int it = blockIdx.x; it < NB * NH * 4; it += gridDim.x) { const int x = it & 7, j = it >> 3; ret_prompt_item(c, lds, (x * 4 + (j >> 2)) * 4 + (j & 3)); }
    unsigned* counter = (unsigned*)(c.ws + WS_CTL) + rep;
    LAS int* sItem = (LAS int*)(lds + LDS_BYTES - 16);
    constexpr int N_CONV = MP / 32, N_RS = MS * NH, N_CS = MS, N_WQ = (WI_TOTAL - WI_IN) / 16, NTOT = N_CONV + N_RS + N_CS + N_WQ;
    static_assert((WI_TOTAL - WI_IN) % 16 == 0, "weight queue items");
    unsigned nxt = 0u;
    if (threadIdx.x == 0) nxt = atomicAdd(counter, 1u);
    for (;;) {
        if (threadIdx.x == 0) { *sItem = (int)nxt; nxt = atomicAdd(counter, 1u); }
        __syncthreads();
        const int it = __builtin_amdgcn_readfirstlane(*sItem);
        __syncthreads();
        if (it >= NTOT) break;
        if (it < N_CS) conv_sample_item(c, lds, it);
        else if (it < N_CS + N_CONV) conv_prompt_item(c, lds, it - N_CS);
        else if (it < N_CS + N_CONV + N_RS) ret_sample_item(c, lds, it - N_CS - N_CONV);
        else { const int t_ = otid(); const int wv = __builtin_amdgcn_readfirstlane(t_ >> 6);
            wt_pair(c, WI_IN / 2 + (it - N_CS - N_CONV - N_RS) * 8 + wv, t_ & 63, (LAS float*)(lds + wv * 16384)); __syncthreads(); }
    }
}

__device__ __forceinline__ void phase2b(const Ctx& c) {
    const int t_ = otid(); const int lane = t_ & 63, gw = blockIdx.x * 8 + (t_ >> 6), NGW = gridDim.x * 8;
    unsigned char* act = c.ws + WS_ACT;
    const float* SSQ = (const float*)(c.ws + WS_SSQ);
    for (int row0 = gw; row0 < RT; row0 += 4 * NGW) {
        u32x4 a[4][2], o[4][2]; float rs[4];
#pragma unroll
        for (int r = 0; r < 4; ++r) { const int row = row0 + r * NGW; rs[r] = 1.0f;
            if (row < RT) {
                const u32x4* sg = (const u32x4*)((bf16_t*)(act + A_SG) + (size_t)row * 1024 + lane * 16);
                const u32x4* ov = (const u32x4*)((const bf16_t*)c.out + (size_t)row * 1024 + lane * 16);
#pragma unroll
                for (int j = 0; j < 2; ++j) { a[r][j] = __builtin_nontemporal_load(sg + j); o[r][j] = __builtin_nontemporal_load(ov + j); }
                if (row < MP) { const f32x4 q = *(const f32x4*)(SSQ + (size_t)row * 16 + (lane >> 4) * 4); rs[r] = 1.0f / sqrtf(((q.x + q.y) + (q.z + q.w)) * (1.0f / DV) + EPS); }
            } }
#pragma unroll
        for (int r = 0; r < 4; ++r) { const int row = row0 + r * NGW;
            if (row < RT) { u32x4* dg = (u32x4*)((bf16_t*)(act + A_SG) + (size_t)row * 1024 + lane * 16); const float k = rs[r];
#pragma unroll
                for (int j = 0; j < 2; ++j) { const u32x4 x = a[r][j], y = o[r][j]; u32x4 w;
                    w.x = pk2(bflo(x.x) * bflo(y.x) * k, bfhi(x.x) * bfhi(y.x) * k); w.y = pk2(bflo(x.y) * bflo(y.y) * k, bfhi(x.y) * bfhi(y.y) * k);
                    w.z = pk2(bflo(x.z) * bflo(y.z) * k, bfhi(x.z) * bfhi(y.z) * k); w.w = pk2(bflo(x.w) * bflo(y.w) * k, bfhi(x.w) * bfhi(y.w) * k);
                    dg[j] = w; } } }
    }
}


#define XB_TMO      128
#define XB_XCNT(j)  (256  + 64 * (j))
#define XB_XSUB(j)  (1280 + 64 * (j))
#define XB_XGEN(j)  (2304 + 64 * (j))
#define XB_TOP      3328
#define XB_TOPGEN   3392
#define XCD_BAR_WORDS 3456
#define XB_SPIN_CAP (1u << 22)
__device__ __forceinline__ unsigned xb_ld(unsigned* p)              { return __hip_atomic_load(p, __ATOMIC_RELAXED, __HIP_MEMORY_SCOPE_AGENT); }
__device__ __forceinline__ unsigned xb_add(unsigned* p, unsigned v) { return __hip_atomic_fetch_add(p, v, __ATOMIC_RELAXED, __HIP_MEMORY_SCOPE_AGENT); }
__device__ __forceinline__ unsigned xb_xcc_id() { return (unsigned)__builtin_amdgcn_s_getreg((3 << 11) | 20) & 0xFu; }
#define XB_SPIN(cond, bar) do { unsigned _sp = 0; while (cond) { __builtin_amdgcn_s_sleep(1); \
    if ((++_sp & 255u) == 0u) { if (xb_ld(&(bar)[XB_TMO])) break; if (_sp > XB_SPIN_CAP) { atomicAdd(&(bar)[XB_TMO], 1u); break; } } } } while (0)
struct XcdBarrier { unsigned* bar; unsigned x; volatile LAS unsigned* st; };
__device__ __forceinline__ XcdBarrier xcd_barrier_post(unsigned* bar, volatile LAS unsigned* st) {
    XcdBarrier b; b.bar = bar; b.x = xb_xcc_id(); b.st = st;
    if (threadIdx.x == 0) (void)xb_add(&bar[XB_XCNT(b.x)], 1u);
    return b;
}
__device__ __forceinline__ void xcd_barrier_complete(unsigned* bar, unsigned x, unsigned& nloc, unsigned& nx) {
    const unsigned G = gridDim.x * gridDim.y * gridDim.z;
    unsigned sum, cnt, mine, sp = 0u;
    for (;;) {
        sum = 0u; cnt = 0u; mine = 0u;
#pragma unroll
        for (unsigned j = 0; j < 16; ++j) { const unsigned c = xb_ld(&bar[XB_XCNT(j)]); sum += c; cnt += (c > 0u) ? 1u : 0u; mine = (j == x) ? c : mine; }
        if (sum == G) break;
        __builtin_amdgcn_s_sleep(1);
        if ((++sp & 255u) == 0u) { if (xb_ld(&bar[XB_TMO])) break; if (sp > XB_SPIN_CAP) { atomicAdd(&bar[XB_TMO], 1u); break; } }
    }
    nloc = mine > 0u ? mine : 1u; nx = cnt > 0u ? cnt : 1u;
}
__device__ __forceinline__ void xcd_barrier(const XcdBarrier& b) {
    asm volatile("s_waitcnt vmcnt(0)" ::: "memory");
    __syncthreads();
    if (threadIdx.x == 0) {
        unsigned* bar = b.bar;
        __builtin_amdgcn_s_waitcnt(0);
        unsigned nloc = b.st[0], nx = b.st[1];
        if (nloc == 0u) { xcd_barrier_complete(bar, b.x, nloc, nx); b.st[0] = nloc; b.st[1] = nx; }
        const unsigned old = xb_add(&bar[XB_XSUB(b.x)], 1u);
        const unsigned gen = old / nloc;
        if (old + 1u == (gen + 1u) * nloc) {
            __builtin_amdgcn_fence(__ATOMIC_RELEASE, "agent");
            asm volatile("s_waitcnt vmcnt(0)" ::: "memory");
            const unsigned og = xb_add(&bar[XB_TOP], 1u);
            const unsigned tg = og / nx;
            if (og + 1u == (tg + 1u) * nx) xb_add(&bar[XB_TOPGEN], 1u);
            else XB_SPIN(xb_ld(&bar[XB_TOPGEN]) == tg, bar);
            __builtin_amdgcn_fence(__ATOMIC_ACQUIRE, "agent");
            xb_add(&bar[XB_XGEN(b.x)], 1u);
            asm volatile("s_waitcnt vmcnt(0)" ::: "memory");
        } else {
            XB_SPIN(xb_ld(&bar[XB_XGEN(b.x)]) == gen, bar);
            __builtin_amdgcn_fence(__ATOMIC_ACQUIRE, "agent");
            asm volatile("s_waitcnt vmcnt(0)" ::: "memory");
        }
    }
    __syncthreads();
}

__global__ void __launch_bounds__(512) fwd_megakernel(Ctx c) {
    extern __shared__ __attribute__((aligned(16))) unsigned char smem[];
    LAS unsigned char* lds = (LAS unsigned char*)smem;
    cg::grid_group grid = cg::this_grid();
    unsigned char* act = c.ws + WS_ACT;
    volatile LAS unsigned* xst = (volatile LAS unsigned*)(lds + LDS_BYTES - 32);
    if (threadIdx.x == 0) { xst[0] = 0u; xst[1] = 0u; }
    __syncthreads();
    const XcdBarrier xb = xcd_barrier_post((unsigned*)(c.ws + WS_BAR), xst);
    phase0(c, lds);
    if (c.ws == nullptr) grid.sync();
    xcd_barrier(xb);
    gemm_all<EK_IN, NIN, DM, 3, Epi<EK_IN>, true>(c, lds, (const bf16_t*)c.out, (const bf16_t*)(c.ws + WS_WIN));
    xcd_barrier(xb);
    phase2(c, lds, 0);
    xcd_barrier(xb);
    gemm_all<EK_CO, DM, CD, 1, Epi<EK_CO>, true>(c, lds, (const bf16_t*)(act + A_AACT), (const bf16_t*)(c.ws + WS_WCO));
    gemm_all<EK_RO, DM, DM, 1, Epi<EK_RO>, true, true>(c, lds, (const bf16_t*)c.out, (const bf16_t*)(c.ws + WS_WRO));
    xcd_barrier(xb);
    gemm_all<EK_WO, DM, DM, 1, EpiWoFused>(c, lds, (const bf16_t*)(act + A_SB), (const bf16_t*)(c.ws + WS_WO));
    xcd_barrier(xb);
    gemm_all<EK_UP, FF, DM, 4, Epi<EK_UP>, true, false, true>(c, lds, (const bf16_t*)(act + A_M2), (const bf16_t*)(c.ws + WS_WUP));
    xcd_barrier(xb);
    gemm_all<EK_DN, DM, FF, 1, EpiDnFused>(c, lds, (const bf16_t*)(act + A_UP), (const bf16_t*)(c.ws + WS_WDN));
}

extern "C" void kernel_launch(void* const* d_in, const int* in_sizes, int n_in, void* d_out, int out_size, void* d_ws, size_t ws_size, hipStream_t stream) {
    static int grid_blocks = 0;
    if (!grid_blocks) {
        if (n_in != 18 || ws_size < WS_END3) { fprintf(stderr, "kernel_launch: unexpected n_in %d / ws_size %zu (need %zu)\n", n_in, ws_size, (size_t)WS_END3); grid_blocks = -1; return; }
        int dev = 0, cus = 0, per_cu = 0;
        hipGetDevice(&dev);
        hipDeviceGetAttribute(&cus, hipDeviceAttributeMultiprocessorCount, dev);
        if (hipFuncSetAttribute((const void*)fwd_megakernel, hipFuncAttributeMaxDynamicSharedMemorySize, LDS_BYTES) != hipSuccess) fprintf(stderr, "kernel_launch: hipFuncSetAttribute failed\n");
        hipOccupancyMaxActiveBlocksPerMultiprocessor(&per_cu, (const void*)fwd_megakernel, 512, LDS_BYTES);
        (void)hipGetLastError();
        if (per_cu < 1) { fprintf(stderr, "kernel_launch: occupancy query says %d blocks per CU\n", per_cu); per_cu = 1; }
        grid_blocks = cus * per_cu; if (grid_blocks > 256) grid_blocks = 256;
    }
    if (grid_blocks < 0) return;
    (void)hipMemsetAsync((char*)d_ws + WS_CTL, 0, CTL_ZERO, stream);
    Ctx c{};
    const float** f = (const float**)&c;
    for (int i = 0; i < 18; ++i) f[i] = (const float*)d_in[i];
    c.out = (float*)d_out; c.ws = (unsigned char*)d_ws;
    void* args[] = {&c};
    hipError_t e = hipLaunchCooperativeKernel((const void*)fwd_megakernel, dim3(grid_blocks), dim3(512), args, LDS_BYTES, stream);
    if (e != hipSuccess) fprintf(stderr, "cooperative launch failed: %s (grid %d)\n", hipGetErrorString(e), grid_blocks);
}
```

```cpp
#include <hip/hip_runtime.h>
#include <hip/hip_cooperative_groups.h>
#include <cstdio>
#include <cstdint>
namespace cg = cooperative_groups;

#define LAS __attribute__((address_space(3)))
typedef unsigned short bf16_t;
typedef short bf16x8 __attribute__((ext_vector_type(8)));
typedef float f32x4 __attribute__((ext_vector_type(4)));
typedef unsigned u32x4 __attribute__((ext_vector_type(4)));
typedef unsigned u32x2 __attribute__((ext_vector_type(2)));

constexpr int DM = 1024, NB = 8, SEQ = 2048, MP = NB * SEQ  , MS = 128, RT = MP + MS  ;
constexpr int CD = 512, CW = 31, NH = 4, DK = 128, DV = 256, FF = 4096, NIN = 6144;
constexpr float EPS = 1e-6f;
constexpr size_t O_NCP = (size_t)RT * DM;
constexpr size_t O_NRP = O_NCP + (size_t)NB * 30 * CD;
constexpr size_t O_NCS = O_NRP + (size_t)NB * NH * DK * DV;
constexpr size_t O_NRS = O_NCS + (size_t)MS * 30 * CD;
constexpr size_t WS_CTL = 0, WS_BAR = 4096, WS_WIN = 131072, WS_WCO = WS_WIN + (size_t)NIN * DM * 2, WS_WRO = WS_WCO + (size_t)DM * CD * 2,
                 WS_WO = WS_WRO + (size_t)DM * DM * 2, WS_WUP = WS_WO + (size_t)DM * DM * 2, WS_WDN = WS_WUP + (size_t)FF * DM * 2,
                 WS_ACT = WS_WDN + (size_t)FF * DM * 2;
constexpr size_t A_U = 0, A_Q = A_U + (size_t)RT * 512 * 2, A_K = A_Q + (size_t)RT * 512 * 2, A_V = A_K + (size_t)RT * 512 * 2,
                 A_SG = A_V + (size_t)RT * 1024 * 2, A_SA = A_SG + (size_t)RT * 1024 * 2, A_SB = A_SA + (size_t)RT * 1024 * 2,
                 A_AACT = A_SB + (size_t)RT * 1024 * 2, A_END = A_AACT + (size_t)RT * 512 * 2;
constexpr size_t A_M2 = (size_t)RT * 1024 * 2  , A_HN = 0  , A_F = 0  , A_UP = (size_t)RT * 1024 * 4;
static_assert(A_UP + (size_t)RT * FF * 2 <= A_END, "act region");
constexpr size_t WS_SSQ = WS_ACT + A_END, WS_END = WS_SSQ + (size_t)MP * 16 * 4;
constexpr size_t WS_XCH = WS_END;
constexpr size_t WS_XCHS = WS_XCH + 3 * 64 * 256 * 4 * 4;
constexpr size_t WS_END2 = WS_XCHS + 3 * 8 * 16 * 32 * 4;
constexpr size_t CTL_XCNT = 20480;
constexpr size_t CTL_XCNTS = CTL_XCNT + 3 * 64 * 256;
constexpr size_t CTL_ZERO = CTL_XCNTS + 3 * 8 * 256;
static_assert(CTL_ZERO <= WS_WIN, "control words");
constexpr size_t WS_RS2S = WS_END2;
constexpr size_t WS_END3 = WS_RS2S + 128 * 4;
constexpr int LDS_BYTES = 147456;

struct Ctx {
    const float *xp, *xs, *cache_conv, *state_ret, *n_mix_pre, *n_mix_post, *w_in, *w_dw, *b_dw, *ln_w, *ln_b, *w_co, *w_ro, *w_o,
        *n_ffn_pre, *n_ffn_post, *w_up, *w_dn;
    float* out; unsigned char* ws;
};

__device__ __forceinline__ unsigned pk2(float lo, float hi) { unsigned r; asm volatile("v_cvt_pk_bf16_f32 %0, %1, %2" : "=v"(r) : "v"(lo), "v"(hi)); return r; }
__device__ __forceinline__ float bflo(unsigned w) { return __uint_as_float(w << 16); }
__device__ __forceinline__ float bfhi(unsigned w) { return __uint_as_float(w & 0xffff0000u); }
__device__ __forceinline__ float bf2f(bf16_t b) { return __uint_as_float(((unsigned)b) << 16); }
__device__ __forceinline__ float sigm(float x) { return __builtin_amdgcn_rcpf(1.0f + __expf(-x)); }
__device__ __forceinline__ float wave_sum(float v) {
#pragma unroll
    for (int o = 1; o < 64; o <<= 1) v += __shfl_xor(v, o);
    return v;
}
#define LDS_WAIT() asm volatile("s_waitcnt lgkmcnt(0)" ::: "memory")
__device__ __forceinline__ int otid() { int t = threadIdx.x; asm volatile("" : "+v"(t)); return t; }
__device__ __forceinline__ const float* xrow(const Ctx& c, int row) { return row < MP ? c.xp + (size_t)row * DM : c.xs + (size_t)(row - MP) * DM; }

namespace pg8 {
constexpr int BM = 256, BK = 64, HALF = 128, HTB = HALF * BK * 2, STAGE_BYTES = 8 * HTB, NXCD = 8, WGM = 8;
__host__ __device__ __forceinline__ int lds_byte(int r, int c) { const int st = (r >> 4) * 2 + (c >> 5), rr = r & 15, cc = c & 31, ob = rr * 64 + cc * 2; return st * 1024 + (ob ^ (((ob >> 9) & 1) << 5)); }
__host__ __device__ __forceinline__ void stage_rc(int b, int& R, int& C) { const int st = b / 1024, sb = b % 1024, swz = sb ^ (((sb >> 9) & 1) << 5); R = (st >> 1) * 16 + swz / 64; C = (st & 1) * 32 + (swz % 64) / 2; }
__host__ __device__ __forceinline__ int perm32(int rho) { const int n = rho >> 4, i = rho & 15; return 8 * (i >> 2) + 4 * n + (i & 3); }
struct Unit { int pm, pn; };
struct Gemm { const bf16_t* A; const bf16_t* Bt; int M, N, K; const float* ssq = nullptr; };
struct StaticOrder {
    int nM, nN, nwg, G, c;
    __device__ void init(int M, int N, int G_, int c_) { nM = M / BM; nN = N / BM; nwg = nM * nN; G = G_; c = c_; }
    __device__ bool next(int i, Unit& u) const {
        const long L = (long)i * G + c; if (L >= nwg) return false;
        int wgid = (int)L; { const int q = nwg / NXCD, r = nwg % NXCD, xcd = wgid % NXCD, off = wgid / NXCD; wgid = (xcd < r ? xcd * (q + 1) : r * (q + 1) + (xcd - r) * q) + off; }
        const int nig = WGM * nN, gid = wgid / nig, fm = gid * WGM, gsz = (nM - fm) < WGM ? (nM - fm) : WGM;
        u.pm = fm + ((wgid % nig) % gsz); u.pn = (wgid % nig) / gsz; return true;
    }
};
template <class Epi, bool ALIGN_EPI = false, bool SP2 = true, bool HNORM = false, bool RS2TAB = false>
__device__ __forceinline__ void gemm_phase(LAS unsigned char* lds, const Gemm g, const StaticOrder& S, const Epi& E) {
    int tid_ = threadIdx.x; asm volatile("" : "+v"(tid_));
    const int tid = tid_, wid = __builtin_amdgcn_readfirstlane(tid >> 6), lane = tid & 63, wr = wid >> 2, wc = wid & 3, fr = lane & 15, fq = lane >> 4;
    const int K = g.K, nt = K / BK;
    unsigned voffA[2], voffB[2];
#pragma unroll
    for (int i = 0; i < 2; ++i) { int R, C; stage_rc(tid * 16 + i * 8192, R, C); const int Rb = (R & ~31) + perm32(R & 31);
        voffA[i] = (unsigned)(R * K + C) * 2u; voffB[i] = (unsigned)(Rb * K + C) * 2u; }
    const size_t kstep = (size_t)(BK * 2);
    const size_t hstep = (size_t)HALF * K * 2;
    const size_t tstep = 2 * hstep;
    const unsigned ldsw = (unsigned)wid * 1024u;
    const int aoff = lds_byte(wr * 64 + fr, fq * 8), boff = lds_byte(wc * 32 + fr, fq * 8);
#define PG8_SA(b, h) (((b) * 2 + (h)) * HTB)
#define PG8_SB(b, h) ((4 + (b) * 2 + (h)) * HTB)
#define PG8_STAGE(bufoff, gbase, voff) do { _Pragma("unroll") for (int _i = 0; _i < 2; ++_i) \
        __builtin_amdgcn_global_load_lds((const unsigned*)((const char*)(gbase) + (voff)[_i]), (LAS unsigned*)(lds + (bufoff) + ldsw + _i * 8192), 16, 0, 0); } while (0)
#define PG8_LDA(dst, b, h) do { _Pragma("unroll") for (int m = 0; m < 4; ++m) _Pragma("unroll") for (int k = 0; k < 2; ++k) dst[m][k] = *(const LAS bf16x8*)(lds + PG8_SA(b, h) + aoff + m * 2048 + k * 1024); } while (0)
#define PG8_LDB(dst, b, h) do { _Pragma("unroll") for (int n = 0; n < 2; ++n) _Pragma("unroll") for (int k = 0; k < 2; ++k) dst[n][k] = *(const LAS bf16x8*)(lds + PG8_SB(b, h) + boff + n * 2048 + k * 1024); } while (0)
#define PG8_MMA(ai, bj, At, Bt) do { __builtin_amdgcn_s_setprio(1); _Pragma("unroll") for (int m = 0; m < 4; ++m) _Pragma("unroll") for (int n = 0; n < 2; ++n) _Pragma("unroll") for (int k = 0; k < 2; ++k) \
        acc[ai][bj][m][n] = __builtin_amdgcn_mfma_f32_16x16x32_bf16(Bt[n][k], At[m][k], acc[ai][bj][m][n], 0, 0, 0); __builtin_amdgcn_s_setprio(0); } while (0)
#define PG8_WAIT_V(n) asm volatile("s_waitcnt vmcnt(" #n ")" ::: "memory")
#define PG8_WAIT_L(n) asm volatile("s_waitcnt lgkmcnt(" #n ")" ::: "memory")
#define PG8_BAR __builtin_amdgcn_s_barrier()
#define PG8_SCHED __builtin_amdgcn_sched_barrier(0)
    Unit cur, nxt; int ui = 0;
    if (!S.next(0, cur)) return;
    f32x4 acc[2][2][4][2];
#pragma unroll
    for (int a = 0; a < 2; ++a)
#pragma unroll
        for (int b = 0; b < 2; ++b)
#pragma unroll
            for (int m = 0; m < 4; ++m)
#pragma unroll
                for (int n = 0; n < 2; ++n) acc[a][b][m][n] = (f32x4){0.f, 0.f, 0.f, 0.f};
    bf16x8 At[4][2], B0[2][2], B1[2][2];
    const char* cA = (const char*)g.A + (size_t)cur.pm * tstep; const char* cB = (const char*)g.Bt + (size_t)cur.pn * tstep;
    LAS float* hrt = (LAS float*)(lds + STAGE_BYTES);
    if constexpr (RS2TAB) {
        if (tid < 256) { const f32x4 q = *(const f32x4*)(g.ssq + (size_t)(cur.pm * 256 + tid) * 4); hrt[tid] = 1.0f / sqrtf(((q.x + q.y) + (q.z + q.w)) * (1.0f / 1024.0f) + 1e-6f); }
        asm volatile("s_waitcnt vmcnt(0) lgkmcnt(0)" ::: "memory"); PG8_BAR;
    }
    if constexpr (HNORM) {
        if (tid < 256) { const float* q = g.ssq + (size_t)(cur.pm * 256 + tid) * 16; float r[4];
#pragma unroll
            for (int hh = 0; hh < 4; ++hh) { const f32x4 v = *(const f32x4*)(q + 4 * hh); r[hh] = 1.0f / sqrtf(((v.x + v.y) + (v.z + v.w)) * (1.0f / 256.0f) + 1e-6f); }
            *(LAS f32x4*)(hrt + tid * 4) = (f32x4){r[0] / r[1], r[1] / r[2], r[2] / r[3], r[3]}; }
        asm volatile("s_waitcnt vmcnt(0) lgkmcnt(0)" ::: "memory"); PG8_BAR;
    }
    if constexpr (SP2) {
        PG8_STAGE(PG8_SB(0, 0), cB, voffB); PG8_STAGE(PG8_SB(0, 1), cB + hstep, voffB); PG8_STAGE(PG8_SA(0, 0), cA, voffA); PG8_STAGE(PG8_SA(0, 1), cA + hstep, voffA);
        if (wr == 1) PG8_BAR;
        PG8_WAIT_V(2); PG8_BAR;
        PG8_STAGE(PG8_SB(1, 0), cB + kstep, voffB); PG8_STAGE(PG8_SA(1, 0), cA + kstep, voffA); PG8_STAGE(PG8_SB(1, 1), cB + hstep + kstep, voffB);
        PG8_WAIT_V(6); PG8_BAR;
    } else {
    PG8_STAGE(PG8_SB(0, 0), cB, voffB); PG8_STAGE(PG8_SA(0, 0), cA, voffA); PG8_STAGE(PG8_SB(0, 1), cB + hstep, voffB); PG8_STAGE(PG8_SA(0, 1), cA + hstep, voffA);
    if (wr == 1) PG8_BAR;
    PG8_WAIT_V(4); PG8_BAR;
    PG8_STAGE(PG8_SB(1, 0), cB + kstep, voffB); PG8_STAGE(PG8_SA(1, 0), cA + kstep, voffA); PG8_STAGE(PG8_SB(1, 1), cB + hstep + kstep, voffB);
    PG8_WAIT_V(6); PG8_BAR;
    }
    for (;;) {
        const bool has_next = S.next(ui + 1, nxt);
        const char* nA = has_next ? (const char*)g.A + (size_t)nxt.pm * tstep : cA; const char* nB = has_next ? (const char*)g.Bt + (size_t)nxt.pn * tstep : cB;
        for (int t = 0; t < nt; t += 2) {
            const bool last = (t == nt - 2);
            const char* a1 = cA + (size_t)(t + 1) * kstep;
            const char* a2 = last ? nA : cA + (size_t)(t + 2) * kstep; const char* b2 = last ? nB : cB + (size_t)(t + 2) * kstep;
            const char* a3 = a2 + kstep; const char* b3 = b2 + kstep;
            if constexpr (HNORM) { if (t == 4 || t == 8 || t == 12) { const int hi = (t >> 2) - 1;
#pragma unroll
                for (int ai = 0; ai < 2; ++ai)
#pragma unroll
                    for (int m = 0; m < 4; ++m) { const float f = hrt[(ai * 128 + wr * 64 + m * 16 + fr) * 4 + hi];
#pragma unroll
                        for (int bj = 0; bj < 2; ++bj)
#pragma unroll
                            for (int n = 0; n < 2; ++n) acc[ai][bj][m][n] *= f; } } }
            if constexpr (SP2) {
            PG8_LDB(B0, 0, 0); PG8_LDB(B1, 0, 1); PG8_SCHED; PG8_LDA(At, 0, 0); PG8_STAGE(PG8_SA(1, 1), a1 + hstep, voffA);
            PG8_WAIT_V(8); PG8_WAIT_L(0); PG8_BAR; PG8_MMA(0, 0, At, B0); PG8_MMA(0, 1, At, B1); PG8_BAR; PG8_SCHED;
            PG8_LDA(At, 0, 1); PG8_STAGE(PG8_SB(0, 0), b2, voffB); PG8_STAGE(PG8_SB(0, 1), b2 + hstep, voffB); PG8_STAGE(PG8_SA(0, 0), a2, voffA);
            PG8_WAIT_V(8); PG8_WAIT_L(0); PG8_BAR; PG8_MMA(1, 0, At, B0); PG8_MMA(1, 1, At, B1); PG8_BAR; PG8_SCHED;
            PG8_LDB(B0, 1, 0); PG8_LDB(B1, 1, 1); PG8_SCHED; PG8_LDA(At, 1, 0); PG8_STAGE(PG8_SA(0, 1), a2 + hstep, voffA);
            PG8_WAIT_V(8); PG8_WAIT_L(0); PG8_BAR; PG8_MMA(0, 0, At, B0); PG8_MMA(0, 1, At, B1); PG8_BAR; PG8_SCHED;
            PG8_LDA(At, 1, 1); PG8_STAGE(PG8_SB(1, 0), b3, voffB); PG8_STAGE(PG8_SB(1, 1), b3 + hstep, voffB); PG8_STAGE(PG8_SA(1, 0), a3, voffA);
            PG8_WAIT_V(8); PG8_WAIT_L(0); PG8_BAR; PG8_MMA(1, 0, At, B0); PG8_MMA(1, 1, At, B1); PG8_BAR; PG8_SCHED;
            } else {
            PG8_LDB(B0, 0, 0); PG8_SCHED; PG8_LDA(At, 0, 0); PG8_STAGE(PG8_SA(1, 1), a1 + hstep, voffA);
            PG8_WAIT_L(8); PG8_BAR; PG8_WAIT_L(0); PG8_MMA(0, 0, At, B0); PG8_BAR; PG8_SCHED;
            PG8_LDB(B1, 0, 1); PG8_STAGE(PG8_SB(0, 0), b2, voffB);
            PG8_BAR; PG8_WAIT_L(0); PG8_MMA(0, 1, At, B1); PG8_BAR;
            PG8_LDA(At, 0, 1); PG8_STAGE(PG8_SA(0, 0), a2, voffA);
            PG8_BAR; PG8_WAIT_L(0); PG8_MMA(1, 0, At, B0); PG8_BAR; PG8_SCHED;
            PG8_STAGE(PG8_SB(0, 1), b2 + hstep, voffB);
            PG8_WAIT_V(6); PG8_BAR; PG8_MMA(1, 1, At, B1); PG8_BAR;
            PG8_LDB(B0, 1, 0); PG8_SCHED; PG8_LDA(At, 1, 0); PG8_STAGE(PG8_SA(0, 1), a2 + hstep, voffA);
            PG8_WAIT_L(8); PG8_BAR; PG8_WAIT_L(0); PG8_MMA(0, 0, At, B0); PG8_BAR; PG8_SCHED;
            PG8_LDB(B1, 1, 1); PG8_STAGE(PG8_SB(1, 0), b3, voffB);
            PG8_BAR; PG8_WAIT_L(0); PG8_MMA(0, 1, At, B1); PG8_BAR;
            PG8_LDA(At, 1, 1); PG8_STAGE(PG8_SA(1, 0), a3, voffA);
            PG8_BAR; PG8_WAIT_L(0); PG8_MMA(1, 0, At, B0); PG8_BAR; PG8_SCHED;
            PG8_STAGE(PG8_SB(1, 1), b3 + hstep, voffB);
            PG8_WAIT_V(6); PG8_BAR; PG8_MMA(1, 1, At, B1); PG8_BAR;
            }
        }
        if constexpr (HNORM) {
#pragma unroll
            for (int ai = 0; ai < 2; ++ai)
#pragma unroll
                for (int m = 0; m < 4; ++m) { const float f = hrt[(ai * 128 + wr * 64 + m * 16 + fr) * 4 + 3];
#pragma unroll
                    for (int bj = 0; bj < 2; ++bj)
#pragma unroll
                        for (int n = 0; n < 2; ++n) acc[ai][bj][m][n] *= f; } }
        if constexpr (ALIGN_EPI) { if (wr == 0) PG8_BAR; }
        if constexpr (!Epi::AFTER_DRAIN) E(acc, cur, wr, wc, fr, fq);
        if (!has_next) break;
#pragma unroll
        for (int a = 0; a < 2; ++a)
#pragma unroll
            for (int b = 0; b < 2; ++b)
#pragma unroll
                for (int m = 0; m < 4; ++m)
#pragma unroll
                    for (int n = 0; n < 2; ++n) acc[a][b][m][n] = (f32x4){0.f, 0.f, 0.f, 0.f};
        cur = nxt; cA = nA; cB = nB; ++ui;
        if constexpr (ALIGN_EPI) { if (wr == 1) PG8_BAR; }
    }
    PG8_WAIT_V(0);
    if constexpr (!ALIGN_EPI) { if (wr == 0) PG8_BAR; }
    PG8_BAR;
    if constexpr (Epi::AFTER_DRAIN) E.fused(acc, cur, wr, wc, fr, fq, lds, tid);
#undef PG8_SA
#undef PG8_SB
#undef PG8_STAGE
#undef PG8_LDA
#undef PG8_LDB
#undef PG8_MMA
#undef PG8_WAIT_V
#undef PG8_WAIT_L
#undef PG8_BAR
#undef PG8_SCHED
}
}

enum { EK_IN = 0, EK_CO, EK_RO, EK_WO, EK_UP, EK_DN };

template <int KIND>
__device__ __forceinline__ void epi8(const Ctx& c, int row, int col, f32x4 v0, f32x4 v1) {
    unsigned char* act = c.ws + WS_ACT;
    if constexpr (KIND == EK_IN) {
        if (col < 1024) {
            u32x2 w; w.x = pk2(v0[0] * sigm(v0[1]), v0[2] * sigm(v0[3])); w.y = pk2(v1[0] * sigm(v1[1]), v1[2] * sigm(v1[3]));
            *(u32x2*)((bf16_t*)(act + A_U) + (size_t)row * 512 + (col >> 1)) = w;
        } else if (col < 2048) {
            const bool isk = col >= 1536; const int cc = col - (isk ? 1536 : 1024), h = cc >> 7, i0 = (cc & 127) >> 1;
            const float pos = row < MP ? (float)(row & (SEQ - 1)) : 16384.0f;
            const float sc = isk ? 0.08838834764831845f : 1.0f;
            const float* freq = (const float*)(c.ws + WS_CTL + 256);
            const f32x4 fv = *(const f32x4*)(freq + i0);
            float x1[4] = {v0[0], v0[2], v1[0], v1[2]}, x2[4] = {v0[1], v0[3], v1[1], v1[3]}, o1[4], o2[4];
#pragma unroll
            for (int p = 0; p < 4; ++p) {
                const float ang = pos * fv[p];
                const float n = rintf(ang * 0.15915494309189535f);
                const float r = fmaf(-n, -1.7484555e-7f, fmaf(-n, 6.2831854820251465f, ang));
                const float sn = __sinf(r) * sc, cs = __cosf(r) * sc;
                o1[p] = x1[p] * cs - x2[p] * sn; o2[p] = x2[p] * cs + x1[p] * sn;
            }
            bf16_t* dst = (bf16_t*)(act + (isk ? A_K : A_Q)) + (size_t)row * 512 + h * 128 + i0;
            u32x2 w1, w2; w1.x = pk2(o1[0], o1[1]); w1.y = pk2(o1[2], o1[3]); w2.x = pk2(o2[0], o2[1]); w2.y = pk2(o2[2], o2[3]);
            *(u32x2*)dst = w1; *(u32x2*)(dst + 64) = w2;
        } else {
            const int seg = (col - 2048) >> 10, cc = (col - 2048) & 1023;
            float f[8] = {v0[0], v0[1], v0[2], v0[3], v1[0], v1[1], v1[2], v1[3]};
            u32x4 w; w.x = pk2(f[0], f[1]); w.y = pk2(f[2], f[3]); w.z = pk2(f[4], f[5]); w.w = pk2(f[6], f[7]);
            *(u32x4*)((bf16_t*)(act + A_V + (size_t)seg * ((size_t)RT * 1024 * 2)) + (size_t)row * 1024 + cc) = w;
        }
    } else if constexpr (KIND == EK_CO) {
        u32x4* p = (u32x4*)((bf16_t*)(act + A_SA) + (size_t)row * 1024 + col); const u32x4 g = *p;
        u32x4 w; w.x = pk2(v0[0] * sigm(bflo(g.x)), v0[1] * sigm(bfhi(g.x))); w.y = pk2(v0[2] * sigm(bflo(g.y)), v0[3] * sigm(bfhi(g.y)));
        w.z = pk2(v1[0] * sigm(bflo(g.z)), v1[1] * sigm(bfhi(g.z))); w.w = pk2(v1[2] * sigm(bflo(g.w)), v1[3] * sigm(bfhi(g.w)));
        *p = w;
    } else if constexpr (KIND == EK_RO) {
        const u32x4 t = *(const u32x4*)((bf16_t*)(act + A_SA) + (size_t)row * 1024 + col);
        u32x4* p = (u32x4*)((bf16_t*)(act + A_SB) + (size_t)row * 1024 + col); const u32x4 g = *p;
        u32x4 w; w.x = pk2(bflo(t.x) + v0[0] * sigm(bflo(g.x)), bfhi(t.x) + v0[1] * sigm(bfhi(g.x))); w.y = pk2(bflo(t.y) + v0[2] * sigm(bflo(g.y)), bfhi(t.y) + v0[3] * sigm(bfhi(g.y)));
        w.z = pk2(bflo(t.z) + v1[0] * sigm(bflo(g.z)), bfhi(t.z) + v1[1] * sigm(bfhi(g.z))); w.w = pk2(bflo(t.w) + v1[2] * sigm(bflo(g.w)), bfhi(t.w) + v1[3] * sigm(bfhi(g.w)));
        *p = w;
    } else if constexpr (KIND == EK_WO) {
        u32x4 w; w.x = pk2(v0[0], v0[1]); w.y = pk2(v0[2], v0[3]); w.z = pk2(v1[0], v1[1]); w.w = pk2(v1[2], v1[3]);
        *(u32x4*)((bf16_t*)(act + A_M2) + (size_t)row * DM + col) = w;
    } else if constexpr (KIND == EK_UP) {
        float f[8] = {v0[0], v0[1], v0[2], v0[3], v1[0], v1[1], v1[2], v1[3]};
#pragma unroll
        for (int j = 0; j < 8; ++j) { const float r = fmaxf(f[j], 0.f); f[j] = r * r; }
        u32x4 w; w.x = pk2(f[0], f[1]); w.y = pk2(f[2], f[3]); w.z = pk2(f[4], f[5]); w.w = pk2(f[6], f[7]);
        *(u32x4*)((bf16_t*)(act + A_UP) + (size_t)row * FF + col) = w;
    } else {
        u32x4 w; w.x = pk2(v0[0], v0[1]); w.y = pk2(v0[2], v0[3]); w.z = pk2(v1[0], v1[1]); w.w = pk2(v1[2], v1[3]);
        *(u32x4*)((bf16_t*)(act + A_F) + (size_t)row * DM + col) = w;
    }
}

template <int KIND> struct Epi {
    static constexpr bool AFTER_DRAIN = false;
    Ctx c; const LAS float* tab = nullptr;
    __device__ __forceinline__ void operator()(const f32x4 (&acc)[2][2][4][2], const pg8::Unit& u, int wr, int wc, int fr, int fq) const {
#pragma unroll
        for (int ai = 0; ai < 2; ++ai)
#pragma unroll
            for (int m = 0; m < 4; ++m) {
                const int row = u.pm * 256 + ai * 128 + wr * 64 + m * 16 + fr;
                float f = 1.0f; if constexpr (KIND == EK_UP) f = tab[ai * 128 + wr * 64 + m * 16 + fr];
#pragma unroll
                for (int bj = 0; bj < 2; ++bj) {
                    if constexpr (KIND == EK_UP) epi8<KIND>(c, row, u.pn * 256 + bj * 128 + wc * 32 + 8 * fq, acc[ai][bj][m][0] * f, acc[ai][bj][m][1] * f);
                    else epi8<KIND>(c, row, u.pn * 256 + bj * 128 + wc * 32 + 8 * fq, acc[ai][bj][m][0], acc[ai][bj][m][1]);
                }
            }
    }
};

__device__ __forceinline__ void row_rms_exchange(const Ctx& c, int set, const f32x4 (&v)[2][2][4][2], const pg8::Unit& u, int wr, int wc, int fr, int fq, LAS unsigned char* lds, int tid) {
    LAS float* P = (LAS float*)lds;
    LAS float* S = (LAS float*)(lds + 8192);
    unsigned* slots = (unsigned*)(c.ws + WS_XCH) + (size_t)set * 64 * 256 * 4;
    unsigned* cnt = (unsigned*)(c.ws + WS_CTL + CTL_XCNT) + (size_t)(set * 64 + u.pm) * 64;
#pragma unroll
    for (int ai = 0; ai < 2; ++ai)
#pragma unroll
        for (int m = 0; m < 4; ++m) {
            float q = 0.f;
#pragma unroll
            for (int bj = 0; bj < 2; ++bj)
#pragma unroll
                for (int n = 0; n < 2; ++n) { const f32x4 x = v[ai][bj][m][n]; q += (x[0] * x[0] + x[1] * x[1]) + (x[2] * x[2] + x[3] * x[3]); }
            q += __shfl_xor(q, 16); q += __shfl_xor(q, 32);
            if (fq == 0) P[(ai * 128 + wr * 64 + m * 16 + fr) * 4 + wc] = q;
        }
    __syncthreads();
    if (tid < 256) {
        const float t = (P[tid * 4 + 0] + P[tid * 4 + 1]) + (P[tid * 4 + 2] + P[tid * 4 + 3]);
        __hip_atomic_store(slots + ((size_t)(u.pm * 256 + tid) * 4 + u.pn), __float_as_uint(t), __ATOMIC_RELAXED, __HIP_MEMORY_SCOPE_AGENT);
    }
    asm volatile("s_waitcnt vmcnt(0)" ::: "memory");
    __syncthreads();
    if (tid == 0) {
        __hip_atomic_fetch_add(cnt, 1u, __ATOMIC_RELAXED, __HIP_MEMORY_SCOPE_AGENT);
        unsigned sp = 0;
        while (__hip_atomic_load(cnt, __ATOMIC_RELAXED, __HIP_MEMORY_SCOPE_AGENT) < 4u) { __builtin_amdgcn_s_sleep(1); if (++sp > (1u << 22)) break; }
        __builtin_amdgcn_fence(__ATOMIC_ACQUIRE, "agent");
        asm volatile("s_waitcnt vmcnt(0)" ::: "memory");
    }
    __syncthreads();
    if (tid < 256) {
        const unsigned* sl = slots + (size_t)(u.pm * 256 + tid) * 4;
        float t = 0.f;
#pragma unroll
        for (int k = 0; k < 4; ++k) t += __uint_as_float(__hip_atomic_load(sl + k, __ATOMIC_RELAXED, __HIP_MEMORY_SCOPE_AGENT));
        S[tid] = 1.0f / sqrtf(t * (1.0f / DM) + EPS);
    }
    __syncthreads();
}
struct EpiWoFused {
    static constexpr bool AFTER_DRAIN = true;
    Ctx c;
    __device__ __forceinline__ void fused(f32x4 (&acc)[2][2][4][2], const pg8::Unit& u, int wr, int wc, int fr, int fq, LAS unsigned char* lds, int tid) const {
        row_rms_exchange(c, 1, acc, u, wr, wc, fr, fq, lds, tid);
        const LAS float* S = (const LAS float*)(lds + 8192);
        bf16_t* MB = (bf16_t*)(c.ws + WS_ACT + A_M2); bf16_t* HN = (bf16_t*)(c.ws + WS_ACT + A_HN);
#pragma unroll
        for (int bj = 0; bj < 2; ++bj) {
            const int col = u.pn * 256 + bj * 128 + wc * 32 + 8 * fq;
            const f32x4 g0 = *(const f32x4*)(c.n_mix_post + col), g1 = *(const f32x4*)(c.n_mix_post + col + 4);
#pragma unroll
            for (int ai = 0; ai < 2; ++ai)
#pragma unroll
                for (int m = 0; m < 4; ++m) { const int rl = ai * 128 + wr * 64 + m * 16 + fr; const float rs = S[rl]; const size_t ro = (size_t)(u.pm * 256 + rl) * DM + col;
                    const f32x4 x0 = __builtin_nontemporal_load((const f32x4*)(c.xp + ro)), x1 = __builtin_nontemporal_load((const f32x4*)(c.xp + ro + 4));
                    const f32x4 h0 = x0 + acc[ai][bj][m][0] * rs * g0, h1 = x1 + acc[ai][bj][m][1] * rs * g1;
                    acc[ai][bj][m][0] = h0; acc[ai][bj][m][1] = h1;
                    u32x4 w; w.x = pk2(h0[0], h0[1]); w.y = pk2(h0[2], h0[3]); w.z = pk2(h1[0], h1[1]); w.w = pk2(h1[2], h1[3]);
                    *(u32x4*)(MB + ro) = w; }
        }
        {
            LAS float* P = (LAS float*)lds;
            unsigned* slots = (unsigned*)(c.ws + WS_XCH) + (size_t)2 * 64 * 256 * 4;
#pragma unroll
            for (int ai = 0; ai < 2; ++ai)
#pragma unroll
                for (int m = 0; m < 4; ++m) { float q = 0.f;
#pragma unroll
                    for (int bj = 0; bj < 2; ++bj)
#pragma unroll
                        for (int n = 0; n < 2; ++n) { const f32x4 x = acc[ai][bj][m][n]; q += (x[0] * x[0] + x[1] * x[1]) + (x[2] * x[2] + x[3] * x[3]); }
                    q += __shfl_xor(q, 16); q += __shfl_xor(q, 32);
                    if (fq == 0) P[(ai * 128 + wr * 64 + m * 16 + fr) * 4 + wc] = q; }
            __syncthreads();
            if (tid < 256) slots[(size_t)(u.pm * 256 + tid) * 4 + u.pn] = __float_as_uint((P[tid * 4 + 0] + P[tid * 4 + 1]) + (P[tid * 4 + 2] + P[tid * 4 + 3]));
        }
    }
};

__device__ __forceinline__ float small_rms_exchange(const Ctx& c, int set, int mt, int ng, int lane, const f32x4& s0, const f32x4& s1) {
    const int fr = lane & 15, fq = lane >> 4;
    unsigned* slots = (unsigned*)(c.ws + WS_XCHS) + (size_t)((set * 8 + mt) * 16) * 32;
    unsigned* cnt = (unsigned*)(c.ws + WS_CTL + CTL_XCNTS) + (size_t)(set * 8 + mt) * 64;
    float q = ((s0[0] * s0[0] + s0[1] * s0[1]) + (s0[2] * s0[2] + s0[3] * s0[3])) + ((s1[0] * s1[0] + s1[1] * s1[1]) + (s1[2] * s1[2] + s1[3] * s1[3]));
    q += __shfl_xor(q, 16); q += __shfl_xor(q, 32);
    if (fq == 0) __hip_atomic_store(slots + fr * 32 + ng, __float_as_uint(q), __ATOMIC_RELAXED, __HIP_MEMORY_SCOPE_AGENT);
    asm volatile("s_waitcnt vmcnt(0)" ::: "memory");
    if (lane == 0) {
        __hip_atomic_fetch_add(cnt, 1u, __ATOMIC_RELAXED, __HIP_MEMORY_SCOPE_AGENT);
        unsigned sp = 0;
        while (__hip_atomic_load(cnt, __ATOMIC_RELAXED, __HIP_MEMORY_SCOPE_AGENT) < 32u) { __builtin_amdgcn_s_sleep(1); if (++sp > (1u << 22)) break; }
    }
    __builtin_amdgcn_fence(__ATOMIC_ACQUIRE, "agent");
    asm volatile("s_waitcnt vmcnt(0)" ::: "memory");
    float t = 0.f;
#pragma unroll
    for (int k = 0; k < 8; ++k) t += __uint_as_float(__hip_atomic_load(slots + fr * 32 + fq * 8 + k, __ATOMIC_RELAXED, __HIP_MEMORY_SCOPE_AGENT));
    t += __shfl_xor(t, 16); t += __shfl_xor(t, 32);
    return 1.0f / sqrtf(t * (1.0f / DM) + EPS);
}
template <int KIND>
__device__ __forceinline__ void small_fused(const Ctx& c, int mt, int ng, int lane, f32x4 s0, f32x4 s1) {
    const int fr = lane & 15, fq = lane >> 4, col = ng * 32 + 8 * fq;
    const size_t ro = (size_t)(MP + mt * 16 + fr) * DM + col;
    bf16_t* MB = (bf16_t*)(c.ws + WS_ACT + A_M2);
    if constexpr (KIND == EK_WO) {
        const float rs = small_rms_exchange(c, 0, mt, ng, lane, s0, s1);
        const float* xr = c.xs + (size_t)(mt * 16 + fr) * DM + col;
        const f32x4 g0 = *(const f32x4*)(c.n_mix_post + col), g1 = *(const f32x4*)(c.n_mix_post + col + 4);
        const f32x4 h0 = *(const f32x4*)xr + s0 * rs * g0, h1 = *(const f32x4*)(xr + 4) + s1 * rs * g1;
        u32x4 w; w.x = pk2(h0[0], h0[1]); w.y = pk2(h0[2], h0[3]); w.z = pk2(h1[0], h1[1]); w.w = pk2(h1[2], h1[3]);
        *(u32x4*)(MB + ro) = w;
        const float rs2 = small_rms_exchange(c, 1, mt, ng, lane, h0, h1);
        if (ng == 0 && fq == 0) ((float*)(c.ws + WS_RS2S))[mt * 16 + fr] = rs2;
    } else {
        const float rs = small_rms_exchange(c, 2, mt, ng, lane, s0, s1);
        const u32x4 hw = *(const u32x4*)(MB + ro);
        const f32x4 h0 = {bflo(hw.x), bfhi(hw.x), bflo(hw.y), bfhi(hw.y)}, h1 = {bflo(hw.z), bfhi(hw.z), bflo(hw.w), bfhi(hw.w)};
        const f32x4 g0 = *(const f32x4*)(c.n_ffn_post + col), g1 = *(const f32x4*)(c.n_ffn_post + col + 4);
        float* p = c.out + ro;
        *(f32x4*)p = h0 + s0 * rs * g0; *(f32x4*)(p + 4) = h1 + s1 * rs * g1;
    }
}

struct EpiDnFused {
    static constexpr bool AFTER_DRAIN = true;
    Ctx c;
    __device__ __forceinline__ void fused(const f32x4 (&acc)[2][2][4][2], const pg8::Unit& u, int wr, int wc, int fr, int fq, LAS unsigned char* lds, int tid) const {
        row_rms_exchange(c, 0, acc, u, wr, wc, fr, fq, lds, tid);
        const LAS float* S = (const LAS float*)(lds + 8192);
#pragma unroll
        for (int bj = 0; bj < 2; ++bj) {
            const int col = u.pn * 256 + bj * 128 + wc * 32 + 8 * fq;
            const f32x4 g0 = *(const f32x4*)(c.n_ffn_post + col), g1 = *(const f32x4*)(c.n_ffn_post + col + 4);
#pragma unroll
            for (int ai = 0; ai < 2; ++ai)
#pragma unroll
                for (int m = 0; m < 4; ++m) { const int rl = ai * 128 + wr * 64 + m * 16 + fr; const float rs = S[rl];
                    float* p = c.out + (size_t)(u.pm * 256 + rl) * DM + col;
                    const u32x4 hw = __builtin_nontemporal_load((const u32x4*)((const bf16_t*)(c.ws + WS_ACT + A_M2) + (size_t)(u.pm * 256 + rl) * DM + col));
                    const f32x4 h0 = {bflo(hw.x), bfhi(hw.x), bflo(hw.y), bfhi(hw.y)}, h1 = {bflo(hw.z), bfhi(hw.z), bflo(hw.w), bfhi(hw.w)};
                    __builtin_nontemporal_store(h0 + acc[ai][bj][m][0] * rs * g0, (f32x4*)p); __builtin_nontemporal_store(h1 + acc[ai][bj][m][1] * rs * g1, (f32x4*)(p + 4)); }
        }
    }
};

template <int KIND, int N, int K, int NI, class BigEpi = Epi<KIND>, bool ALIGN = false, bool HNORM = false, bool RS2TAB = false>
__device__ __forceinline__ void gemm_all(const Ctx& c, LAS unsigned char* lds, const bf16_t* A, const bf16_t* Bt) {
    {
    {
    pg8::StaticOrder S; S.init(MP, N, gridDim.x, blockIdx.x);
    BigEpi E{c};
    if constexpr (RS2TAB) E.tab = (const LAS float*)(lds + pg8::STAGE_BYTES);
    pg8::Gemm g{A, Bt, MP, N, K, RS2TAB ? (const float*)(c.ws + WS_XCH) + (size_t)2 * 64 * 256 * 4 : (const float*)(c.ws + WS_SSQ)};
    pg8::gemm_phase<BigEpi, ALIGN, true, HNORM, RS2TAB>(lds, g, S, E);
    __syncthreads();
    }
    {
    const int tid = otid(), wid = __builtin_amdgcn_readfirstlane(tid >> 6), lane = tid & 63, fr = lane & 15, fq = lane >> 4;
    LAS f32x4* red = (LAS f32x4*)lds;
    constexpr int nitems = 8 * (N / 32), kw = K / 8, KS = kw / 32, KB = KS > 4 ? 4 : KS;
    const unsigned toff = (unsigned)((fr * K + wid * kw + 8 * fq) * 2);
    const unsigned tb0 = (unsigned)((pg8::perm32(fr) * K + wid * kw + 8 * fq) * 2), tb1 = (unsigned)((pg8::perm32(16 + fr) * K + wid * kw + 8 * fq) * 2);
    for (int base = blockIdx.x * NI; base < nitems; base += gridDim.x * NI) {
        f32x4 a0[NI], a1[NI];
#pragma unroll
        for (int q = 0; q < NI; ++q) { a0[q] = (f32x4){0.f, 0.f, 0.f, 0.f}; a1[q] = (f32x4){0.f, 0.f, 0.f, 0.f}; }
#pragma unroll 1
        for (int k0 = 0; k0 < KS; k0 += KB) {
            bf16x8 af[NI][KB], b0[NI][KB], b1[NI][KB];
#pragma unroll
            for (int q = 0; q < NI; ++q) { const int item = base + q, mt = item & 7, ng = item >> 3;
                const char* ap = (const char*)(A + (size_t)(MP + mt * 16) * K) + (size_t)k0 * 64; const char* bp = (const char*)(Bt + (size_t)(ng * 32) * K) + (size_t)k0 * 64;
#pragma unroll
                for (int ks = 0; ks < KB; ++ks) { af[q][ks] = *(const bf16x8*)(ap + ks * 64 + toff); b0[q][ks] = *(const bf16x8*)(bp + ks * 64 + tb0); b1[q][ks] = *(const bf16x8*)(bp + ks * 64 + tb1); } }
#pragma unroll
            for (int q = 0; q < NI; ++q)
#pragma unroll
                for (int ks = 0; ks < KB; ++ks) { a0[q] = __builtin_amdgcn_mfma_f32_16x16x32_bf16(b0[q][ks], af[q][ks], a0[q], 0, 0, 0); a1[q] = __builtin_amdgcn_mfma_f32_16x16x32_bf16(b1[q][ks], af[q][ks], a1[q], 0, 0, 0); }
        }
#pragma unroll
        for (int q = 0; q < NI; ++q) { red[((q * 8 + wid) * 2 + 0) * 64 + lane] = a0[q]; red[((q * 8 + wid) * 2 + 1) * 64 + lane] = a1[q]; }
        __syncthreads();
        if (wid < NI && base + wid < nitems) {
            f32x4 s0 = red[((wid * 8) * 2 + 0) * 64 + lane], s1 = red[((wid * 8) * 2 + 1) * 64 + lane];
#pragma unroll
            for (int w = 1; w < 8; ++w) { s0 += red[((wid * 8 + w) * 2 + 0) * 64 + lane]; s1 += red[((wid * 8 + w) * 2 + 1) * 64 + lane]; }
            const int item = base + wid, mt = item & 7, ng = item >> 3;
            if constexpr (KIND == EK_WO || KIND == EK_DN) small_fused<KIND>(c, mt, ng, lane, s0, s1);
            else { if constexpr (KIND == EK_UP) { const float f = ((const float*)(c.ws + WS_RS2S))[mt * 16 + fr]; s0 *= f; s1 *= f; }
                epi8<KIND>(c, MP + mt * 16 + fr, ng * 32 + 8 * fq, s0, s1); }
        }
        __syncthreads();
    }
    }
    }
}

__device__ __forceinline__ int map_in(int n) {
    if (n < 512) return 2 * n;
    if (n < 1024) return 2 * (n - 512) + 1;
    if (n < 2048) { const int base = n < 1536 ? 1024 : 1536, cc = n - base, h = cc >> 7, d = cc & 127; return base + h * 128 + 2 * (d & 63) + (d >> 6); }
    return n;
}
struct WItem { const float* W; bf16_t* WT; int K, N, r; bool mapin; const float* kscale; };
__device__ __forceinline__ void wt_load(const WItem& w, int lane, f32x4 (&v)[8]) {
    const int nblk = w.N / 32, kb = w.r / nblk, nb = w.r % nblk, k0 = 64 * kb, n0 = 32 * nb, kr = lane >> 3, seg = lane & 7;
    const float* wp = w.W + (size_t)(k0 + kr) * w.N + n0 + seg * 4;
#pragma unroll
    for (int i = 0; i < 8; ++i) v[i] = __builtin_nontemporal_load((const f32x4*)(wp + (size_t)(8 * i) * w.N));
}
__device__ __forceinline__ void wt_finish(const WItem& w, int lane, const f32x4 (&v)[8], LAS float* scr) {
    const int nblk = w.N / 32, kb = w.r / nblk, nb = w.r % nblk, k0 = 64 * kb, n0 = 32 * nb, kr = lane >> 3, seg = lane & 7;
#pragma unroll
    for (int i = 0; i < 8; ++i) { LAS float* d = scr + (8 * i + kr) * 33 + seg * 4; d[0] = v[i][0]; d[1] = v[i][1]; d[2] = v[i][2]; d[3] = v[i][3]; }
    LDS_WAIT();
    const int ch = lane & 7;
#pragma unroll
    for (int j = 0; j < 4; ++j) { const int n = (lane >> 3) + 8 * j; const LAS float* s = scr + (8 * ch) * 33 + n;
        f32x4 ga = {1.f, 1.f, 1.f, 1.f}, gb = {1.f, 1.f, 1.f, 1.f};
        if (w.kscale) { ga = *(const f32x4*)(w.kscale + k0 + 8 * ch); gb = *(const f32x4*)(w.kscale + k0 + 8 * ch + 4); }
        u32x4 o; o.x = pk2(s[0 * 33] * ga[0], s[1 * 33] * ga[1]); o.y = pk2(s[2 * 33] * ga[2], s[3 * 33] * ga[3]); o.z = pk2(s[4 * 33] * gb[0], s[5 * 33] * gb[1]); o.w = pk2(s[6 * 33] * gb[2], s[7 * 33] * gb[3]);
        const int dn = w.mapin ? map_in(n0 + n) : (n0 + n);
        *(u32x4*)(w.WT + (size_t)dn * w.K + k0 + 8 * ch) = o; }
    LDS_WAIT();
}
constexpr int WI_IN = (DM / 64) * (NIN / 32);
constexpr int WI_CO = (CD / 64) * (DM / 32), WI_RO = (DM / 64) * (DM / 32), WI_O = WI_RO, WI_UP = (DM / 64) * (FF / 32), WI_DN = (FF / 64) * (DM / 32);
constexpr int WI_TOTAL = WI_IN + WI_CO + WI_RO + WI_O + WI_UP + WI_DN;

__device__ __forceinline__ void wt_pair(const Ctx& c, int p, int lane, LAS float* scr) {
    int r = 2 * p; WItem w;
    if (r < WI_IN) { w.W = c.w_in; w.WT = (bf16_t*)(c.ws + WS_WIN); w.K = DM; w.N = NIN; w.mapin = true; w.kscale = nullptr; }
    else if ((r -= WI_IN) < WI_CO) { w.W = c.w_co; w.WT = (bf16_t*)(c.ws + WS_WCO); w.K = CD; w.N = DM; w.mapin = false; w.kscale = nullptr; }
    else if ((r -= WI_CO) < WI_RO) { w.W = c.w_ro; w.WT = (bf16_t*)(c.ws + WS_WRO); w.K = DM; w.N = DM; w.mapin = false; w.kscale = nullptr; }
    else if ((r -= WI_RO) < WI_O) { w.W = c.w_o; w.WT = (bf16_t*)(c.ws + WS_WO); w.K = DM; w.N = DM; w.mapin = false; w.kscale = nullptr; }
    else if ((r -= WI_O) < WI_UP) { w.W = c.w_up; w.WT = (bf16_t*)(c.ws + WS_WUP); w.K = DM; w.N = FF; w.mapin = false; w.kscale = c.n_ffn_pre; }
    else { r -= WI_UP; w.W = c.w_dn; w.WT = (bf16_t*)(c.ws + WS_WDN); w.K = FF; w.N = DM; w.mapin = false; w.kscale = nullptr; }
    WItem w1 = w; w.r = r; w1.r = r + 1;
    f32x4 va[8], vb[8];
    wt_load(w, lane, va); wt_load(w1, lane, vb);
    wt_finish(w, lane, va, scr); wt_finish(w1, lane, vb, scr);
}
__device__ __forceinline__ void rms_rows4_to_bf16(const Ctx& c, int row0, int stride, const float* w, bf16_t* XN, int lane) {
    f32x4 v[4][4];
#pragma unroll
    for (int r = 0; r < 4; ++r) { const int row = row0 + r * stride;
        if (row < RT) { const float* x = xrow(c, row);
#pragma unroll
            for (int j = 0; j < 4; ++j) v[r][j] = __builtin_nontemporal_load((const f32x4*)x + 64 * j + lane); } }
#pragma unroll
    for (int r = 0; r < 4; ++r) { const int row = row0 + r * stride;
        if (row < RT) { float s = 0.f;
#pragma unroll
            for (int j = 0; j < 4; ++j) s += (v[r][j].x * v[r][j].x + v[r][j].y * v[r][j].y) + (v[r][j].z * v[r][j].z + v[r][j].w * v[r][j].w);
            const float rs = 1.0f / sqrtf(wave_sum(s) * (1.0f / DM) + EPS);
#pragma unroll
            for (int j = 0; j < 4; ++j) { const f32x4 g = *((const f32x4*)w + 64 * j + lane);
                u32x2 p; p.x = pk2(v[r][j].x * rs * g.x, v[r][j].y * rs * g.y); p.y = pk2(v[r][j].z * rs * g.z, v[r][j].w * rs * g.w);
                *((u32x2*)(XN + (size_t)row * DM) + 64 * j + lane) = p; } } }
}
__device__ __forceinline__ void phase0(const Ctx& c, LAS unsigned char* lds) {
    const int tid = otid(), wid = __builtin_amdgcn_readfirstlane(tid >> 6), lane = tid & 63;
    if (blockIdx.x == 0 && tid < 64) {
        const float xi = (float)tid / 63.0f;
        const float p = (float)exp((double)xi * 9.210340371976184);
        ((float*)(c.ws + WS_CTL + 256))[tid] = 1.0f / p;
    }
    LAS float* scr = (LAS float*)(lds + wid * 16384);
    const int gw = blockIdx.x * 8 + wid, NGW = gridDim.x * 8;
    bf16_t* XN = (bf16_t*)c.out;
    for (int row = gw; row < RT; row += 4 * NGW) rms_rows4_to_bf16(c, row, NGW, c.n_mix_pre, XN, lane);
    for (int p = gw; p < WI_IN / 2; p += NGW) wt_pair(c, p, lane, scr);
}

__device__ __forceinline__ void ret_prompt_item(const Ctx& c, LAS unsigned char* lds, int item) {
    const int tid = otid(), wid = __builtin_amdgcn_readfirstlane(tid >> 6), lane = tid & 63, fr = lane & 15, fq = lane >> 4;
    const int s = item & 3, h = (item >> 2) & 3, b = item >> 4;
    const float l2g = log2f(1.0f - exp2f(-5.0f - (float)h));
    unsigned char* act = c.ws + WS_ACT;
    const bf16_t* Q = (const bf16_t*)(act + A_Q); const bf16_t* Kg = (const bf16_t*)(act + A_K); const bf16_t* V = (const bf16_t*)(act + A_V); bf16_t* OB = (bf16_t*)c.out;
    float* SSQ = (float*)(c.ws + WS_SSQ);
    constexpr int LD = 136;
    LAS bf16_t* sQ = (LAS bf16_t*)lds; LAS bf16_t* sK = sQ + 128 * LD; LAS bf16_t* sKT = sK + 128 * LD; LAS bf16_t* sVT = sKT + 128 * LD; LAS bf16_t* sST = sVT + 64 * LD;
    for (int i = tid; i < 64 * LD / 2; i += 512) ((LAS unsigned*)sST)[i] = 0u;
    f32x4 Sacc[4];
#pragma unroll
    for (int e = 0; e < 4; ++e) Sacc[e] = (f32x4){0.f, 0.f, 0.f, 0.f};
    const float gC = exp2f(128.0f * l2g);
    const int il = 16 * wid + fr;
    u32x4 rq[4], rk[4]; unsigned kv[16], vv[8]; u32x2 sgv[4], sgc[4];
    const bf16_t* SGp = (const bf16_t*)(act + A_SG);
    const int dp = tid & 63, ep = tid & 31, jgv = tid >> 5;
    const int jgk = wid;
    const unsigned toq = (unsigned)(((tid >> 4) * 512 + (tid & 15) * 8) * 2);
    const unsigned tok = (unsigned)(2 * dp * 2);
    const unsigned tov = (unsigned)(((jgv * 8) * 1024 + 2 * ep) * 2);
    const unsigned tosg = (unsigned)((il * 1024 + 4 * fq) * 2);
#define RET_LOAD(CH) do { const size_t r0_ = (size_t)b * SEQ + (size_t)(CH) * 128; \
        const char* qb_ = (const char*)(Q + r0_ * 512 + h * 128); const char* kb_ = (const char*)(Kg + r0_ * 512 + h * 128); \
        const char* kt_ = (const char*)(Kg + (r0_ + jgk * 16) * 512 + h * 128); const char* vb_ = (const char*)(V + r0_ * 1024 + h * 256 + s * 64); \
        _Pragma("unroll") for (int i = 0; i < 4; ++i) { rq[i] = *(const u32x4*)(qb_ + (size_t)i * 32768 + toq); rk[i] = *(const u32x4*)(kb_ + (size_t)i * 32768 + toq); } \
        _Pragma("unroll") for (int jj = 0; jj < 16; ++jj) kv[jj] = *(const unsigned*)(kt_ + (size_t)jj * 1024 + tok); \
        _Pragma("unroll") for (int jj = 0; jj < 8; ++jj) vv[jj] = *(const unsigned*)(vb_ + (size_t)jj * 2048 + tov); \
        const char* sg_ = (const char*)(SGp + r0_ * 1024 + h * 256 + s * 64); \
        _Pragma("unroll") for (int et = 0; et < 4; ++et) sgv[et] = *(const u32x2*)(sg_ + (size_t)et * 32 + tosg); } while (0)
    RET_LOAD(0);
    for (int ch = 0; ch < SEQ / 128; ++ch) {
        const size_t r0 = (size_t)b * SEQ + (size_t)ch * 128;
#pragma unroll
        for (int i = 0; i < 4; ++i) { const int id = tid + 512 * i, row = id >> 4, cq = id & 15;
            *(LAS u32x4*)(sQ + row * LD + cq * 8) = rq[i]; *(LAS u32x4*)(sK + row * LD + cq * 8) = rk[i]; }
        {
            unsigned lo[8], hi[8];
#pragma unroll
            for (int jj = 0; jj < 16; jj += 2) {
                const float d0 = exp2f((float)(127 - (jgk * 16 + jj)) * l2g), d1 = exp2f((float)(127 - (jgk * 16 + jj + 1)) * l2g);
                lo[jj >> 1] = pk2(bflo(kv[jj]) * d0, bflo(kv[jj + 1]) * d1); hi[jj >> 1] = pk2(bfhi(kv[jj]) * d0, bfhi(kv[jj + 1]) * d1);
            }
            LAS u32x4* p0 = (LAS u32x4*)(sKT + (2 * dp) * LD + jgk * 16); LAS u32x4* p1 = (LAS u32x4*)(sKT + (2 * dp + 1) * LD + jgk * 16);
            p0[0] = (u32x4){lo[0], lo[1], lo[2], lo[3]}; p0[1] = (u32x4){lo[4], lo[5], lo[6], lo[7]};
            p1[0] = (u32x4){hi[0], hi[1], hi[2], hi[3]}; p1[1] = (u32x4){hi[4], hi[5], hi[6], hi[7]};
        }
        {
            u32x4 lo, hi;
            lo.x = (vv[0] & 0xffffu) | (vv[1] << 16); lo.y = (vv[2] & 0xffffu) | (vv[3] << 16); lo.z = (vv[4] & 0xffffu) | (vv[5] << 16); lo.w = (vv[6] & 0xffffu) | (vv[7] << 16);
            hi.x = (vv[0] >> 16) | (vv[1] & 0xffff0000u); hi.y = (vv[2] >> 16) | (vv[3] & 0xffff0000u); hi.z = (vv[4] >> 16) | (vv[5] & 0xffff0000u); hi.w = (vv[6] >> 16) | (vv[7] & 0xffff0000u);
            *(LAS u32x4*)(sVT + (2 * ep) * LD + jgv * 8) = lo; *(LAS u32x4*)(sVT + (2 * ep + 1) * LD + jgv * 8) = hi;
        }
#pragma unroll
        for (int et = 0; et < 4; ++et) sgc[et] = sgv[et];
        if (ch + 1 < SEQ / 128) RET_LOAD(ch + 1);
        __syncthreads();
        bf16x8 qf[4];
#pragma unroll
        for (int ks = 0; ks < 4; ++ks) qf[ks] = *(const LAS bf16x8*)(sQ + il * LD + ks * 32 + fq * 8);
        f32x4 sc[8];
#pragma unroll
        for (int jp = 0; jp < 8; jp += 2) {
            bf16x8 kf[2][4];
#pragma unroll
            for (int t = 0; t < 2; ++t)
#pragma unroll
                for (int ks = 0; ks < 4; ++ks) kf[t][ks] = *(const LAS bf16x8*)(sK + ((jp + t) * 16 + fr) * LD + ks * 32 + fq * 8);
#pragma unroll
            for (int t = 0; t < 2; ++t) { sc[jp + t] = (f32x4){0.f, 0.f, 0.f, 0.f};
#pragma unroll
                for (int ks = 0; ks < 4; ++ks) sc[jp + t] = __builtin_amdgcn_mfma_f32_16x16x32_bf16(kf[t][ks], qf[ks], sc[jp + t], 0, 0, 0); }
        }
        __syncthreads();
#pragma unroll
        for (int jt = 0; jt < 8; ++jt) { float pv[4];
#pragma unroll
            for (int jj = 0; jj < 4; ++jj) { const int df = il - (jt * 16 + 4 * fq + jj); pv[jj] = df >= 0 ? sc[jt][jj] * exp2f((float)df * l2g) : 0.f; }
            u32x2 w; w.x = pk2(pv[0], pv[1]); w.y = pk2(pv[2], pv[3]);
            *(LAS u32x2*)(sK + il * LD + jt * 16 + 4 * fq) = w; }
        LDS_WAIT(); __builtin_amdgcn_wave_barrier();
        f32x4 o[4];
#pragma unroll
        for (int ep2 = 0; ep2 < 4; ep2 += 2) {
            bf16x8 sf[2][4];
#pragma unroll
            for (int t = 0; t < 2; ++t)
#pragma unroll
                for (int ks = 0; ks < 4; ++ks) sf[t][ks] = *(const LAS bf16x8*)(sST + ((ep2 + t) * 16 + fr) * LD + ks * 32 + fq * 8);
#pragma unroll
            for (int t = 0; t < 2; ++t) { o[ep2 + t] = (f32x4){0.f, 0.f, 0.f, 0.f};
#pragma unroll
                for (int ks = 0; ks < 4; ++ks) o[ep2 + t] = __builtin_amdgcn_mfma_f32_16x16x32_bf16(sf[t][ks], qf[ks], o[ep2 + t], 0, 0, 0); }
        }
        const float qd = exp2f((float)(il + 1) * l2g);
#pragma unroll
        for (int et = 0; et < 4; ++et) { o[et] *= qd; Sacc[et] *= gC; }
#pragma unroll
        for (int k2 = 0; k2 < 4; k2 += 2) {
            bf16x8 pf[2], kf[2], vf[2][4];
#pragma unroll
            for (int t = 0; t < 2; ++t) { const int ks = k2 + t;
                pf[t] = *(const LAS bf16x8*)(sK + il * LD + ks * 32 + fq * 8); kf[t] = *(const LAS bf16x8*)(sKT + il * LD + ks * 32 + fq * 8);
#pragma unroll
                for (int et = 0; et < 4; ++et) vf[t][et] = *(const LAS bf16x8*)(sVT + (et * 16 + fr) * LD + ks * 32 + fq * 8); }
#pragma unroll
            for (int t = 0; t < 2; ++t)
#pragma unroll
                for (int et = 0; et < 4; ++et) { o[et] = __builtin_amdgcn_mfma_f32_16x16x32_bf16(vf[t][et], pf[t], o[et], 0, 0, 0);
                    Sacc[et] = __builtin_amdgcn_mfma_f32_16x16x32_bf16(kf[t], vf[t][et], Sacc[et], 0, 0, 0); }
        }
        float ss = 0.f;
#pragma unroll
        for (int et = 0; et < 4; ++et) { ss += (o[et][0] * o[et][0] + o[et][1] * o[et][1]) + (o[et][2] * o[et][2] + o[et][3] * o[et][3]);
            const float g0 = bflo(sgc[et].x), g1 = bfhi(sgc[et].x), g2 = bflo(sgc[et].y), g3 = bfhi(sgc[et].y);
            u32x2 w; w.x = pk2(o[et][0] * g0 * sigm(g0), o[et][1] * g1 * sigm(g1)); w.y = pk2(o[et][2] * g2 * sigm(g2), o[et][3] * g3 * sigm(g3));
            *(u32x2*)(OB + (r0 + il) * 1024 + h * 256 + s * 64 + et * 16 + 4 * fq) = w; }
        ss += __shfl_xor(ss, 16); ss += __shfl_xor(ss, 32);
        if (fq == 0) SSQ[(r0 + il) * 16 + h * 4 + s] = ss;
        __syncthreads();
#pragma unroll
        for (int et = 0; et < 4; ++et) { u32x2 w; w.x = pk2(Sacc[et][0], Sacc[et][1]); w.y = pk2(Sacc[et][2], Sacc[et][3]);
            *(LAS u32x2*)(sST + (et * 16 + fr) * LD + 16 * wid + 4 * fq) = w; }
    }
    float* nrp = c.out + O_NRP + ((size_t)(b * NH + h) * DK) * DV + s * 64;
#pragma unroll
    for (int et = 0; et < 4; ++et)
#pragma unroll
        for (int jj = 0; jj < 4; ++jj) nrp[(size_t)(16 * wid + 4 * fq + jj) * DV + et * 16 + fr] = Sacc[et][jj];
    __syncthreads();
#undef RET_LOAD
}

__device__ __forceinline__ float block_sum(float v, LAS float* red, int tid) {
    v = wave_sum(v);
    __syncthreads();
    if ((tid & 63) == 0) red[tid >> 6] = v;
    __syncthreads();
    float t = 0.f;
#pragma unroll
    for (int w = 0; w < 8; ++w) t += red[w];
    return t;
}

__device__ __forceinline__ void ret_sample_item(const Ctx& c, LAS unsigned char* lds, int item) {
    const int tid = otid(), b = item >> 2, h = item & 3, row = MP + b;
    unsigned char* act = c.ws + WS_ACT;
    const bf16_t* Q = (const bf16_t*)(act + A_Q) + (size_t)row * 512 + h * 128; const bf16_t* Kg = (const bf16_t*)(act + A_K) + (size_t)row * 512 + h * 128;
    const bf16_t* V = (const bf16_t*)(act + A_V) + (size_t)row * 1024 + h * 256; bf16_t* OB = (bf16_t*)c.out + (size_t)row * 1024 + h * 256;
    LAS float* sq = (LAS float*)lds; LAS float* sk = sq + 128; LAS float* red = sk + 128; LAS float* part = red + 16;
    if (tid < 128) sq[tid] = bf2f(Q[tid]); else if (tid < 256) sk[tid - 128] = bf2f(Kg[tid - 128]);
    __syncthreads();
    const float g = 1.0f - exp2f(-5.0f - (float)h);
    const int e4 = (tid & 63) * 4, dg = tid >> 6;
    const u32x2 vw = *(const u32x2*)(V + e4);
    const f32x4 vv = {bflo(vw.x), bfhi(vw.x), bflo(vw.y), bfhi(vw.y)};
    const float* Sin = c.state_ret + ((size_t)(b * NH + h) * DK + dg * 16) * DV + e4;
    float* Sout = c.out + O_NRS + ((size_t)(b * NH + h) * DK + dg * 16) * DV + e4;
    f32x4 oa = {0.f, 0.f, 0.f, 0.f};
    f32x4 sv[16];
#pragma unroll
    for (int dd = 0; dd < 16; ++dd) sv[dd] = __builtin_nontemporal_load((const f32x4*)(Sin + (size_t)dd * DV));
#pragma unroll
    for (int dd = 0; dd < 16; ++dd) { const float kd = sk[dg * 16 + dd], qd = sq[dg * 16 + dd];
        const f32x4 sn = sv[dd] * g + vv * kd; __builtin_nontemporal_store(sn, (f32x4*)(Sout + (size_t)dd * DV)); oa += sn * qd; }
    *(LAS f32x4*)(part + dg * 256 + e4) = oa;
    __syncthreads();
    float ov = 0.f;
    if (tid < 256) {
#pragma unroll
        for (int w = 0; w < 8; ++w) ov += part[w * 256 + tid];
    }
    const float tot = block_sum(ov * ov, red, tid);
    const float rs = 1.0f / sqrtf(tot * (1.0f / DV) + EPS);
    if (tid < 256) { const float g = bf2f(((const bf16_t*)(act + A_SG))[(size_t)row * 1024 + h * 256 + tid]); OB[tid] = (bf16_t)(pk2(g * sigm(g) * ov * rs, 0.f) & 0xffffu); }
    __syncthreads();
}

__device__ __forceinline__ void conv_prompt_item(const Ctx& c, LAS unsigned char* lds, int item) {
    const int tid = otid(), wid = tid >> 6, lane = tid & 63, b = item >> 6, t0 = (item & 63) * 32;
    unsigned char* act = c.ws + WS_ACT;
    const bf16_t* U = (const bf16_t*)(act + A_U) + (size_t)b * SEQ * 512; bf16_t* AA = (bf16_t*)(act + A_AACT) + (size_t)b * SEQ * 512;
    LAS bf16_t* sU = (LAS bf16_t*)lds; LAS float* sC = (LAS float*)(lds + 63488);
    {
        u32x4 uv[8];
#pragma unroll
        for (int i = 0; i < 8; ++i) { const int id = tid + 512 * i, lr = id >> 6, cq = id & 63, t = t0 - 30 + lr;
            uv[i] = (u32x4){0u, 0u, 0u, 0u}; if (t >= 0 && lr < 62) uv[i] = __builtin_nontemporal_load((const u32x4*)(U + (size_t)t * 512 + cq * 8)); }
#pragma unroll
        for (int i = 0; i < 8; ++i) { const int id = tid + 512 * i, lr = id >> 6, cq = id & 63;
            if (lr < 62) *(LAS u32x4*)(sU + lr * 512 + cq * 8) = uv[i]; }
    }
    float wreg[CW];
#pragma unroll
    for (int w = 0; w < CW; ++w) wreg[w] = c.w_dw[w * CD + tid];
    const float bias = c.b_dw[tid];
    __syncthreads();
#pragma unroll 1
    for (int tb = 0; tb < 4; ++tb) {
        float a[8];
#pragma unroll
        for (int o = 0; o < 8; ++o) a[o] = bias;
#pragma unroll
        for (int k = 0; k < 38; ++k) { const float u = bf2f(sU[(tb * 8 + k) * 512 + tid]);
#pragma unroll
            for (int o = 0; o < 8; ++o) { const int w = k - o; if (w >= 0 && w < CW) a[o] += u * wreg[w]; } }
#pragma unroll
        for (int o = 0; o < 8; ++o) sC[(tb * 8 + o) * 512 + tid] = a[o];
    }
    __syncthreads();
    const f32x4 g0 = *(const f32x4*)(c.ln_w + lane * 4), g1 = *(const f32x4*)(c.ln_w + 256 + lane * 4), b0 = *(const f32x4*)(c.ln_b + lane * 4), b1 = *(const f32x4*)(c.ln_b + 256 + lane * 4);
    for (int rr = wid; rr < 32; rr += 8) {
        f32x4 x0 = *(const LAS f32x4*)(sC + rr * 512 + lane * 4), x1 = *(const LAS f32x4*)(sC + rr * 512 + 256 + lane * 4);
        const float mean = wave_sum((x0.x + x0.y) + (x0.z + x0.w) + (x1.x + x1.y) + (x1.z + x1.w)) * (1.0f / CD);
        x0 -= mean; x1 -= mean;
        const float var = wave_sum((x0.x * x0.x + x0.y * x0.y) + (x0.z * x0.z + x0.w * x0.w) + (x1.x * x1.x + x1.y * x1.y) + (x1.z * x1.z + x1.w * x1.w)) * (1.0f / CD);
        const float rstd = 1.0f / sqrtf(var + EPS);
        f32x4 y0 = x0 * rstd * g0 + b0, y1 = x1 * rstd * g1 + b1;
#pragma unroll
        for (int j = 0; j < 4; ++j) { y0[j] = y0[j] * sigm(y0[j]); y1[j] = y1[j] * sigm(y1[j]); }
        u32x2 w0, w1; w0.x = pk2(y0.x, y0.y); w0.y = pk2(y0.z, y0.w); w1.x = pk2(y1.x, y1.y); w1.y = pk2(y1.z, y1.w);
        bf16_t* dst = AA + (size_t)(t0 + rr) * 512;
        *(u32x2*)(dst + lane * 4) = w0; *(u32x2*)(dst + 256 + lane * 4) = w1;
    }
    if (t0 == SEQ - 32) {
        float* ncp = c.out + O_NCP + (size_t)b * 30 * CD;
        for (int id = tid; id < 30 * CD; id += 512) ncp[id] = bf2f(sU[(32 + (id >> 9)) * 512 + (id & 511)]);
    }
    __syncthreads();
}

__device__ __forceinline__ void conv_sample_item(const Ctx& c, LAS unsigned char* lds, int b) {
    const int tid = otid();
    unsigned char* act = c.ws + WS_ACT;
    LAS float* red = (LAS float*)lds;
    const float* cache = c.cache_conv + (size_t)b * 30 * CD; float* ncs = c.out + O_NCS + (size_t)b * 30 * CD;
    float acc = c.b_dw[tid];
#pragma unroll 1
    for (int w0 = 0; w0 < 30; w0 += 10) {
        float cv[10], wv[10];
#pragma unroll
        for (int w = 0; w < 10; ++w) { cv[w] = __builtin_nontemporal_load(cache + (w0 + w) * CD + tid); wv[w] = c.w_dw[(w0 + w) * CD + tid]; }
#pragma unroll
        for (int w = 0; w < 10; ++w) { acc += cv[w] * wv[w]; if (w0 + w >= 1) __builtin_nontemporal_store(cv[w], ncs + (w0 + w - 1) * CD + tid); }
    }
    const float u = bf2f(((const bf16_t*)(act + A_U))[(size_t)(MP + b) * 512 + tid]);
    acc += u * c.w_dw[30 * CD + tid]; ncs[29 * CD + tid] = u;
    const float mean = block_sum(acc, red, tid) * (1.0f / CD);
    const float d = acc - mean;
    const float var = block_sum(d * d, red, tid) * (1.0f / CD);
    float y = d * (1.0f / sqrtf(var + EPS)) * c.ln_w[tid] + c.ln_b[tid];
    y = y * sigm(y);
    ((bf16_t*)(act + A_AACT))[(size_t)(MP + b) * 512 + tid] = (bf16_t)(pk2(y, 0.f) & 0xffffu);
    __syncthreads();
}

__device__ __forceinline__ void phase2(const Ctx& c, LAS unsigned char* lds, int rep) {
    for (int it = blockIdx.x; it < NB * NH * 4; it += gridDim.x) { const int x = it & 7, j = it >> 3; ret_prompt_item(c, lds, (x * 4 + (j >> 2)) * 4 + (j & 3)); }
    unsigned* counter = (unsigned*)(c.ws + WS_CTL) + rep;
    LAS int* sItem = (LAS int*)(lds + LDS_BYTES - 16);
    constexpr int N_CONV = MP / 32, N_RS = MS * NH, N_CS = MS, N_WQ = (WI_TOTAL - WI_IN) / 16, NTOT = N_CONV + N_RS + N_CS + N_WQ;
    static_assert((WI_TOTAL - WI_IN) % 16 == 0, "weight queue items");
    unsigned nxt = 0u;
    if (threadIdx.x == 0) nxt = atomicAdd(counter, 1u);
    for (;;) {
        if (threadIdx.x == 0) { *sItem = (int)nxt; nxt = atomicAdd(counter, 1u); }
        __syncthreads();
        const int it = __builtin_amdgcn_readfirstlane(*sItem);
        __syncthreads();
        if (it >= NTOT) break;
        if (it < N_CS) conv_sample_item(c, lds, it);
        else if (it < N_CS + N_CONV) conv_prompt_item(c, lds, it - N_CS);
        else if (it < N_CS + N_CONV + N_RS) ret_sample_item(c, lds, it - N_CS - N_CONV);
        else { const int t_ = otid(); const int wv = __builtin_amdgcn_readfirstlane(t_ >> 6);
            wt_pair(c, WI_IN / 2 + (it - N_CS - N_CONV - N_RS) * 8 + wv, t_ & 63, (LAS float*)(lds + wv * 16384)); __syncthreads(); }
    }
}

__device__ __forceinline__ void phase2b(const Ctx& c) {
    const int t_ = otid(); const int lane = t_ & 63, gw = blockIdx.x * 8 + (t_ >> 6), NGW = gridDim.x * 8;
    unsigned char* act = c.ws + WS_ACT;
    const float* SSQ = (const float*)(c.ws + WS_SSQ);
    for (int row0 = gw; row0 < RT; row0 += 4 * NGW) {
        u32x4 a[4][2], o[4][2]; float rs[4];
#pragma unroll
        for (int r = 0; r < 4; ++r) { const int row = row0 + r * NGW; rs[r] = 1.0f;
            if (row < RT) {
                const u32x4* sg = (const u32x4*)((bf16_t*)(act + A_SG) + (size_t)row * 1024 + lane * 16);
                const u32x4* ov = (const u32x4*)((const bf16_t*)c.out + (size_t)row * 1024 + lane * 16);
#pragma unroll
                for (int j = 0; j < 2; ++j) { a[r][j] = __builtin_nontemporal_load(sg + j); o[r][j] = __builtin_nontemporal_load(ov + j); }
                if (row < MP) { const f32x4 q = *(const f32x4*)(SSQ + (size_t)row * 16 + (lane >> 4) * 4); rs[r] = 1.0f / sqrtf(((q.x + q.y) + (q.z + q.w)) * (1.0f / DV) + EPS); }
            } }
#pragma unroll
        for (int r = 0; r < 4; ++r) { const int row = row0 + r * NGW;
            if (row < RT) { u32x4* dg = (u32x4*)((bf16_t*)(act + A_SG) + (size_t)row * 1024 + lane * 16); const float k = rs[r];
#pragma unroll
                for (int j = 0; j < 2; ++j) { const u32x4 x = a[r][j], y = o[r][j]; u32x4 w;
                    w.x = pk2(bflo(x.x) * bflo(y.x) * k, bfhi(x.x) * bfhi(y.x) * k); w.y = pk2(bflo(x.y) * bflo(y.y) * k, bfhi(x.y) * bfhi(y.y) * k);
                    w.z = pk2(bflo(x.z) * bflo(y.z) * k, bfhi(x.z) * bfhi(y.z) * k); w.w = pk2(bflo(x.w) * bflo(y.w) * k, bfhi(x.w) * bfhi(y.w) * k);
                    dg[j] = w; } } }
    }
}


#define XB_TMO      128
#define XB_XCNT(j)  (256  + 64 * (j))
#define XB_XSUB(j)  (1280 + 64 * (j))
#define XB_XGEN(j)  (2304 + 64 * (j))
#define XB_TOP      3328
#define XB_TOPGEN   3392
#define XCD_BAR_WORDS 3456
#define XB_SPIN_CAP (1u << 22)
__device__ __forceinline__ unsigned xb_ld(unsigned* p)              { return __hip_atomic_load(p, __ATOMIC_RELAXED, __HIP_MEMORY_SCOPE_AGENT); }
__device__ __forceinline__ unsigned xb_add(unsigned* p, unsigned v) { return __hip_atomic_fetch_add(p, v, __ATOMIC_RELAXED, __HIP_MEMORY_SCOPE_AGENT); }
__device__ __forceinline__ unsigned xb_xcc_id() { return (unsigned)__builtin_amdgcn_s_getreg((3 << 11) | 20) & 0xFu; }
#define XB_SPIN(cond, bar) do { unsigned _sp = 0; while (cond) { __builtin_amdgcn_s_sleep(1); \
    if ((++_sp & 255u) == 0u) { if (xb_ld(&(bar)[XB_TMO])) break; if (_sp > XB_SPIN_CAP) { atomicAdd(&(bar)[XB_TMO], 1u); break; } } } } while (0)
struct XcdBarrier { unsigned* bar; unsigned x; volatile LAS unsigned* st; };
__device__ __forceinline__ XcdBarrier xcd_barrier_post(unsigned* bar, volatile LAS unsigned* st) {
    XcdBarrier b; b.bar = bar; b.x = xb_xcc_id(); b.st = st;
    if (threadIdx.x == 0) (void)xb_add(&bar[XB_XCNT(b.x)], 1u);
    return b;
}
__device__ __forceinline__ void xcd_barrier_complete(unsigned* bar, unsigned x, unsigned& nloc, unsigned& nx) {
    const unsigned G = gridDim.x * gridDim.y * gridDim.z;
    unsigned sum, cnt, mine, sp = 0u;
    for (;;) {
        sum = 0u; cnt = 0u; mine = 0u;
#pragma unroll
        for (unsigned j = 0; j < 16; ++j) { const unsigned c = xb_ld(&bar[XB_XCNT(j)]); sum += c; cnt += (c > 0u) ? 1u : 0u; mine = (j == x) ? c : mine; }
        if (sum == G) break;
        __builtin_amdgcn_s_sleep(1);
        if ((++sp & 255u) == 0u) { if (xb_ld(&bar[XB_TMO])) break; if (sp > XB_SPIN_CAP) { atomicAdd(&bar[XB_TMO], 1u); break; } }
    }
    nloc = mine > 0u ? mine : 1u; nx = cnt > 0u ? cnt : 1u;
}
__device__ __forceinline__ void xcd_barrier(const XcdBarrier& b) {
    asm volatile("s_waitcnt vmcnt(0)" ::: "memory");
    __syncthreads();
    if (threadIdx.x == 0) {
        unsigned* bar = b.bar;
        __builtin_amdgcn_s_waitcnt(0);
        unsigned nloc = b.st[0], nx = b.st[1];
        if (nloc == 0u) { xcd_barrier_complete(bar, b.x, nloc, nx); b.st[0] = nloc; b.st[1] = nx; }
        const unsigned old = xb_add(&bar[XB_XSUB(b.x)], 1u);
        const unsigned gen = old / nloc;
        if (old + 1u == (gen + 1u) * nloc) {
            __builtin_amdgcn_fence(__ATOMIC_RELEASE, "agent");
            asm volatile("s_waitcnt vmcnt(0)" ::: "memory");
            const unsigned og = xb_add(&bar[XB_TOP], 1u);
            const unsigned tg = og / nx;
            if (og + 1u == (tg + 1u) * nx) xb_add(&bar[XB_TOPGEN], 1u);
            else XB_SPIN(xb_ld(&bar[XB_TOPGEN]) == tg, bar);
            __builtin_amdgcn_fence(__ATOMIC_ACQUIRE, "agent");
            xb_add(&bar[XB_XGEN(b.x)], 1u);
            asm volatile("s_waitcnt vmcnt(0)" ::: "memory");
        } else {
            XB_SPIN(xb_ld(&bar[XB_XGEN(b.x)]) == gen, bar);
            __builtin_amdgcn_fence(__ATOMIC_ACQUIRE, "agent");
            asm volatile("s_waitcnt vmcnt(0)" ::: "memory");
        }
    }
    __syncthreads();
}

__global__ void __launch_bounds__(512) fwd_megakernel(Ctx c) {
    extern __shared__ __attribute__((aligned(16))) unsigned char smem[];
    LAS unsigned char* lds = (LAS unsigned char*)smem;
    cg::grid_group grid = cg::this_grid();
    unsigned char* act = c.ws + WS_ACT;
    volatile LAS unsigned* xst = (volatile LAS unsigned*)(lds + LDS_BYTES - 32);
    if (threadIdx.x == 0) { xst[0] = 0u; xst[1] = 0u; }
    __syncthreads();
    const XcdBarrier xb = xcd_barrier_post((unsigned*)(c.ws + WS_BAR), xst);
    phase0(c, lds);
    if (c.ws == nullptr) grid.sync();
    xcd_barrier(xb);
    gemm_all<EK_IN, NIN, DM, 3, Epi<EK_IN>, true>(c, lds, (const bf16_t*)c.out, (const bf16_t*)(c.ws + WS_WIN));
    xcd_barrier(xb);
    phase2(c, lds, 0);
    xcd_barrier(xb);
    gemm_all<EK_CO, DM, CD, 1, Epi<EK_CO>, true>(c, lds, (const bf16_t*)(act + A_AACT), (const bf16_t*)(c.ws + WS_WCO));
    gemm_all<EK_RO, DM, DM, 1, Epi<EK_RO>, true, true>(c, lds, (const bf16_t*)c.out, (const bf16_t*)(c.ws + WS_WRO));
    xcd_barrier(xb);
    gemm_all<EK_WO, DM, DM, 1, EpiWoFused>(c, lds, (const bf16_t*)(act + A_SB), (const bf16_t*)(c.ws + WS_WO));
    xcd_barrier(xb);
    gemm_all<EK_UP, FF, DM, 4, Epi<EK_UP>, true, false, true>(c, lds, (const bf16_t*)(act + A_M2), (const bf16_t*)(c.ws + WS_WUP));
    xcd_barrier(xb);
    gemm_all<EK_DN, DM, FF, 1, EpiDnFused>(c, lds, (const bf16_t*)(act + A_UP), (const bf16_t*)(c.ws + WS_WDN));
}

extern "C" void kernel_launch(void* const* d_in, const int* in_sizes, int n_in, void* d_out, int out_size, void* d_ws, size_t ws_size, hipStream_t stream) {
    static int grid_blocks = 0;
    if (!grid_blocks) {
        if (n_in != 18 || ws_size < WS_END3) { fprintf(stderr, "kernel_launch: unexpected n_in %d / ws_size %zu (need %zu)\n", n_in, ws_size, (size_t)WS_END3); grid_blocks = -1; return; }
        int dev = 0, cus = 0, per_cu = 0;
        hipGetDevice(&dev);
        hipDeviceGetAttribute(&cus, hipDeviceAttributeMultiprocessorCount, dev);
        if (hipFuncSetAttribute((const void*)fwd_megakernel, hipFuncAttributeMaxDynamicSharedMemorySize, LDS_BYTES) != hipSuccess) fprintf(stderr, "kernel_launch: hipFuncSetAttribute failed\n");
        hipOccupancyMaxActiveBlocksPerMultiprocessor(&per_cu, (const void*)fwd_megakernel, 512, LDS_BYTES);
        (void)hipGetLastError();
        if (per_cu < 1) { fprintf(stderr, "kernel_launch: occupancy query says %d blocks per CU\n", per_cu); per_cu = 1; }
        grid_blocks = cus * per_cu; if (grid_blocks > 256) grid_blocks = 256;
    }
    if (grid_blocks < 0) return;
    (void)hipMemsetAsync((char*)d_ws + WS_CTL, 0, CTL_ZERO, stream);
    Ctx c{};
    const float** f = (const float**)&c;
    for (int i = 0; i < 18; ++i) f[i] = (const float*)d_in[i];
    c.out = (float*)d_out; c.ws = (unsigned char*)d_ws;
    void* args[] = {&c};
    hipError_t e = hipLaunchCooperativeKernel((const void*)fwd_megakernel, dim3(grid_blocks), dim3(512), args, LDS_BYTES, stream);
    if (e != hipSuccess) fprintf(stderr, "cooperative launch failed: %s (grid %d)\n", hipGetErrorString(e), grid_blocks);
}
```

```cpp
#include <hip/hip_runtime.h>
#include <hip/hip_cooperative_groups.h>
#include <cstdio>
#include <cstdint>
namespace cg = cooperative_groups;

#define LAS __attribute__((address_space(3)))
typedef unsigned short bf16_t;
typedef short bf16x8 __attribute__((ext_vector_type(8)));
typedef float f32x4 __attribute__((ext_vector_type(4)));
typedef unsigned u32x4 __attribute__((ext_vector_type(4)));
typedef unsigned u32x2 __attribute__((ext_vector_type(2)));

constexpr int DM = 1024, NB = 8, SEQ = 2048, MP = NB * SEQ  , MS = 128, RT = MP + MS  ;
constexpr int CD = 512, CW = 31, NH = 4, DK = 128, DV = 256, FF = 4096, NIN = 6144;
constexpr float EPS = 1e-6f;
constexpr size_t O_NCP = (size_t)RT * DM;
constexpr size_t O_NRP = O_NCP + (size_t)NB * 30 * CD;
constexpr size_t O_NCS = O_NRP + (size_t)NB * NH * DK * DV;
constexpr size_t O_NRS = O_NCS + (size_t)MS * 30 * CD;
constexpr size_t WS_CTL = 0, WS_BAR = 4096, WS_WIN = 131072, WS_WCO = WS_WIN + (size_t)NIN * DM * 2, WS_WRO = WS_WCO + (size_t)DM * CD * 2,
                 WS_WO = WS_WRO + (size_t)DM * DM * 2, WS_WUP = WS_WO + (size_t)DM * DM * 2, WS_WDN = WS_WUP + (size_t)FF * DM * 2,
                 WS_ACT = WS_WDN + (size_t)FF * DM * 2;
constexpr size_t A_U = 0, A_Q = A_U + (size_t)RT * 512 * 2, A_K = A_Q + (size_t)RT * 512 * 2, A_V = A_K + (size_t)RT * 512 * 2,
                 A_SG = A_V + (size_t)RT * 1024 * 2, A_SA = A_SG + (size_t)RT * 1024 * 2, A_SB = A_SA + (size_t)RT * 1024 * 2,
                 A_AACT = A_SB + (size_t)RT * 1024 * 2, A_END = A_AACT + (size_t)RT * 512 * 2;
constexpr size_t A_M2 = (size_t)RT * 1024 * 2  , A_HN = 0  , A_F = 0  , A_UP = (size_t)RT * 1024 * 4;
static_assert(A_UP + (size_t)RT * FF * 2 <= A_END, "act region");
constexpr size_t WS_SSQ = WS_ACT + A_END, WS_END = WS_SSQ + (size_t)MP * 16 * 4;
constexpr size_t WS_XCH = WS_END;
constexpr size_t WS_XCHS = WS_XCH + 2 * 64 * 256 * 4 * 8;
constexpr size_t WS_XCH2 = WS_XCHS + 3 * 8 * 16 * 32 * 8;
constexpr size_t WS_END2 = WS_XCH2 + 64 * 256 * 4 * 4;
constexpr size_t XCH_WORDS = (WS_XCH2 - WS_XCH) / 8;
constexpr size_t CTL_XCNT = 20480;
constexpr size_t CTL_XCNTS = CTL_XCNT + 3 * 64 * 256;
constexpr size_t CTL_ZERO = CTL_XCNTS + 3 * 8 * 256;
static_assert(CTL_ZERO <= WS_WIN, "control words");
constexpr size_t WS_RS2S = WS_END2;
constexpr size_t WS_END3 = WS_RS2S + 128 * 4;
constexpr int LDS_BYTES = 147456;

struct Ctx {
    const float *xp, *xs, *cache_conv, *state_ret, *n_mix_pre, *n_mix_post, *w_in, *w_dw, *b_dw, *ln_w, *ln_b, *w_co, *w_ro, *w_o,
        *n_ffn_pre, *n_ffn_post, *w_up, *w_dn;
    float* out; unsigned char* ws;
};

__device__ __forceinline__ unsigned pk2(float lo, float hi) { unsigned r; asm volatile("v_cvt_pk_bf16_f32 %0, %1, %2" : "=v"(r) : "v"(lo), "v"(hi)); return r; }
__device__ __forceinline__ float bflo(unsigned w) { return __uint_as_float(w << 16); }
__device__ __forceinline__ float bfhi(unsigned w) { return __uint_as_float(w & 0xffff0000u); }
__device__ __forceinline__ float bf2f(bf16_t b) { return __uint_as_float(((unsigned)b) << 16); }
__device__ __forceinline__ float sigm(float x) { return __builtin_amdgcn_rcpf(1.0f + __expf(-x)); }
__device__ __forceinline__ float wave_sum(float v) {
#pragma unroll
    for (int o = 1; o < 64; o <<= 1) v += __shfl_xor(v, o);
    return v;
}
#define LDS_WAIT() asm volatile("s_waitcnt lgkmcnt(0)" ::: "memory")
__device__ __forceinline__ int otid() { int t = threadIdx.x; asm volatile("" : "+v"(t)); return t; }
__device__ __forceinline__ const float* xrow(const Ctx& c, int row) { return row < MP ? c.xp + (size_t)row * DM : c.xs + (size_t)(row - MP) * DM; }

namespace pg8 {
constexpr int BM = 256, BK = 64, HALF = 128, HTB = HALF * BK * 2, STAGE_BYTES = 8 * HTB, NXCD = 8, WGM = 8;
__host__ __device__ __forceinline__ int lds_byte(int r, int c) { const int st = (r >> 4) * 2 + (c >> 5), rr = r & 15, cc = c & 31, ob = rr * 64 + cc * 2; return st * 1024 + (ob ^ (((ob >> 9) & 1) << 5)); }
__host__ __device__ __forceinline__ void stage_rc(int b, int& R, int& C) { const int st = b / 1024, sb = b % 1024, swz = sb ^ (((sb >> 9) & 1) << 5); R = (st >> 1) * 16 + swz / 64; C = (st & 1) * 32 + (swz % 64) / 2; }
__host__ __device__ __forceinline__ int perm32(int rho) { const int n = rho >> 4, i = rho & 15; return 8 * (i >> 2) + 4 * n + (i & 3); }
struct Unit { int pm, pn; };
struct Gemm { const bf16_t* A; const bf16_t* Bt; int M, N, K; const float* ssq = nullptr; };
struct StaticOrder {
    int nM, nN, nwg, G, c;
    __device__ void init(int M, int N, int G_, int c_) { nM = M / BM; nN = N / BM; nwg = nM * nN; G = G_; c = c_; }
    __device__ bool next(int i, Unit& u) const {
        const long L = (long)i * G + c; if (L >= nwg) return false;
        int wgid = (int)L; { const int q = nwg / NXCD, r = nwg % NXCD, xcd = wgid % NXCD, off = wgid / NXCD; wgid = (xcd < r ? xcd * (q + 1) : r * (q + 1) + (xcd - r) * q) + off; }
        const int nig = WGM * nN, gid = wgid / nig, fm = gid * WGM, gsz = (nM - fm) < WGM ? (nM - fm) : WGM;
        u.pm = fm + ((wgid % nig) % gsz); u.pn = (wgid % nig) / gsz; return true;
    }
};
template <class Epi, bool ALIGN_EPI = false, bool SP2 = true, bool HNORM = false, bool RS2TAB = false>
__device__ __forceinline__ void gemm_phase(LAS unsigned char* lds, const Gemm g, const StaticOrder& S, const Epi& E) {
    int tid_ = threadIdx.x; asm volatile("" : "+v"(tid_));
    const int tid = tid_, wid = __builtin_amdgcn_readfirstlane(tid >> 6), lane = tid & 63, wr = wid >> 2, wc = wid & 3, fr = lane & 15, fq = lane >> 4;
    const int K = g.K, nt = K / BK;
    unsigned voffA[2], voffB[2];
#pragma unroll
    for (int i = 0; i < 2; ++i) { int R, C; stage_rc(tid * 16 + i * 8192, R, C); const int Rb = (R & ~31) + perm32(R & 31);
        voffA[i] = (unsigned)(R * K + C) * 2u; voffB[i] = (unsigned)(Rb * K + C) * 2u; }
    const size_t kstep = (size_t)(BK * 2);
    const size_t hstep = (size_t)HALF * K * 2;
    const size_t tstep = 2 * hstep;
    const unsigned ldsw = (unsigned)wid * 1024u;
    const int aoff = lds_byte(wr * 64 + fr, fq * 8), boff = lds_byte(wc * 32 + fr, fq * 8);
#define PG8_SA(b, h) (((b) * 2 + (h)) * HTB)
#define PG8_SB(b, h) ((4 + (b) * 2 + (h)) * HTB)
#define PG8_STAGE(bufoff, gbase, voff) do { _Pragma("unroll") for (int _i = 0; _i < 2; ++_i) \
        __builtin_amdgcn_global_load_lds((const unsigned*)((const char*)(gbase) + (voff)[_i]), (LAS unsigned*)(lds + (bufoff) + ldsw + _i * 8192), 16, 0, 0); } while (0)
#define PG8_LDA(dst, b, h) do { _Pragma("unroll") for (int m = 0; m < 4; ++m) _Pragma("unroll") for (int k = 0; k < 2; ++k) dst[m][k] = *(const LAS bf16x8*)(lds + PG8_SA(b, h) + aoff + m * 2048 + k * 1024); } while (0)
#define PG8_LDB(dst, b, h) do { _Pragma("unroll") for (int n = 0; n < 2; ++n) _Pragma("unroll") for (int k = 0; k < 2; ++k) dst[n][k] = *(const LAS bf16x8*)(lds + PG8_SB(b, h) + boff + n * 2048 + k * 1024); } while (0)
#define PG8_MMA(ai, bj, At, Bt) do { __builtin_amdgcn_s_setprio(1); _Pragma("unroll") for (int m = 0; m < 4; ++m) _Pragma("unroll") for (int n = 0; n < 2; ++n) _Pragma("unroll") for (int k = 0; k < 2; ++k) \
        acc[ai][bj][m][n] = __builtin_amdgcn_mfma_f32_16x16x32_bf16(Bt[n][k], At[m][k], acc[ai][bj][m][n], 0, 0, 0); __builtin_amdgcn_s_setprio(0); } while (0)
#define PG8_WAIT_V(n) asm volatile("s_waitcnt vmcnt(" #n ")" ::: "memory")
#define PG8_WAIT_L(n) asm volatile("s_waitcnt lgkmcnt(" #n ")" ::: "memory")
#define PG8_BAR __builtin_amdgcn_s_barrier()
#define PG8_SCHED __builtin_amdgcn_sched_barrier(0)
    Unit cur, nxt; int ui = 0;
    if (!S.next(0, cur)) return;
    f32x4 acc[2][2][4][2];
#pragma unroll
    for (int a = 0; a < 2; ++a)
#pragma unroll
        for (int b = 0; b < 2; ++b)
#pragma unroll
            for (int m = 0; m < 4; ++m)
#pragma unroll
                for (int n = 0; n < 2; ++n) acc[a][b][m][n] = (f32x4){0.f, 0.f, 0.f, 0.f};
    bf16x8 At[4][2], B0[2][2], B1[2][2];
    const char* cA = (const char*)g.A + (size_t)cur.pm * tstep; const char* cB = (const char*)g.Bt + (size_t)cur.pn * tstep;
    LAS float* hrt = (LAS float*)(lds + STAGE_BYTES);
    if constexpr (RS2TAB) {
        if (tid < 256) { const f32x4 q = *(const f32x4*)(g.ssq + (size_t)(cur.pm * 256 + tid) * 4); hrt[tid] = 1.0f / sqrtf(((q.x + q.y) + (q.z + q.w)) * (1.0f / 1024.0f) + 1e-6f); }
        asm volatile("s_waitcnt vmcnt(0) lgkmcnt(0)" ::: "memory"); PG8_BAR;
    }
    if constexpr (HNORM) {
        if (tid < 256) { const float* q = g.ssq + (size_t)(cur.pm * 256 + tid) * 16; float r[4];
#pragma unroll
            for (int hh = 0; hh < 4; ++hh) { const f32x4 v = *(const f32x4*)(q + 4 * hh); r[hh] = 1.0f / sqrtf(((v.x + v.y) + (v.z + v.w)) * (1.0f / 256.0f) + 1e-6f); }
            *(LAS f32x4*)(hrt + tid * 4) = (f32x4){r[0] / r[1], r[1] / r[2], r[2] / r[3], r[3]}; }
        asm volatile("s_waitcnt vmcnt(0) lgkmcnt(0)" ::: "memory"); PG8_BAR;
    }
    if constexpr (SP2) {
        PG8_STAGE(PG8_SB(0, 0), cB, voffB); PG8_STAGE(PG8_SB(0, 1), cB + hstep, voffB); PG8_STAGE(PG8_SA(0, 0), cA, voffA); PG8_STAGE(PG8_SA(0, 1), cA + hstep, voffA);
        if (wr == 1) PG8_BAR;
        PG8_WAIT_V(2); PG8_BAR;
        PG8_STAGE(PG8_SB(1, 0), cB + kstep, voffB); PG8_STAGE(PG8_SA(1, 0), cA + kstep, voffA); PG8_STAGE(PG8_SB(1, 1), cB + hstep + kstep, voffB);
        PG8_WAIT_V(6); PG8_BAR;
    } else {
    PG8_STAGE(PG8_SB(0, 0), cB, voffB); PG8_STAGE(PG8_SA(0, 0), cA, voffA); PG8_STAGE(PG8_SB(0, 1), cB + hstep, voffB); PG8_STAGE(PG8_SA(0, 1), cA + hstep, voffA);
    if (wr == 1) PG8_BAR;
    PG8_WAIT_V(4); PG8_BAR;
    PG8_STAGE(PG8_SB(1, 0), cB + kstep, voffB); PG8_STAGE(PG8_SA(1, 0), cA + kstep, voffA); PG8_STAGE(PG8_SB(1, 1), cB + hstep + kstep, voffB);
    PG8_WAIT_V(6); PG8_BAR;
    }
    for (;;) {
        const bool has_next = S.next(ui + 1, nxt);
        const char* nA = has_next ? (const char*)g.A + (size_t)nxt.pm * tstep : cA; const char* nB = has_next ? (const char*)g.Bt + (size_t)nxt.pn * tstep : cB;
        for (int t = 0; t < nt; t += 2) {
            const bool last = (t == nt - 2);
            const char* a1 = cA + (size_t)(t + 1) * kstep;
            const char* a2 = last ? nA : cA + (size_t)(t + 2) * kstep; const char* b2 = last ? nB : cB + (size_t)(t + 2) * kstep;
            const char* a3 = a2 + kstep; const char* b3 = b2 + kstep;
            if constexpr (HNORM) { if (t == 4 || t == 8 || t == 12) { const int hi = (t >> 2) - 1;
#pragma unroll
                for (int ai = 0; ai < 2; ++ai)
#pragma unroll
                    for (int m = 0; m < 4; ++m) { const float f = hrt[(ai * 128 + wr * 64 + m * 16 + fr) * 4 + hi];
#pragma unroll
                        for (int bj = 0; bj < 2; ++bj)
#pragma unroll
                            for (int n = 0; n < 2; ++n) acc[ai][bj][m][n] *= f; } } }
            if constexpr (SP2) {
            PG8_LDB(B0, 0, 0); PG8_LDB(B1, 0, 1); PG8_SCHED; PG8_LDA(At, 0, 0); PG8_STAGE(PG8_SA(1, 1), a1 + hstep, voffA);
            PG8_WAIT_V(8); PG8_WAIT_L(0); PG8_BAR; PG8_MMA(0, 0, At, B0); PG8_MMA(0, 1, At, B1); PG8_BAR; PG8_SCHED;
            PG8_LDA(At, 0, 1); PG8_STAGE(PG8_SB(0, 0), b2, voffB); PG8_STAGE(PG8_SB(0, 1), b2 + hstep, voffB); PG8_STAGE(PG8_SA(0, 0), a2, voffA);
            PG8_WAIT_V(8); PG8_WAIT_L(0); PG8_BAR; PG8_MMA(1, 0, At, B0); PG8_MMA(1, 1, At, B1); PG8_BAR; PG8_SCHED;
            PG8_LDB(B0, 1, 0); PG8_LDB(B1, 1, 1); PG8_SCHED; PG8_LDA(At, 1, 0); PG8_STAGE(PG8_SA(0, 1), a2 + hstep, voffA);
            PG8_WAIT_V(8); PG8_WAIT_L(0); PG8_BAR; PG8_MMA(0, 0, At, B0); PG8_MMA(0, 1, At, B1); PG8_BAR; PG8_SCHED;
            PG8_LDA(At, 1, 1); PG8_STAGE(PG8_SB(1, 0), b3, voffB); PG8_STAGE(PG8_SB(1, 1), b3 + hstep, voffB); PG8_STAGE(PG8_SA(1, 0), a3, voffA);
            PG8_WAIT_V(8); PG8_WAIT_L(0); PG8_BAR; PG8_MMA(1, 0, At, B0); PG8_MMA(1, 1, At, B1); PG8_BAR; PG8_SCHED;
            } else {
            PG8_LDB(B0, 0, 0); PG8_SCHED; PG8_LDA(At, 0, 0); PG8_STAGE(PG8_SA(1, 1), a1 + hstep, voffA);
            PG8_WAIT_L(8); PG8_BAR; PG8_WAIT_L(0); PG8_MMA(0, 0, At, B0); PG8_BAR; PG8_SCHED;
            PG8_LDB(B1, 0, 1); PG8_STAGE(PG8_SB(0, 0), b2, voffB);
            PG8_BAR; PG8_WAIT_L(0); PG8_MMA(0, 1, At, B1); PG8_BAR;
            PG8_LDA(At, 0, 1); PG8_STAGE(PG8_SA(0, 0), a2, voffA);
            PG8_BAR; PG8_WAIT_L(0); PG8_MMA(1, 0, At, B0); PG8_BAR; PG8_SCHED;
            PG8_STAGE(PG8_SB(0, 1), b2 + hstep, voffB);
            PG8_WAIT_V(6); PG8_BAR; PG8_MMA(1, 1, At, B1); PG8_BAR;
            PG8_LDB(B0, 1, 0); PG8_SCHED; PG8_LDA(At, 1, 0); PG8_STAGE(PG8_SA(0, 1), a2 + hstep, voffA);
            PG8_WAIT_L(8); PG8_BAR; PG8_WAIT_L(0); PG8_MMA(0, 0, At, B0); PG8_BAR; PG8_SCHED;
            PG8_LDB(B1, 1, 1); PG8_STAGE(PG8_SB(1, 0), b3, voffB);
            PG8_BAR; PG8_WAIT_L(0); PG8_MMA(0, 1, At, B1); PG8_BAR;
            PG8_LDA(At, 1, 1); PG8_STAGE(PG8_SA(1, 0), a3, voffA);
            PG8_BAR; PG8_WAIT_L(0); PG8_MMA(1, 0, At, B0); PG8_BAR; PG8_SCHED;
            PG8_STAGE(PG8_SB(1, 1), b3 + hstep, voffB);
            PG8_WAIT_V(6); PG8_BAR; PG8_MMA(1, 1, At, B1); PG8_BAR;
            }
        }
        if constexpr (HNORM) {
#pragma unroll
            for (int ai = 0; ai < 2; ++ai)
#pragma unroll
                for (int m = 0; m < 4; ++m) { const float f = hrt[(ai * 128 + wr * 64 + m * 16 + fr) * 4 + 3];
#pragma unroll
                    for (int bj = 0; bj < 2; ++bj)
#pragma unroll
                        for (int n = 0; n < 2; ++n) acc[ai][bj][m][n] *= f; } }
        if constexpr (ALIGN_EPI) { if (wr == 0) PG8_BAR; }
        if constexpr (!Epi::AFTER_DRAIN) E(acc, cur, wr, wc, fr, fq);
        if (!has_next) break;
#pragma unroll
        for (int a = 0; a < 2; ++a)
#pragma unroll
            for (int b = 0; b < 2; ++b)
#pragma unroll
                for (int m = 0; m < 4; ++m)
#pragma unroll
                    for (int n = 0; n < 2; ++n) acc[a][b][m][n] = (f32x4){0.f, 0.f, 0.f, 0.f};
        cur = nxt; cA = nA; cB = nB; ++ui;
        if constexpr (ALIGN_EPI) { if (wr == 1) PG8_BAR; }
    }
    PG8_WAIT_V(0);
    if constexpr (!ALIGN_EPI) { if (wr == 0) PG8_BAR; }
    PG8_BAR;
    if constexpr (Epi::AFTER_DRAIN) E.fused(acc, cur, wr, wc, fr, fq, lds, tid);
#undef PG8_SA
#undef PG8_SB
#undef PG8_STAGE
#undef PG8_LDA
#undef PG8_LDB
#undef PG8_MMA
#undef PG8_WAIT_V
#undef PG8_WAIT_L
#undef PG8_BAR
#undef PG8_SCHED
}
}

enum { EK_IN = 0, EK_CO, EK_RO, EK_WO, EK_UP, EK_DN };

template <int KIND>
__device__ __forceinline__ void epi8(const Ctx& c, int row, int col, f32x4 v0, f32x4 v1) {
    unsigned char* act = c.ws + WS_ACT;
    if constexpr (KIND == EK_IN) {
        if (col < 1024) {
            u32x2 w; w.x = pk2(v0[0] * sigm(v0[1]), v0[2] * sigm(v0[3])); w.y = pk2(v1[0] * sigm(v1[1]), v1[2] * sigm(v1[3]));
            *(u32x2*)((bf16_t*)(act + A_U) + (size_t)row * 512 + (col >> 1)) = w;
        } else if (col < 2048) {
            const bool isk = col >= 1536; const int cc = col - (isk ? 1536 : 1024), h = cc >> 7, i0 = (cc & 127) >> 1;
            const float pos = row < MP ? (float)(row & (SEQ - 1)) : 16384.0f;
            const float sc = isk ? 0.08838834764831845f : 1.0f;
            const float* freq = (const float*)(c.ws + WS_CTL + 256);
            const f32x4 fv = *(const f32x4*)(freq + i0);
            float x1[4] = {v0[0], v0[2], v1[0], v1[2]}, x2[4] = {v0[1], v0[3], v1[1], v1[3]}, o1[4], o2[4];
#pragma unroll
            for (int p = 0; p < 4; ++p) {
                const float ang = pos * fv[p];
                const float n = rintf(ang * 0.15915494309189535f);
                const float r = fmaf(-n, -1.7484555e-7f, fmaf(-n, 6.2831854820251465f, ang));
                const float sn = __sinf(r) * sc, cs = __cosf(r) * sc;
                o1[p] = x1[p] * cs - x2[p] * sn; o2[p] = x2[p] * cs + x1[p] * sn;
            }
            bf16_t* dst = (bf16_t*)(act + (isk ? A_K : A_Q)) + (size_t)row * 512 + h * 128 + i0;
            u32x2 w1, w2; w1.x = pk2(o1[0], o1[1]); w1.y = pk2(o1[2], o1[3]); w2.x = pk2(o2[0], o2[1]); w2.y = pk2(o2[2], o2[3]);
            *(u32x2*)dst = w1; *(u32x2*)(dst + 64) = w2;
        } else {
            const int seg = (col - 2048) >> 10, cc = (col - 2048) & 1023;
            float f[8] = {v0[0], v0[1], v0[2], v0[3], v1[0], v1[1], v1[2], v1[3]};
            u32x4 w; w.x = pk2(f[0], f[1]); w.y = pk2(f[2], f[3]); w.z = pk2(f[4], f[5]); w.w = pk2(f[6], f[7]);
            *(u32x4*)((bf16_t*)(act + A_V + (size_t)seg * ((size_t)RT * 1024 * 2)) + (size_t)row * 1024 + cc) = w;
        }
    } else if constexpr (KIND == EK_CO) {
        u32x4* p = (u32x4*)((bf16_t*)(act + A_SA) + (size_t)row * 1024 + col); const u32x4 g = *p;
        u32x4 w; w.x = pk2(v0[0] * sigm(bflo(g.x)), v0[1] * sigm(bfhi(g.x))); w.y = pk2(v0[2] * sigm(bflo(g.y)), v0[3] * sigm(bfhi(g.y)));
        w.z = pk2(v1[0] * sigm(bflo(g.z)), v1[1] * sigm(bfhi(g.z))); w.w = pk2(v1[2] * sigm(bflo(g.w)), v1[3] * sigm(bfhi(g.w)));
        *p = w;
    } else if constexpr (KIND == EK_RO) {
        const u32x4 t = *(const u32x4*)((bf16_t*)(act + A_SA) + (size_t)row * 1024 + col);
        u32x4* p = (u32x4*)((bf16_t*)(act + A_SB) + (size_t)row * 1024 + col); const u32x4 g = *p;
        u32x4 w; w.x = pk2(bflo(t.x) + v0[0] * sigm(bflo(g.x)), bfhi(t.x) + v0[1] * sigm(bfhi(g.x))); w.y = pk2(bflo(t.y) + v0[2] * sigm(bflo(g.y)), bfhi(t.y) + v0[3] * sigm(bfhi(g.y)));
        w.z = pk2(bflo(t.z) + v1[0] * sigm(bflo(g.z)), bfhi(t.z) + v1[1] * sigm(bfhi(g.z))); w.w = pk2(bflo(t.w) + v1[2] * sigm(bflo(g.w)), bfhi(t.w) + v1[3] * sigm(bfhi(g.w)));
        *p = w;
    } else if constexpr (KIND == EK_WO) {
        u32x4 w; w.x = pk2(v0[0], v0[1]); w.y = pk2(v0[2], v0[3]); w.z = pk2(v1[0], v1[1]); w.w = pk2(v1[2], v1[3]);
        *(u32x4*)((bf16_t*)(act + A_M2) + (size_t)row * DM + col) = w;
    } else if constexpr (KIND == EK_UP) {
        float f[8] = {v0[0], v0[1], v0[2], v0[3], v1[0], v1[1], v1[2], v1[3]};
#pragma unroll
        for (int j = 0; j < 8; ++j) { const float r = fmaxf(f[j], 0.f); f[j] = r * r; }
        u32x4 w; w.x = pk2(f[0], f[1]); w.y = pk2(f[2], f[3]); w.z = pk2(f[4], f[5]); w.w = pk2(f[6], f[7]);
        *(u32x4*)((bf16_t*)(act + A_UP) + (size_t)row * FF + col) = w;
    } else {
        u32x4 w; w.x = pk2(v0[0], v0[1]); w.y = pk2(v0[2], v0[3]); w.z = pk2(v1[0], v1[1]); w.w = pk2(v1[2], v1[3]);
        *(u32x4*)((bf16_t*)(act + A_F) + (size_t)row * DM + col) = w;
    }
}

template <int KIND> struct Epi {
    static constexpr bool AFTER_DRAIN = false;
    Ctx c; const LAS float* tab = nullptr;
    __device__ __forceinline__ void operator()(const f32x4 (&acc)[2][2][4][2], const pg8::Unit& u, int wr, int wc, int fr, int fq) const {
#pragma unroll
        for (int ai = 0; ai < 2; ++ai)
#pragma unroll
            for (int m = 0; m < 4; ++m) {
                const int row = u.pm * 256 + ai * 128 + wr * 64 + m * 16 + fr;
                float f = 1.0f; if constexpr (KIND == EK_UP) f = tab[ai * 128 + wr * 64 + m * 16 + fr];
#pragma unroll
                for (int bj = 0; bj < 2; ++bj) {
                    if constexpr (KIND == EK_UP) epi8<KIND>(c, row, u.pn * 256 + bj * 128 + wc * 32 + 8 * fq, acc[ai][bj][m][0] * f, acc[ai][bj][m][1] * f);
                    else epi8<KIND>(c, row, u.pn * 256 + bj * 128 + wc * 32 + 8 * fq, acc[ai][bj][m][0], acc[ai][bj][m][1]);
                }
            }
    }
};

__device__ __forceinline__ bool xch_poll(const unsigned long long* p, float& val) {
    unsigned sp = 0;
    for (;;) { const unsigned long long w = __hip_atomic_load(p, __ATOMIC_RELAXED, __HIP_MEMORY_SCOPE_AGENT);
        if ((unsigned)(w >> 32) != 0u) { val = __uint_as_float((unsigned)w); return true; }
        if (++sp > (1u << 22)) { val = 0.f; return false; }
        __builtin_amdgcn_s_sleep(1); }
}
__device__ __forceinline__ void row_rms_exchange(const Ctx& c, int set, const f32x4 (&v)[2][2][4][2], const pg8::Unit& u, int wr, int wc, int fr, int fq, LAS unsigned char* lds, int tid) {
    LAS float* P = (LAS float*)lds;
    LAS float* S = (LAS float*)(lds + 8192);
    unsigned long long* slots = (unsigned long long*)(c.ws + WS_XCH) + (size_t)set * 64 * 256 * 4;
#pragma unroll
    for (int ai = 0; ai < 2; ++ai)
#pragma unroll
        for (int m = 0; m < 4; ++m) {
            float q = 0.f;
#pragma unroll
            for (int bj = 0; bj < 2; ++bj)
#pragma unroll
                for (int n = 0; n < 2; ++n) { const f32x4 x = v[ai][bj][m][n]; q += (x[0] * x[0] + x[1] * x[1]) + (x[2] * x[2] + x[3] * x[3]); }
            q += __shfl_xor(q, 16); q += __shfl_xor(q, 32);
            if (fq == 0) P[(ai * 128 + wr * 64 + m * 16 + fr) * 4 + wc] = q;
        }
    __syncthreads();
    if (tid < 256) {
        const float t = (P[tid * 4 + 0] + P[tid * 4 + 1]) + (P[tid * 4 + 2] + P[tid * 4 + 3]);
        unsigned long long* sl = slots + (size_t)(u.pm * 256 + tid) * 4;
        __hip_atomic_store(sl + u.pn, (1ull << 32) | (unsigned long long)__float_as_uint(t), __ATOMIC_RELAXED, __HIP_MEMORY_SCOPE_AGENT);
        float tot = 0.f;
#pragma unroll
        for (int k = 0; k < 4; ++k) { float x; xch_poll(sl + k, x); tot += x; }
        S[tid] = 1.0f / sqrtf(tot * (1.0f / DM) + EPS);
    }
    __syncthreads();
}
struct EpiWoFused {
    static constexpr bool AFTER_DRAIN = true;
    Ctx c;
    __device__ __forceinline__ void fused(f32x4 (&acc)[2][2][4][2], const pg8::Unit& u, int wr, int wc, int fr, int fq, LAS unsigned char* lds, int tid) const {
        row_rms_exchange(c, 1, acc, u, wr, wc, fr, fq, lds, tid);
        const LAS float* S = (const LAS float*)(lds + 8192);
        bf16_t* MB = (bf16_t*)(c.ws + WS_ACT + A_M2); bf16_t* HN = (bf16_t*)(c.ws + WS_ACT + A_HN);
#pragma unroll
        for (int bj = 0; bj < 2; ++bj) {
            const int col = u.pn * 256 + bj * 128 + wc * 32 + 8 * fq;
            const f32x4 g0 = *(const f32x4*)(c.n_mix_post + col), g1 = *(const f32x4*)(c.n_mix_post + col + 4);
#pragma unroll
            for (int ai = 0; ai < 2; ++ai)
#pragma unroll
                for (int m = 0; m < 4; ++m) { const int rl = ai * 128 + wr * 64 + m * 16 + fr; const float rs = S[rl]; const size_t ro = (size_t)(u.pm * 256 + rl) * DM + col;
                    const f32x4 x0 = __builtin_nontemporal_load((const f32x4*)(c.xp + ro)), x1 = __builtin_nontemporal_load((const f32x4*)(c.xp + ro + 4));
                    const f32x4 h0 = x0 + acc[ai][bj][m][0] * rs * g0, h1 = x1 + acc[ai][bj][m][1] * rs * g1;
                    acc[ai][bj][m][0] = h0; acc[ai][bj][m][1] = h1;
                    u32x4 w; w.x = pk2(h0[0], h0[1]); w.y = pk2(h0[2], h0[3]); w.z = pk2(h1[0], h1[1]); w.w = pk2(h1[2], h1[3]);
                    *(u32x4*)(MB + ro) = w; }
        }
        {
            LAS float* P = (LAS float*)lds;
            unsigned* slots = (unsigned*)(c.ws + WS_XCH2);
#pragma unroll
            for (int ai = 0; ai < 2; ++ai)
#pragma unroll
                for (int m = 0; m < 4; ++m) { float q = 0.f;
#pragma unroll
                    for (int bj = 0; bj < 2; ++bj)
#pragma unroll
                        for (int n = 0; n < 2; ++n) { const f32x4 x = acc[ai][bj][m][n]; q += (x[0] * x[0] + x[1] * x[1]) + (x[2] * x[2] + x[3] * x[3]); }
                    q += __shfl_xor(q, 16); q += __shfl_xor(q, 32);
                    if (fq == 0) P[(ai * 128 + wr * 64 + m * 16 + fr) * 4 + wc] = q; }
            __syncthreads();
            if (tid < 256) slots[(size_t)(u.pm * 256 + tid) * 4 + u.pn] = __float_as_uint((P[tid * 4 + 0] + P[tid * 4 + 1]) + (P[tid * 4 + 2] + P[tid * 4 + 3]));
        }
    }
};

__device__ __forceinline__ float small_rms_exchange(const Ctx& c, int set, int mt, int ng, int lane, const f32x4& s0, const f32x4& s1) {
    const int fr = lane & 15, fq = lane >> 4;
    unsigned long long* slots = (unsigned long long*)(c.ws + WS_XCHS) + (size_t)((set * 8 + mt) * 16) * 32;
    float q = ((s0[0] * s0[0] + s0[1] * s0[1]) + (s0[2] * s0[2] + s0[3] * s0[3])) + ((s1[0] * s1[0] + s1[1] * s1[1]) + (s1[2] * s1[2] + s1[3] * s1[3]));
    q += __shfl_xor(q, 16); q += __shfl_xor(q, 32);
    if (fq == 0) __hip_atomic_store(slots + fr * 32 + ng, (1ull << 32) | (unsigned long long)__float_as_uint(q), __ATOMIC_RELAXED, __HIP_MEMORY_SCOPE_AGENT);
    float t = 0.f;
#pragma unroll
    for (int k = 0; k < 8; ++k) { float x; xch_poll(slots + fr * 32 + fq * 8 + k, x); t += x; }
    t += __shfl_xor(t, 16); t += __shfl_xor(t, 32);
    return 1.0f / sqrtf(t * (1.0f / DM) + EPS);
}
template <int KIND>
__device__ __forceinline__ void small_fused(const Ctx& c, int mt, int ng, int lane, f32x4 s0, f32x4 s1) {
    const int fr = lane & 15, fq = lane >> 4, col = ng * 32 + 8 * fq;
    const size_t ro = (size_t)(MP + mt * 16 + fr) * DM + col;
    bf16_t* MB = (bf16_t*)(c.ws + WS_ACT + A_M2);
    if constexpr (KIND == EK_WO) {
        const float rs = small_rms_exchange(c, 0, mt, ng, lane, s0, s1);
        const float* xr = c.xs + (size_t)(mt * 16 + fr) * DM + col;
        const f32x4 g0 = *(const f32x4*)(c.n_mix_post + col), g1 = *(const f32x4*)(c.n_mix_post + col + 4);
        const f32x4 h0 = *(const f32x4*)xr + s0 * rs * g0, h1 = *(const f32x4*)(xr + 4) + s1 * rs * g1;
        u32x4 w; w.x = pk2(h0[0], h0[1]); w.y = pk2(h0[2], h0[3]); w.z = pk2(h1[0], h1[1]); w.w = pk2(h1[2], h1[3]);
        *(u32x4*)(MB + ro) = w;
        const float rs2 = small_rms_exchange(c, 1, mt, ng, lane, h0, h1);
        if (ng == 0 && fq == 0) ((float*)(c.ws + WS_RS2S))[mt * 16 + fr] = rs2;
    } else {
        const float rs = small_rms_exchange(c, 2, mt, ng, lane, s0, s1);
        const u32x4 hw = *(const u32x4*)(MB + ro);
        const f32x4 h0 = {bflo(hw.x), bfhi(hw.x), bflo(hw.y), bfhi(hw.y)}, h1 = {bflo(hw.z), bfhi(hw.z), bflo(hw.w), bfhi(hw.w)};
        const f32x4 g0 = *(const f32x4*)(c.n_ffn_post + col), g1 = *(const f32x4*)(c.n_ffn_post + col + 4);
        float* p = c.out + ro;
        *(f32x4*)p = h0 + s0 * rs * g0; *(f32x4*)(p + 4) = h1 + s1 * rs * g1;
    }
}

struct EpiDnFused {
    static constexpr bool AFTER_DRAIN = true;
    Ctx c;
    __device__ __forceinline__ void fused(const f32x4 (&acc)[2][2][4][2], const pg8::Unit& u, int wr, int wc, int fr, int fq, LAS unsigned char* lds, int tid) const {
        row_rms_exchange(c, 0, acc, u, wr, wc, fr, fq, lds, tid);
        const LAS float* S = (const LAS float*)(lds + 8192);
#pragma unroll
        for (int bj = 0; bj < 2; ++bj) {
            const int col = u.pn * 256 + bj * 128 + wc * 32 + 8 * fq;
            const f32x4 g0 = *(const f32x4*)(c.n_ffn_post + col), g1 = *(const f32x4*)(c.n_ffn_post + col + 4);
#pragma unroll
            for (int ai = 0; ai < 2; ++ai)
#pragma unroll
                for (int m = 0; m < 4; ++m) { const int rl = ai * 128 + wr * 64 + m * 16 + fr; const float rs = S[rl];
                    float* p = c.out + (size_t)(u.pm * 256 + rl) * DM + col;
                    const u32x4 hw = __builtin_nontemporal_load((const u32x4*)((const bf16_t*)(c.ws + WS_ACT + A_M2) + (size_t)(u.pm * 256 + rl) * DM + col));
                    const f32x4 h0 = {bflo(hw.x), bfhi(hw.x), bflo(hw.y), bfhi(hw.y)}, h1 = {bflo(hw.z), bfhi(hw.z), bflo(hw.w), bfhi(hw.w)};
                    __builtin_nontemporal_store(h0 + acc[ai][bj][m][0] * rs * g0, (f32x4*)p); __builtin_nontemporal_store(h1 + acc[ai][bj][m][1] * rs * g1, (f32x4*)(p + 4)); }
        }
    }
};

template <int KIND, int N, int K, int NI, class BigEpi = Epi<KIND>, bool ALIGN = false, bool HNORM = false, bool RS2TAB = false>
__device__ __forceinline__ void gemm_all(const Ctx& c, LAS unsigned char* lds, const bf16_t* A, const bf16_t* Bt) {
    {
    {
    pg8::StaticOrder S; S.init(MP, N, gridDim.x, blockIdx.x);
    BigEpi E{c};
    if constexpr (RS2TAB) E.tab = (const LAS float*)(lds + pg8::STAGE_BYTES);
    pg8::Gemm g{A, Bt, MP, N, K, RS2TAB ? (const float*)(c.ws + WS_XCH2) : (const float*)(c.ws + WS_SSQ)};
    pg8::gemm_phase<BigEpi, ALIGN, true, HNORM, RS2TAB>(lds, g, S, E);
    __syncthreads();
    }
    {
    const int tid = otid(), wid = __builtin_amdgcn_readfirstlane(tid >> 6), lane = tid & 63, fr = lane & 15, fq = lane >> 4;
    LAS f32x4* red = (LAS f32x4*)lds;
    constexpr int nitems = 8 * (N / 32), kw = K / 8, KS = kw / 32, KB = KS > 4 ? 4 : KS;
    const unsigned toff = (unsigned)((fr * K + wid * kw + 8 * fq) * 2);
    const unsigned tb0 = (unsigned)((pg8::perm32(fr) * K + wid * kw + 8 * fq) * 2), tb1 = (unsigned)((pg8::perm32(16 + fr) * K + wid * kw + 8 * fq) * 2);
    for (int base = blockIdx.x * NI; base < nitems; base += gridDim.x * NI) {
        f32x4 a0[NI], a1[NI];
#pragma unroll
        for (int q = 0; q < NI; ++q) { a0[q] = (f32x4){0.f, 0.f, 0.f, 0.f}; a1[q] = (f32x4){0.f, 0.f, 0.f, 0.f}; }
#pragma unroll 1
        for (int k0 = 0; k0 < KS; k0 += KB) {
            bf16x8 af[NI][KB], b0[NI][KB], b1[NI][KB];
#pragma unroll
            for (int q = 0; q < NI; ++q) { const int item = base + q, mt = item & 7, ng = item >> 3;
                const char* ap = (const char*)(A + (size_t)(MP + mt * 16) * K) + (size_t)k0 * 64; const char* bp = (const char*)(Bt + (size_t)(ng * 32) * K) + (size_t)k0 * 64;
#pragma unroll
                for (int ks = 0; ks < KB; ++ks) { af[q][ks] = *(const bf16x8*)(ap + ks * 64 + toff); b0[q][ks] = *(const bf16x8*)(bp + ks * 64 + tb0); b1[q][ks] = *(const bf16x8*)(bp + ks * 64 + tb1); } }
#pragma unroll
            for (int q = 0; q < NI; ++q)
#pragma unroll
                for (int ks = 0; ks < KB; ++ks) { a0[q] = __builtin_amdgcn_mfma_f32_16x16x32_bf16(b0[q][ks], af[q][ks], a0[q], 0, 0, 0); a1[q] = __builtin_amdgcn_mfma_f32_16x16x32_bf16(b1[q][ks], af[q][ks], a1[q], 0, 0, 0); }
        }
#pragma unroll
        for (int q = 0; q < NI; ++q) { red[((q * 8 + wid) * 2 + 0) * 64 + lane] = a0[q]; red[((q * 8 + wid) * 2 + 1) * 64 + lane] = a1[q]; }
        __syncthreads();
        if (wid < NI && base + wid < nitems) {
            f32x4 s0 = red[((wid * 8) * 2 + 0) * 64 + lane], s1 = red[((wid * 8) * 2 + 1) * 64 + lane];
#pragma unroll
            for (int w = 1; w < 8; ++w) { s0 += red[((wid * 8 + w) * 2 + 0) * 64 + lane]; s1 += red[((wid * 8 + w) * 2 + 1) * 64 + lane]; }
            const int item = base + wid, mt = item & 7, ng = item >> 3;
            if constexpr (KIND == EK_WO || KIND == EK_DN) small_fused<KIND>(c, mt, ng, lane, s0, s1);
            else { if constexpr (KIND == EK_UP) { const float f = ((const float*)(c.ws + WS_RS2S))[mt * 16 + fr]; s0 *= f; s1 *= f; }
                epi8<KIND>(c, MP + mt * 16 + fr, ng * 32 + 8 * fq, s0, s1); }
        }
        __syncthreads();
    }
    }
    }
}

__device__ __forceinline__ int map_in(int n) {
    if (n < 512) return 2 * n;
    if (n < 1024) return 2 * (n - 512) + 1;
    if (n < 2048) { const int base = n < 1536 ? 1024 : 1536, cc = n - base, h = cc >> 7, d = cc & 127; return base + h * 128 + 2 * (d & 63) + (d >> 6); }
    return n;
}
struct WItem { const float* W; bf16_t* WT; int K, N, r; bool mapin; const float* kscale; };
__device__ __forceinline__ void wt_load(const WItem& w, int lane, f32x4 (&v)[8]) {
    const int nblk = w.N / 32, kb = w.r / nblk, nb = w.r % nblk, k0 = 64 * kb, n0 = 32 * nb, kr = lane >> 3, seg = lane & 7;
    const float* wp = w.W + (size_t)(k0 + kr) * w.N + n0 + seg * 4;
#pragma unroll
    for (int i = 0; i < 8; ++i) v[i] = __builtin_nontemporal_load((const f32x4*)(wp + (size_t)(8 * i) * w.N));
}
__device__ __forceinline__ void wt_finish(const WItem& w, int lane, const f32x4 (&v)[8], LAS float* scr) {
    const int nblk = w.N / 32, kb = w.r / nblk, nb = w.r % nblk, k0 = 64 * kb, n0 = 32 * nb, kr = lane >> 3, seg = lane & 7;
#pragma unroll
    for (int i = 0; i < 8; ++i) { LAS float* d = scr + (8 * i + kr) * 33 + seg * 4; d[0] = v[i][0]; d[1] = v[i][1]; d[2] = v[i][2]; d[3] = v[i][3]; }
    LDS_WAIT();
    const int ch = lane & 7;
#pragma unroll
    for (int j = 0; j < 4; ++j) { const int n = (lane >> 3) + 8 * j; const LAS float* s = scr + (8 * ch) * 33 + n;
        f32x4 ga = {1.f, 1.f, 1.f, 1.f}, gb = {1.f, 1.f, 1.f, 1.f};
        if (w.kscale) { ga = *(const f32x4*)(w.kscale + k0 + 8 * ch); gb = *(const f32x4*)(w.kscale + k0 + 8 * ch + 4); }
        u32x4 o; o.x = pk2(s[0 * 33] * ga[0], s[1 * 33] * ga[1]); o.y = pk2(s[2 * 33] * ga[2], s[3 * 33] * ga[3]); o.z = pk2(s[4 * 33] * gb[0], s[5 * 33] * gb[1]); o.w = pk2(s[6 * 33] * gb[2], s[7 * 33] * gb[3]);
        const int dn = w.mapin ? map_in(n0 + n) : (n0 + n);
        *(u32x4*)(w.WT + (size_t)dn * w.K + k0 + 8 * ch) = o; }
    LDS_WAIT();
}
constexpr int WI_IN = (DM / 64) * (NIN / 32);
constexpr int WI_CO = (CD / 64) * (DM / 32), WI_RO = (DM / 64) * (DM / 32), WI_O = WI_RO, WI_UP = (DM / 64) * (FF / 32), WI_DN = (FF / 64) * (DM / 32);
constexpr int WI_TOTAL = WI_IN + WI_CO + WI_RO + WI_O + WI_UP + WI_DN;

__device__ __forceinline__ void wt_pair(const Ctx& c, int p, int lane, LAS float* scr) {
    int r = 2 * p; WItem w;
    if (r < WI_IN) { w.W = c.w_in; w.WT = (bf16_t*)(c.ws + WS_WIN); w.K = DM; w.N = NIN; w.mapin = true; w.kscale = nullptr; }
    else if ((r -= WI_IN) < WI_CO) { w.W = c.w_co; w.WT = (bf16_t*)(c.ws + WS_WCO); w.K = CD; w.N = DM; w.mapin = false; w.kscale = nullptr; }
    else if ((r -= WI_CO) < WI_RO) { w.W = c.w_ro; w.WT = (bf16_t*)(c.ws + WS_WRO); w.K = DM; w.N = DM; w.mapin = false; w.kscale = nullptr; }
    else if ((r -= WI_RO) < WI_O) { w.W = c.w_o; w.WT = (bf16_t*)(c.ws + WS_WO); w.K = DM; w.N = DM; w.mapin = false; w.kscale = nullptr; }
    else if ((r -= WI_O) < WI_UP) { w.W = c.w_up; w.WT = (bf16_t*)(c.ws + WS_WUP); w.K = DM; w.N = FF; w.mapin = false; w.kscale = c.n_ffn_pre; }
    else { r -= WI_UP; w.W = c.w_dn; w.WT = (bf16_t*)(c.ws + WS_WDN); w.K = FF; w.N = DM; w.mapin = false; w.kscale = nullptr; }
    WItem w1 = w; w.r = r; w1.r = r + 1;
    f32x4 va[8], vb[8];
    wt_load(w, lane, va); wt_load(w1, lane, vb);
    wt_finish(w, lane, va, scr); wt_finish(w1, lane, vb, scr);
}
__device__ __forceinline__ void rms_rows4_to_bf16(const Ctx& c, int row0, int stride, const float* w, bf16_t* XN, int lane) {
    f32x4 v[4][4];
#pragma unroll
    for (int r = 0; r < 4; ++r) { const int row = row0 + r * stride;
        if (row < RT) { const float* x = xrow(c, row);
#pragma unroll
            for (int j = 0; j < 4; ++j) v[r][j] = __builtin_nontemporal_load((const f32x4*)x + 64 * j + lane); } }
#pragma unroll
    for (int r = 0; r < 4; ++r) { const int row = row0 + r * stride;
        if (row < RT) { float s = 0.f;
#pragma unroll
            for (int j = 0; j < 4; ++j) s += (v[r][j].x * v[r][j].x + v[r][j].y * v[r][j].y) + (v[r][j].z * v[r][j].z + v[r][j].w * v[r][j].w);
            const float rs = 1.0f / sqrtf(wave_sum(s) * (1.0f / DM) + EPS);
#pragma unroll
            for (int j = 0; j < 4; ++j) { const f32x4 g = *((const f32x4*)w + 64 * j + lane);
                u32x2 p; p.x = pk2(v[r][j].x * rs * g.x, v[r][j].y * rs * g.y); p.y = pk2(v[r][j].z * rs * g.z, v[r][j].w * rs * g.w);
                *((u32x2*)(XN + (size_t)row * DM) + 64 * j + lane) = p; } } }
}
__device__ __forceinline__ void phase0(const Ctx& c, LAS unsigned char* lds) {
    const int tid = otid(), wid = __builtin_amdgcn_readfirstlane(tid >> 6), lane = tid & 63;
    if (blockIdx.x == 0 && tid < 64) {
        const float xi = (float)tid / 63.0f;
        const float p = (float)exp((double)xi * 9.210340371976184);
        ((float*)(c.ws + WS_CTL + 256))[tid] = 1.0f / p;
    }
    LAS float* scr = (LAS float*)(lds + wid * 16384);
    const int gw = blockIdx.x * 8 + wid, NGW = gridDim.x * 8;
    for (size_t i = (size_t)blockIdx.x * 512 + tid; i < XCH_WORDS; i += (size_t)gridDim.x * 512)
        __hip_atomic_store((unsigned long long*)(c.ws + WS_XCH) + i, 0ull, __ATOMIC_RELAXED, __HIP_MEMORY_SCOPE_AGENT);
    bf16_t* XN = (bf16_t*)c.out;
    for (int row = gw; row < RT; row += 4 * NGW) rms_rows4_to_bf16(c, row, NGW, c.n_mix_pre, XN, lane);
    for (int p = gw; p < WI_IN / 2; p += NGW) wt_pair(c, p, lane, scr);
}

__device__ __forceinline__ void ret_prompt_item(const Ctx& c, LAS unsigned char* lds, int item) {
    const int tid = otid(), wid = __builtin_amdgcn_readfirstlane(tid >> 6), lane = tid & 63, fr = lane & 15, fq = lane >> 4;
    const int s = item & 3, h = (item >> 2) & 3, b = item >> 4;
    const float l2g = log2f(1.0f - exp2f(-5.0f - (float)h));
    unsigned char* act = c.ws + WS_ACT;
    const bf16_t* Q = (const bf16_t*)(act + A_Q); const bf16_t* Kg = (const bf16_t*)(act + A_K); const bf16_t* V = (const bf16_t*)(act + A_V); bf16_t* OB = (bf16_t*)c.out;
    float* SSQ = (float*)(c.ws + WS_SSQ);
    constexpr int LD = 136;
    LAS bf16_t* sQ = (LAS bf16_t*)lds; LAS bf16_t* sK = sQ + 128 * LD; LAS bf16_t* sKT = sK + 128 * LD; LAS bf16_t* sVT = sKT + 128 * LD; LAS bf16_t* sST = sVT + 64 * LD;
    for (int i = tid; i < 64 * LD / 2; i += 512) ((LAS unsigned*)sST)[i] = 0u;
    f32x4 Sacc[4];
#pragma unroll
    for (int e = 0; e < 4; ++e) Sacc[e] = (f32x4){0.f, 0.f, 0.f, 0.f};
    const float gC = exp2f(128.0f * l2g);
    const int il = 16 * wid + fr;
    u32x4 rq[4], rk[4]; unsigned kv[16], vv[8]; u32x2 sgv[4], sgc[4];
    const bf16_t* SGp = (const bf16_t*)(act + A_SG);
    const int dp = tid & 63, ep = tid & 31, jgv = tid >> 5;
    const int jgk = wid;
    const unsigned toq = (unsigned)(((tid >> 4) * 512 + (tid & 15) * 8) * 2);
    const unsigned tok = (unsigned)(2 * dp * 2);
    const unsigned tov = (unsigned)(((jgv * 8) * 1024 + 2 * ep) * 2);
    const unsigned tosg = (unsigned)((il * 1024 + 4 * fq) * 2);
#define RET_LOAD(CH) do { const size_t r0_ = (size_t)b * SEQ + (size_t)(CH) * 128; \
        const char* qb_ = (const char*)(Q + r0_ * 512 + h * 128); const char* kb_ = (const char*)(Kg + r0_ * 512 + h * 128); \
        const char* kt_ = (const char*)(Kg + (r0_ + jgk * 16) * 512 + h * 128); const char* vb_ = (const char*)(V + r0_ * 1024 + h * 256 + s * 64); \
        _Pragma("unroll") for (int i = 0; i < 4; ++i) { rq[i] = *(const u32x4*)(qb_ + (size_t)i * 32768 + toq); rk[i] = *(const u32x4*)(kb_ + (size_t)i * 32768 + toq); } \
        _Pragma("unroll") for (int jj = 0; jj < 16; ++jj) kv[jj] = *(const unsigned*)(kt_ + (size_t)jj * 1024 + tok); \
        _Pragma("unroll") for (int jj = 0; jj < 8; ++jj) vv[jj] = *(const unsigned*)(vb_ + (size_t)jj * 2048 + tov); \
        const char* sg_ = (const char*)(SGp + r0_ * 1024 + h * 256 + s * 64); \
        _Pragma("unroll") for (int et = 0; et < 4; ++et) sgv[et] = *(const u32x2*)(sg_ + (size_t)et * 32 + tosg); } while (0)
    RET_LOAD(0);
    for (int ch = 0; ch < SEQ / 128; ++ch) {
        const size_t r0 = (size_t)b * SEQ + (size_t)ch * 128;
#pragma unroll
        for (int i = 0; i < 4; ++i) { const int id = tid + 512 * i, row = id >> 4, cq = id & 15;
            *(LAS u32x4*)(sQ + row * LD + cq * 8) = rq[i]; *(LAS u32x4*)(sK + row * LD + cq * 8) = rk[i]; }
        {
            unsigned lo[8], hi[8];
#pragma unroll
            for (int jj = 0; jj < 16; jj += 2) {
                const float d0 = exp2f((float)(127 - (jgk * 16 + jj)) * l2g), d1 = exp2f((float)(127 - (jgk * 16 + jj + 1)) * l2g);
                lo[jj >> 1] = pk2(bflo(kv[jj]) * d0, bflo(kv[jj + 1]) * d1); hi[jj >> 1] = pk2(bfhi(kv[jj]) * d0, bfhi(kv[jj + 1]) * d1);
            }
            LAS u32x4* p0 = (LAS u32x4*)(sKT + (2 * dp) * LD + jgk * 16); LAS u32x4* p1 = (LAS u32x4*)(sKT + (2 * dp + 1) * LD + jgk * 16);
            p0[0] = (u32x4){lo[0], lo[1], lo[2], lo[3]}; p0[1] = (u32x4){lo[4], lo[5], lo[6], lo[7]};
            p1[0] = (u32x4){hi[0], hi[1], hi[2], hi[3]}; p1[1] = (u32x4){hi[4], hi[5], hi[6], hi[7]};
        }
        {
            u32x4 lo, hi;
            lo.x = (vv[0] & 0xffffu) | (vv[1] << 16); lo.y = (vv[2] & 0xffffu) | (vv[3] << 16); lo.z = (vv[4] & 0xffffu) | (vv[5] << 16); lo.w = (vv[6] & 0xffffu) | (vv[7] << 16);
            hi.x = (vv[0] >> 16) | (vv[1] & 0xffff0000u); hi.y = (vv[2] >> 16) | (vv[3] & 0xffff0000u); hi.z = (vv[4] >> 16) | (vv[5] & 0xffff0000u); hi.w = (vv[6] >> 16) | (vv[7] & 0xffff0000u);
            *(LAS u32x4*)(sVT + (2 * ep) * LD + jgv * 8) = lo; *(LAS u32x4*)(sVT + (2 * ep + 1) * LD + jgv * 8) = hi;
        }
#pragma unroll
        for (int et = 0; et < 4; ++et) sgc[et] = sgv[et];
        if (ch + 1 < SEQ / 128) RET_LOAD(ch + 1);
        __syncthreads();
        bf16x8 qf[4];
#pragma unroll
        for (int ks = 0; ks < 4; ++ks) qf[ks] = *(const LAS bf16x8*)(sQ + il * LD + ks * 32 + fq * 8);
        f32x4 sc[8];
#pragma unroll
        for (int jp = 0; jp < 8; jp += 2) {
            bf16x8 kf[2][4];
#pragma unroll
            for (int t = 0; t < 2; ++t)
#pragma unroll
                for (int ks = 0; ks < 4; ++ks) kf[t][ks] = *(const LAS bf16x8*)(sK + ((jp + t) * 16 + fr) * LD + ks * 32 + fq * 8);
#pragma unroll
            for (int t = 0; t < 2; ++t) { sc[jp + t] = (f32x4){0.f, 0.f, 0.f, 0.f};
#pragma unroll
                for (int ks = 0; ks < 4; ++ks) sc[jp + t] = __builtin_amdgcn_mfma_f32_16x16x32_bf16(kf[t][ks], qf[ks], sc[jp + t], 0, 0, 0); }
        }
        __syncthreads();
#pragma unroll
        for (int jt = 0; jt < 8; ++jt) { float pv[4];
#pragma unroll
            for (int jj = 0; jj < 4; ++jj) { const int df = il - (jt * 16 + 4 * fq + jj); pv[jj] = df >= 0 ? sc[jt][jj] * exp2f((float)df * l2g) : 0.f; }
            u32x2 w; w.x = pk2(pv[0], pv[1]); w.y = pk2(pv[2], pv[3]);
            *(LAS u32x2*)(sK + il * LD + jt * 16 + 4 * fq) = w; }
        LDS_WAIT(); __builtin_amdgcn_wave_barrier();
        f32x4 o[4];
#pragma unroll
        for (int ep2 = 0; ep2 < 4; ep2 += 2) {
            bf16x8 sf[2][4];
#pragma unroll
            for (int t = 0; t < 2; ++t)
#pragma unroll
                for (int ks = 0; ks < 4; ++ks) sf[t][ks] = *(const LAS bf16x8*)(sST + ((ep2 + t) * 16 + fr) * LD + ks * 32 + fq * 8);
#pragma unroll
            for (int t = 0; t < 2; ++t) { o[ep2 + t] = (f32x4){0.f, 0.f, 0.f, 0.f};
#pragma unroll
                for (int ks = 0; ks < 4; ++ks) o[ep2 + t] = __builtin_amdgcn_mfma_f32_16x16x32_bf16(sf[t][ks], qf[ks], o[ep2 + t], 0, 0, 0); }
        }
        const float qd = exp2f((float)(il + 1) * l2g);
#pragma unroll
        for (int et = 0; et < 4; ++et) { o[et] *= qd; Sacc[et] *= gC; }
#pragma unroll
        for (int k2 = 0; k2 < 4; k2 += 2) {
            bf16x8 pf[2], kf[2], vf[2][4];
#pragma unroll
            for (int t = 0; t < 2; ++t) { const int ks = k2 + t;
                pf[t] = *(const LAS bf16x8*)(sK + il * LD + ks * 32 + fq * 8); kf[t] = *(const LAS bf16x8*)(sKT + il * LD + ks * 32 + fq * 8);
#pragma unroll
                for (int et = 0; et < 4; ++et) vf[t][et] = *(const LAS bf16x8*)(sVT + (et * 16 + fr) * LD + ks * 32 + fq * 8); }
#pragma unroll
            for (int t = 0; t < 2; ++t)
#pragma unroll
                for (int et = 0; et < 4; ++et) { o[et] = __builtin_amdgcn_mfma_f32_16x16x32_bf16(vf[t][et], pf[t], o[et], 0, 0, 0);
                    Sacc[et] = __builtin_amdgcn_mfma_f32_16x16x32_bf16(kf[t], vf[t][et], Sacc[et], 0, 0, 0); }
        }
        float ss = 0.f;
#pragma unroll
        for (int et = 0; et < 4; ++et) { ss += (o[et][0] * o[et][0] + o[et][1] * o[et][1]) + (o[et][2] * o[et][2] + o[et][3] * o[et][3]);
            const float g0 = bflo(sgc[et].x), g1 = bfhi(sgc[et].x), g2 = bflo(sgc[et].y), g3 = bfhi(sgc[et].y);
            u32x2 w; w.x = pk2(o[et][0] * g0 * sigm(g0), o[et][1] * g1 * sigm(g1)); w.y = pk2(o[et][2] * g2 * sigm(g2), o[et][3] * g3 * sigm(g3));
            *(u32x2*)(OB + (r0 + il) * 1024 + h * 256 + s * 64 + et * 16 + 4 * fq) = w; }
        ss += __shfl_xor(ss, 16); ss += __shfl_xor(ss, 32);
        if (fq == 0) SSQ[(r0 + il) * 16 + h * 4 + s] = ss;
        __syncthreads();
#pragma unroll
        for (int et = 0; et < 4; ++et) { u32x2 w; w.x = pk2(Sacc[et][0], Sacc[et][1]); w.y = pk2(Sacc[et][2], Sacc[et][3]);
            *(LAS u32x2*)(sST + (et * 16 + fr) * LD + 16 * wid + 4 * fq) = w; }
    }
    float* nrp = c.out + O_NRP + ((size_t)(b * NH + h) * DK) * DV + s * 64;
#pragma unroll
    for (int et = 0; et < 4; ++et)
#pragma unroll
        for (int jj = 0; jj < 4; ++jj) nrp[(size_t)(16 * wid + 4 * fq + jj) * DV + et * 16 + fr] = Sacc[et][jj];
    __syncthreads();
#undef RET_LOAD
}

__device__ __forceinline__ float block_sum(float v, LAS float* red, int tid) {
    v = wave_sum(v);
    __syncthreads();
    if ((tid & 63) == 0) red[tid >> 6] = v;
    __syncthreads();
    float t = 0.f;
#pragma unroll
    for (int w = 0; w < 8; ++w) t += red[w];
    return t;
}

__device__ __forceinline__ void ret_sample_item(const Ctx& c, LAS unsigned char* lds, int item) {
    const int tid = otid(), b = item >> 2, h = item & 3, row = MP + b;
    unsigned char* act = c.ws + WS_ACT;
    const bf16_t* Q = (const bf16_t*)(act + A_Q) + (size_t)row * 512 + h * 128; const bf16_t* Kg = (const bf16_t*)(act + A_K) + (size_t)row * 512 + h * 128;
    const bf16_t* V = (const bf16_t*)(act + A_V) + (size_t)row * 1024 + h * 256; bf16_t* OB = (bf16_t*)c.out + (size_t)row * 1024 + h * 256;
    LAS float* sq = (LAS float*)lds; LAS float* sk = sq + 128; LAS float* red = sk + 128; LAS float* part = red + 16;
    if (tid < 128) sq[tid] = bf2f(Q[tid]); else if (tid < 256) sk[tid - 128] = bf2f(Kg[tid - 128]);
    __syncthreads();
    const float g = 1.0f - exp2f(-5.0f - (float)h);
    const int e4 = (tid & 63) * 4, dg = tid >> 6;
    const u32x2 vw = *(const u32x2*)(V + e4);
    const f32x4 vv = {bflo(vw.x), bfhi(vw.x), bflo(vw.y), bfhi(vw.y)};
    const float* Sin = c.state_ret + ((size_t)(b * NH + h) * DK + dg * 16) * DV + e4;
    float* Sout = c.out + O_NRS + ((size_t)(b * NH + h) * DK + dg * 16) * DV + e4;
    f32x4 oa = {0.f, 0.f, 0.f, 0.f};
    f32x4 sv[16];
#pragma unroll
    for (int dd = 0; dd < 16; ++dd) sv[dd] = __builtin_nontemporal_load((const f32x4*)(Sin + (size_t)dd * DV));
#pragma unroll
    for (int dd = 0; dd < 16; ++dd) { const float kd = sk[dg * 16 + dd], qd = sq[dg * 16 + dd];
        const f32x4 sn = sv[dd] * g + vv * kd; __builtin_nontemporal_store(sn, (f32x4*)(Sout + (size_t)dd * DV)); oa += sn * qd; }
    *(LAS f32x4*)(part + dg * 256 + e4) = oa;
    __syncthreads();
    float ov = 0.f;
    if (tid < 256) {
#pragma unroll
        for (int w = 0; w < 8; ++w) ov += part[w * 256 + tid];
    }
    const float tot = block_sum(ov * ov, red, tid);
    const float rs = 1.0f / sqrtf(tot * (1.0f / DV) + EPS);
    if (tid < 256) { const float g = bf2f(((const bf16_t*)(act + A_SG))[(size_t)row * 1024 + h * 256 + tid]); OB[tid] = (bf16_t)(pk2(g * sigm(g) * ov * rs, 0.f) & 0xffffu); }
    __syncthreads();
}

__device__ __forceinline__ void conv_prompt_item(const Ctx& c, LAS unsigned char* lds, int item) {
    const int tid = otid(), wid = tid >> 6, lane = tid & 63, b = item >> 6, t0 = (item & 63) * 32;
    unsigned char* act = c.ws + WS_ACT;
    const bf16_t* U = (const bf16_t*)(act + A_U) + (size_t)b * SEQ * 512; bf16_t* AA = (bf16_t*)(act + A_AACT) + (size_t)b * SEQ * 512;
    LAS bf16_t* sU = (LAS bf16_t*)lds; LAS float* sC = (LAS float*)(lds + 63488);
    {
        u32x4 uv[8];
#pragma unroll
        for (int i = 0; i < 8; ++i) { const int id = tid + 512 * i, lr = id >> 6, cq = id & 63, t = t0 - 30 + lr;
            uv[i] = (u32x4){0u, 0u, 0u, 0u}; if (t >= 0 && lr < 62) uv[i] = __builtin_nontemporal_load((const u32x4*)(U + (size_t)t * 512 + cq * 8)); }
#pragma unroll
        for (int i = 0; i < 8; ++i) { const int id = tid + 512 * i, lr = id >> 6, cq = id & 63;
            if (lr < 62) *(LAS u32x4*)(sU + lr * 512 + cq * 8) = uv[i]; }
    }
    float wreg[CW];
#pragma unroll
    for (int w = 0; w < CW; ++w) wreg[w] = c.w_dw[w * CD + tid];
    const float bias = c.b_dw[tid];
    __syncthreads();
#pragma unroll 1
    for (int tb = 0; tb < 4; ++tb) {
        float a[8];
#pragma unroll
        for (int o = 0; o < 8; ++o) a[o] = bias;
#pragma unroll
        for (int k = 0; k < 38; ++k) { const float u = bf2f(sU[(tb * 8 + k) * 512 + tid]);
#pragma unroll
            for (int o = 0; o < 8; ++o) { const int w = k - o; if (w >= 0 && w < CW) a[o] += u * wreg[w]; } }
#pragma unroll
        for (int o = 0; o < 8; ++o) sC[(tb * 8 + o) * 512 + tid] = a[o];
    }
    __syncthreads();
    const f32x4 g0 = *(const f32x4*)(c.ln_w + lane * 4), g1 = *(const f32x4*)(c.ln_w + 256 + lane * 4), b0 = *(const f32x4*)(c.ln_b + lane * 4), b1 = *(const f32x4*)(c.ln_b + 256 + lane * 4);
    for (int rr = wid; rr < 32; rr += 8) {
        f32x4 x0 = *(const LAS f32x4*)(sC + rr * 512 + lane * 4), x1 = *(const LAS f32x4*)(sC + rr * 512 + 256 + lane * 4);
        const float mean = wave_sum((x0.x + x0.y) + (x0.z + x0.w) + (x1.x + x1.y) + (x1.z + x1.w)) * (1.0f / CD);
        x0 -= mean; x1 -= mean;
        const float var = wave_sum((x0.x * x0.x + x0.y * x0.y) + (x0.z * x0.z + x0.w * x0.w) + (x1.x * x1.x + x1.y * x1.y) + (x1.z * x1.z + x1.w * x1.w)) * (1.0f / CD);
        const float rstd = 1.0f / sqrtf(var + EPS);
        f32x4 y0 = x0 * rstd * g0 + b0, y1 = x1 * rstd * g1 + b1;
#pragma unroll
        for (int j = 0; j < 4; ++j) { y0[j] = y0[j] * sigm(y0[j]); y1[j] = y1[j] * sigm(y1[j]); }
        u32x2 w0, w1; w0.x = pk2(y0.x, y0.y); w0.y = pk2(y0.z, y0.w); w1.x = pk2(y1.x, y1.y); w1.y = pk2(y1.z, y1.w);
        bf16_t* dst = AA + (size_t)(t0 + rr) * 512;
        *(u32x2*)(dst + lane * 4) = w0; *(u32x2*)(dst + 256 + lane * 4) = w1;
    }
    if (t0 == SEQ - 32) {
        float* ncp = c.out + O_NCP + (size_t)b * 30 * CD;
        for (int id = tid; id < 30 * CD; id += 512) ncp[id] = bf2f(sU[(32 + (id >> 9)) * 512 + (id & 511)]);
    }
    __syncthreads();
}

__device__ __forceinline__ void conv_sample_item(const Ctx& c, LAS unsigned char* lds, int b) {
    const int tid = otid();
    unsigned char* act = c.ws + WS_ACT;
    LAS float* red = (LAS float*)lds;
    const float* cache = c.cache_conv + (size_t)b * 30 * CD; float* ncs = c.out + O_NCS + (size_t)b * 30 * CD;
    float acc = c.b_dw[tid];
#pragma unroll 1
    for (int w0 = 0; w0 < 30; w0 += 10) {
        float cv[10], wv[10];
#pragma unroll
        for (int w = 0; w < 10; ++w) { cv[w] = __builtin_nontemporal_load(cache + (w0 + w) * CD + tid); wv[w] = c.w_dw[(w0 + w) * CD + tid]; }
#pragma unroll
        for (int w = 0; w < 10; ++w) { acc += cv[w] * wv[w]; if (w0 + w >= 1) __builtin_nontemporal_store(cv[w], ncs + (w0 + w - 1) * CD + tid); }
    }
    const float u = bf2f(((const bf16_t*)(act + A_U))[(size_t)(MP + b) * 512 + tid]);
    acc += u * c.w_dw[30 * CD + tid]; ncs[29 * CD + tid] = u;
    const float mean = block_sum(acc, red, tid) * (1.0f / CD);
    const float d = acc - mean;
    const float var = block_sum(d * d, red, tid) * (1.0f / CD);
    float y = d * (1.0f / sqrtf(var + EPS)) * c.ln_w[tid] + c.ln_b[tid];
    y = y * sigm(y);
    ((bf16_t*)(act + A_AACT))[(size_t)(MP + b) * 512 + tid] = (bf16_t)(pk2(y, 0.f) & 0xffffu);
    __syncthreads();
}

__device__ __forceinline__ void phase2(const Ctx& c, LAS unsigned char* lds, int rep) {
    for (int it = blockIdx.x; it < NB * NH * 4; it += gridDim.x) { const int x = it & 7, j = it >> 3; ret_prompt_item(c, lds, (x * 4 + (j >> 2)) * 4 + (j & 3)); }
    unsigned* counter = (unsigned*)(c.ws + WS_CTL) + rep;
    LAS int* sItem = (LAS int*)(lds + LDS_BYTES - 16);
    constexpr int N_CONV = MP / 32, N_RS = MS * NH, N_CS = MS, N_WQ = (WI_TOTAL - WI_IN) / 16, NTOT = N_CONV + N_RS + N_CS + N_WQ;
    static_assert((WI_TOTAL - WI_IN) % 16 == 0, "weight queue items");
    unsigned nxt = 0u;
    if (threadIdx.x == 0) nxt = atomicAdd(counter, 1u);
    for (;;) {
        if (threadIdx.x == 0) { *sItem = (int)nxt; nxt = atomicAdd(counter, 1u); }
        __syncthreads();
        const int it = __builtin_amdgcn_readfirstlane(*sItem);
        __syncthreads();
        if (it >= NTOT) break;
        if (it < N_CS) conv_sample_item(c, lds, it);
        else if (it < N_CS + N_CONV) conv_prompt_item(c, lds, it - N_CS);
        else if (it < N_CS + N_CONV + N_RS) ret_sample_item(c, lds, it - N_CS - N_CONV);
        else { const int t_ = otid(); const int wv = __builtin_amdgcn_readfirstlane(t_ >> 6);
            wt_pair(c, WI_IN / 2 + (it - N_CS - N_CONV - N_RS) * 8 + wv, t_ & 63, (LAS float*)(lds + wv * 16384)); __syncthreads(); }
    }
}

__device__ __forceinline__ void phase2b(const Ctx& c) {
    const int t_ = otid(); const int lane = t_ & 63, gw = blockIdx.x * 8 + (t_ >> 6), NGW = gridDim.x * 8;
    unsigned char* act = c.ws + WS_ACT;
    const float* SSQ = (const float*)(c.ws + WS_SSQ);
    for (int row0 = gw; row0 < RT; row0 += 4 * NGW) {
        u32x4 a[4][2], o[4][2]; float rs[4];
#pragma unroll
        for (int r = 0; r < 4; ++r) { const int row = row0 + r * NGW; rs[r] = 1.0f;
            if (row < RT) {
                const u32x4* sg = (const u32x4*)((bf16_t*)(act + A_SG) + (size_t)row * 1024 + lane * 16);
                const u32x4* ov = (const u32x4*)((const bf16_t*)c.out + (size_t)row * 1024 + lane * 16);
#pragma unroll
                for (int j = 0; j < 2; ++j) { a[r][j] = __builtin_nontemporal_load(sg + j); o[r][j] = __builtin_nontemporal_load(ov + j); }
                if (row < MP) { const f32x4 q = *(const f32x4*)(SSQ + (size_t)row * 16 + (lane >> 4) * 4); rs[r] = 1.0f / sqrtf(((q.x + q.y) + (q.z + q.w)) * (1.0f / DV) + EPS); }
            } }
#pragma unroll
        for (int r = 0; r < 4; ++r) { const int row = row0 + r * NGW;
            if (row < RT) { u32x4* dg = (u32x4*)((bf16_t*)(act + A_SG) + (size_t)row * 1024 + lane * 16); const float k = rs[r];
#pragma unroll
                for (int j = 0; j < 2; ++j) { const u32x4 x = a[r][j], y = o[r][j]; u32x4 w;
                    w.x = pk2(bflo(x.x) * bflo(y.x) * k, bfhi(x.x) * bfhi(y.x) * k); w.y = pk2(bflo(x.y) * bflo(y.y) * k, bfhi(x.y) * bfhi(y.y) * k);
                    w.z = pk2(bflo(x.z) * bflo(y.z) * k, bfhi(x.z) * bfhi(y.z) * k); w.w = pk2(bflo(x.w) * bflo(y.w) * k, bfhi(x.w) * bfhi(y.w) * k);
                    dg[j] = w; } } }
    }
}


#define XB_TMO      128
#define XB_XCNT(j)  (256  + 64 * (j))
#define XB_XSUB(j)  (1280 + 64 * (j))
#define XB_XGEN(j)  (2304 + 64 * (j))
#define XB_TOP      3328
#define XB_TOPGEN   3392
#define XCD_BAR_WORDS 3456
#define XB_SPIN_CAP (1u << 22)
__device__ __forceinline__ unsigned xb_ld(unsigned* p)              { return __hip_atomic_load(p, __ATOMIC_RELAXED, __HIP_MEMORY_SCOPE_AGENT); }
__device__ __forceinline__ unsigned xb_add(unsigned* p, unsigned v) { return __hip_atomic_fetch_add(p, v, __ATOMIC_RELAXED, __HIP_MEMORY_SCOPE_AGENT); }
__device__ __forceinline__ unsigned xb_xcc_id() { return (unsigned)__builtin_amdgcn_s_getreg((3 << 11) | 20) & 0xFu; }
#define XB_SPIN(cond, bar) do { unsigned _sp = 0; while (cond) { __builtin_amdgcn_s_sleep(1); \
    if ((++_sp & 255u) == 0u) { if (xb_ld(&(bar)[XB_TMO])) break; if (_sp > XB_SPIN_CAP) { atomicAdd(&(bar)[XB_TMO], 1u); break; } } } } while (0)
struct XcdBarrier { unsigned* bar; unsigned x; volatile LAS unsigned* st; };
__device__ __forceinline__ XcdBarrier xcd_barrier_post(unsigned* bar, volatile LAS unsigned* st) {
    XcdBarrier b; b.bar = bar; b.x = xb_xcc_id(); b.st = st;
    if (threadIdx.x == 0) (void)xb_add(&bar[XB_XCNT(b.x)], 1u);
    return b;
}
__device__ __forceinline__ void xcd_barrier_complete(unsigned* bar, unsigned x, unsigned& nloc, unsigned& nx) {
    const unsigned G = gridDim.x * gridDim.y * gridDim.z;
    unsigned sum, cnt, mine, sp = 0u;
    for (;;) {
        sum = 0u; cnt = 0u; mine = 0u;
#pragma unroll
        for (unsigned j = 0; j < 16; ++j) { const unsigned c = xb_ld(&bar[XB_XCNT(j)]); sum += c; cnt += (c > 0u) ? 1u : 0u; mine = (j == x) ? c : mine; }
        if (sum == G) break;
        __builtin_amdgcn_s_sleep(1);
        if ((++sp & 255u) == 0u) { if (xb_ld(&bar[XB_TMO])) break; if (sp > XB_SPIN_CAP) { atomicAdd(&bar[XB_TMO], 1u); break; } }
    }
    nloc = mine > 0u ? mine : 1u; nx = cnt > 0u ? cnt : 1u;
}
__device__ __forceinline__ void xcd_barrier(const XcdBarrier& b) {
    asm volatile("s_waitcnt vmcnt(0)" ::: "memory");
    __syncthreads();
    if (threadIdx.x == 0) {
        unsigned* bar = b.bar;
        __builtin_amdgcn_s_waitcnt(0);
        unsigned nloc = b.st[0], nx = b.st[1];
        if (nloc == 0u) { xcd_barrier_complete(bar, b.x, nloc, nx); b.st[0] = nloc; b.st[1] = nx; }
        const unsigned old = xb_add(&bar[XB_XSUB(b.x)], 1u);
        const unsigned gen = old / nloc;
        if (old + 1u == (gen + 1u) * nloc) {
            __builtin_amdgcn_fence(__ATOMIC_RELEASE, "agent");
            asm volatile("s_waitcnt vmcnt(0)" ::: "memory");
            const unsigned og = xb_add(&bar[XB_TOP], 1u);
            const unsigned tg = og / nx;
            if (og + 1u == (tg + 1u) * nx) xb_add(&bar[XB_TOPGEN], 1u);
            else XB_SPIN(xb_ld(&bar[XB_TOPGEN]) == tg, bar);
            __builtin_amdgcn_fence(__ATOMIC_ACQUIRE, "agent");
            xb_add(&bar[XB_XGEN(b.x)], 1u);
            asm volatile("s_waitcnt vmcnt(0)" ::: "memory");
        } else {
            XB_SPIN(xb_ld(&bar[XB_XGEN(b.x)]) == gen, bar);
            __builtin_amdgcn_fence(__ATOMIC_ACQUIRE, "agent");
            asm volatile("s_waitcnt vmcnt(0)" ::: "memory");
        }
    }
    __syncthreads();
}

__global__ void __launch_bounds__(512) fwd_megakernel(Ctx c) {
    extern __shared__ __attribute__((aligned(16))) unsigned char smem[];
    LAS unsigned char* lds = (LAS unsigned char*)smem;
    cg::grid_group grid = cg::this_grid();
    unsigned char* act = c.ws + WS_ACT;
    volatile LAS unsigned* xst = (volatile LAS unsigned*)(lds + LDS_BYTES - 32);
    if (threadIdx.x == 0) { xst[0] = 0u; xst[1] = 0u; }
    __syncthreads();
    const XcdBarrier xb = xcd_barrier_post((unsigned*)(c.ws + WS_BAR), xst);
    phase0(c, lds);
    if (c.ws == nullptr) grid.sync();
    xcd_barrier(xb);
    gemm_all<EK_IN, NIN, DM, 3, Epi<EK_IN>, true>(c, lds, (const bf16_t*)c.out, (const bf16_t*)(c.ws + WS_WIN));
    xcd_barrier(xb);
    phase2(c, lds, 0);
    xcd_barrier(xb);
    gemm_all<EK_CO, DM, CD, 1, Epi<EK_CO>, true>(c, lds, (const bf16_t*)(act + A_AACT), (const bf16_t*)(c.ws + WS_WCO));
    gemm_all<EK_RO, DM, DM, 1, Epi<EK_RO>, true, true>(c, lds, (const bf16_t*)c.out, (const bf16_t*)(c.ws + WS_WRO));
    xcd_barrier(xb);
    gemm_all<EK_WO, DM, DM, 1, EpiWoFused>(c, lds, (const bf16_t*)(act + A_SB), (const bf16_t*)(c.ws + WS_WO));
    xcd_barrier(xb);
    gemm_all<EK_UP, FF, DM, 4, Epi<EK_UP>, true, false, true>(c, lds, (const bf16_t*)(act + A_M2), (const bf16_t*)(c.ws + WS_WUP));
    xcd_barrier(xb);
    gemm_all<EK_DN, DM, FF, 1, EpiDnFused>(c, lds, (const bf16_t*)(act + A_UP), (const bf16_t*)(c.ws + WS_WDN));
}

extern "C" void kernel_launch(void* const* d_in, const int* in_sizes, int n_in, void* d_out, int out_size, void* d_ws, size_t ws_size, hipStream_t stream) {
    static int grid_blocks = 0;
    if (!grid_blocks) {
        if (n_in != 18 || ws_size < WS_END3) { fprintf(stderr, "kernel_launch: unexpected n_in %d / ws_size %zu (need %zu)\n", n_in, ws_size, (size_t)WS_END3); grid_blocks = -1; return; }
        int dev = 0, cus = 0, per_cu = 0;
        hipGetDevice(&dev);
        hipDeviceGetAttribute(&cus, hipDeviceAttributeMultiprocessorCount, dev);
        if (hipFuncSetAttribute((const void*)fwd_megakernel, hipFuncAttributeMaxDynamicSharedMemorySize, LDS_BYTES) != hipSuccess) fprintf(stderr, "kernel_launch: hipFuncSetAttribute failed\n");
        hipOccupancyMaxActiveBlocksPerMultiprocessor(&per_cu, (const void*)fwd_megakernel, 512, LDS_BYTES);
        (void)hipGetLastError();
        if (per_cu < 1) { fprintf(stderr, "kernel_launch: occupancy query says %d blocks per CU\n", per_cu); per_cu = 1; }
        grid_blocks = cus * per_cu; if (grid_blocks > 256) grid_blocks = 256;
    }
    if (grid_blocks < 0) return;
    (void)hipMemsetAsync((char*)d_ws + WS_CTL, 0, CTL_ZERO, stream);
    Ctx c{};
    const float** f = (const float**)&c;
    for (int i = 0; i < 18; ++i) f[i] = (const float*)d_in[i];
    c.out = (float*)d_out; c.ws = (unsigned char*)d_ws;
    void* args[] = {&c};
    hipError_t e = hipLaunchCooperativeKernel((const void*)fwd_megakernel, dim3(grid_blocks), dim3(512), args, LDS_BYTES, stream);
    if (e != hipSuccess) fprintf(stderr, "cooperative launch failed: %s (grid %d)\n", hipGetErrorString(e), grid_blocks);
}
```
